# Optimizing an MI355X kernel written in HIP

```python
import math
import jax, jax.numpy as jnp
from jax import lax
import numpy as np

D_MODEL = 2048
BATCH = 2
SEQ = 4096
DEPTH = 1
DEC_BATCH = 32
DEC_SEQ = 1
PAST_LEN = 16384
PAGE_SIZE = 128

HEAD_DIM = 64
N_Q_HEADS = 16
N_KV_HEADS = 4
Q_PER_KV = N_Q_HEADS // N_KV_HEADS
D_ATTN = N_Q_HEADS * HEAD_DIM
D_KV = N_KV_HEADS * HEAD_DIM
WINDOW = 128
ATTN_BLOCK = 128
ROPE_THETA = 10000.0
D_RNN = 1024
N_RNN_BLOCKS = 16
RNN_BLOCK = D_RNN // N_RNN_BLOCKS
CONV_WIDTH = 4
LRU_C = 8.0
D_FF = 5632
N_MOD = 9
EPS = 1e-6
D_IN = D_ATTN + 2 * D_KV + 2 * D_RNN + 2 * D_MODEL
SPLITS = (D_ATTN, D_ATTN + D_KV, D_ATTN + 2 * D_KV, D_ATTN + 2 * D_KV + D_RNN,
          D_ATTN + 2 * D_KV + 2 * D_RNN, D_ATTN + 2 * D_KV + 2 * D_RNN + D_MODEL)

kernel_name = 'hybrid_swa_sink_rglru_macaron_adaln_step'


def rmsnorm(x, g):
    xf = x.astype(jnp.float32)
    y = xf * lax.rsqrt(jnp.mean(xf * xf, axis=-1, keepdims=True) + EPS)
    return (y * g.astype(jnp.float32)).astype(x.dtype)


def modulate(x, g, shift, scale):
    return rmsnorm(x, g) * (1 + scale) + shift


def swiglu(x, w1, w3, w2):
    return (jax.nn.silu(x @ w1) * (x @ w3)) @ w2


def rope(x, pos):
    half = HEAD_DIM // 2
    inv = ROPE_THETA ** (-jnp.arange(half, dtype=jnp.float32) * 2.0 / HEAD_DIM)
    ang = pos.astype(jnp.float32)[:, None] * inv[None, :]
    cos = jnp.cos(ang)[:, None, :]
    sin = jnp.sin(ang)[:, None, :]
    xf = x.astype(jnp.float32)
    x1, x2 = xf[..., :half], xf[..., half:]
    return jnp.concatenate([x1 * cos - x2 * sin, x2 * cos + x1 * sin], axis=-1).astype(x.dtype)


def sink_softmax(s, sinks):
    sk = sinks.astype(jnp.float32).reshape(N_KV_HEADS, Q_PER_KV, 1, 1)
    m = jnp.maximum(jnp.max(s, axis=-1, keepdims=True), sk)
    p = jnp.exp(s - m)
    return p / (jnp.sum(p, axis=-1, keepdims=True) + jnp.exp(sk - m))


def window_attn_prompt(q, k, v, sinks):
    B, S = q.shape[0], q.shape[1]
    nb = S // ATTN_BLOCK
    qb = q.reshape(B, nb, ATTN_BLOCK, N_KV_HEADS, Q_PER_KV, HEAD_DIM)
    kb = k.reshape(B, nb, ATTN_BLOCK, N_KV_HEADS, HEAD_DIM)
    vb = v.reshape(B, nb, ATTN_BLOCK, N_KV_HEADS, HEAD_DIM)
    pad = ((0, 0), (1, 0), (0, 0), (0, 0), (0, 0))
    kk = jnp.concatenate([jnp.pad(kb[:, :-1], pad), kb], axis=2)
    vv = jnp.concatenate([jnp.pad(vb[:, :-1], pad), vb], axis=2)
    i = jnp.arange(ATTN_BLOCK)[:, None]
    j = jnp.arange(2 * ATTN_BLOCK)[None, :]
    rel = ATTN_BLOCK + i - j
    band = (rel >= 0) & (rel < WINDOW)
    blk = jnp.arange(nb)[:, None, None]
    mask = band[None] & ((blk > 0) | (j[None] >= ATTN_BLOCK))
    s = jnp.einsum('bnqkgd,bnjkd->bnkgqj', qb, kk).astype(jnp.float32) * (HEAD_DIM ** -0.5)
    s = jnp.where(mask[None, :, None, None], s, -jnp.inf)
    p = sink_softmax(s, sinks).astype(v.dtype)
    o = jnp.einsum('bnkgqj,bnjkd->bnqkgd', p, vv)
    return o.reshape(B, S, D_ATTN)


def window_attn_sample(q, k_new, v_new, k_buf, v_buf, sinks):
    DB, T = q.shape[0], q.shape[1]
    kk = jnp.concatenate([k_buf, k_new], axis=1)
    vv = jnp.concatenate([v_buf, v_new], axis=1)
    nbuf = k_buf.shape[1]
    qpos = PAST_LEN + jnp.arange(T)
    kpos = jnp.concatenate([PAST_LEN - nbuf + jnp.arange(nbuf), PAST_LEN + jnp.arange(T)])
    rel = qpos[:, None] - kpos[None, :]
    mask = (rel >= 0) & (rel < WINDOW)
    qg = q.reshape(DB, T, N_KV_HEADS, Q_PER_KV, HEAD_DIM)
    s = jnp.einsum('btkgd,bjkd->bkgtj', qg, kk).astype(jnp.float32) * (HEAD_DIM ** -0.5)
    s = jnp.where(mask[None, None, None], s, -jnp.inf)
    p = sink_softmax(s, sinks).astype(v_new.dtype)
    o = jnp.einsum('bkgtj,bjkd->btkgd', p, vv)
    return o.reshape(DB, T, D_ATTN)


def causal_conv(x, buf, w, b):
    T = x.shape[1]
    xp = jnp.concatenate([buf, x], axis=1)
    y = b
    for t in range(CONV_WIDTH):
        y = y + xp[:, t:t + T] * w[t]
    return y, xp[:, -(CONV_WIDTH - 1):]


def rglru(x, h0, w_rg, b_rg, w_ig, b_ig, lam):
    B, T, _ = x.shape
    xb = x.reshape(B, T, N_RNN_BLOCKS, RNN_BLOCK)
    r = jax.nn.sigmoid(jnp.einsum('bthi,hij->bthj', xb, w_rg).reshape(B, T, D_RNN) + b_rg)
    ig = jax.nn.sigmoid(jnp.einsum('bthi,hij->bthj', xb, w_ig).reshape(B, T, D_RNN) + b_ig)
    log_a = -LRU_C * r.astype(jnp.float32) * jax.nn.softplus(-lam.astype(jnp.float32))
    a = jnp.exp(log_a)
    u = jnp.sqrt(-jnp.expm1(2.0 * log_a)) * (ig * x).astype(jnp.float32)
    u = u.at[:, 0].add(a[:, 0] * h0.astype(jnp.float32))

    def combine(e, l):
        return e[0] * l[0], l[0] * e[1] + l[1]

    _, h = lax.associative_scan(combine, (a, u), axis=1)
    h = h.astype(x.dtype)
    return h, h[:, -1]


def trunk_layer(x, c, pos, conv_buf, h0, k_buf, v_buf, prompt, p):
    mod = jax.nn.silu(c) @ p['w_ada'] + p['b_ada']
    sh1, sc1, ga1, shm, scm, gam, sh2, sc2, ga2 = jnp.split(mod[:, None, :], N_MOD, axis=-1)
    x = x + 0.5 * ga1 * swiglu(modulate(x, p['g_norm_ffn1'], sh1, sc1), p['ffn1_w1'], p['ffn1_w3'], p['ffn1_w2'])
    h = modulate(x, p['g_norm_mix'], shm, scm)
    z = h @ p['w_in']
    q, k, v, rx, rg, g_att, g_rnn = jnp.split(z, SPLITS, axis=-1)
    B, T = x.shape[0], x.shape[1]
    q = rope(rmsnorm(q.reshape(B, T, N_Q_HEADS, HEAD_DIM), p['g_q']), pos)
    k = rope(rmsnorm(k.reshape(B, T, N_KV_HEADS, HEAD_DIM), p['g_k']), pos)
    v = v.reshape(B, T, N_KV_HEADS, HEAD_DIM)
    if prompt:
        o_att = window_attn_prompt(q, k, v, p['sinks'])
        k_state, v_state = k[:, -WINDOW:], v[:, -WINDOW:]
    else:
        o_att = window_attn_sample(q, k, v, k_buf, v_buf, p['sinks'])
        k_state, v_state = k, v
    xc, conv_state = causal_conv(rx, conv_buf, p['conv_w'], p['conv_b'])
    hr, h_last = rglru(xc, h0, p['w_rg'], p['b_rg'], p['w_ig'], p['b_ig'], p['lru_lambda'])
    o_rnn = hr * jax.nn.gelu(rg)
    mix = jax.nn.sigmoid(g_att) * (o_att @ p['w_pa']) + jax.nn.sigmoid(g_rnn) * (o_rnn @ p['w_pr'])
    x = x + gam * (mix @ p['w_out'])
    x = x + 0.5 * ga2 * swiglu(modulate(x, p['g_norm_ffn2'], sh2, sc2), p['ffn2_w1'], p['ffn2_w3'], p['ffn2_w2'])
    return x, k_state, v_state, h_last, conv_state


def setup_inputs(seed: int = 0) -> dict:
    key = jax.random.key(seed)
    ks = jax.random.split(key, 40)
    f32 = jnp.float32

    def nrm(k, shape, scale):
        return jax.random.normal(k, shape, f32) * scale

    a = jax.random.uniform(ks[30], (DEPTH, D_RNN), f32, minval=0.9, maxval=0.999)
    s = a ** 0.125
    lru_lambda = jnp.log(s) - jnp.log1p(-s)
    return {
        'x_prompt': nrm(ks[0], (BATCH, SEQ, D_MODEL), 1.0),
        'x_sample': nrm(ks[1], (DEC_BATCH, DEC_SEQ, D_MODEL), 1.0),
        'c_prompt': nrm(ks[2], (BATCH, D_MODEL), 1.0),
        'c_sample': nrm(ks[3], (DEC_BATCH, D_MODEL), 1.0),
        'cache_k': nrm(ks[4], (DEPTH, DEC_BATCH, WINDOW, N_KV_HEADS, HEAD_DIM), 1.0),
        'cache_v': nrm(ks[5], (DEPTH, DEC_BATCH, WINDOW, N_KV_HEADS, HEAD_DIM), 1.0),
        'state_h': nrm(ks[6], (DEPTH, DEC_BATCH, D_RNN), 0.5),
        'state_conv': nrm(ks[7], (DEPTH, DEC_BATCH, CONV_WIDTH - 1, D_RNN), 1.0),
        'w_ada': nrm(ks[8], (DEPTH, D_MODEL, N_MOD * D_MODEL), D_MODEL ** -0.5),
        'b_ada': nrm(ks[9], (DEPTH, N_MOD * D_MODEL), 0.02),
        'g_norm_ffn1': 1.0 + nrm(ks[10], (DEPTH, D_MODEL), 0.02),
        'g_norm_mix': 1.0 + nrm(ks[11], (DEPTH, D_MODEL), 0.02),
        'g_norm_ffn2': 1.0 + nrm(ks[12], (DEPTH, D_MODEL), 0.02),
        'ffn1_w1': nrm(ks[13], (DEPTH, D_MODEL, D_FF), D_MODEL ** -0.5),
        'ffn1_w3': nrm(ks[14], (DEPTH, D_MODEL, D_FF), D_MODEL ** -0.5),
        'ffn1_w2': nrm(ks[15], (DEPTH, D_FF, D_MODEL), D_FF ** -0.5),
        'ffn2_w1': nrm(ks[16], (DEPTH, D_MODEL, D_FF), D_MODEL ** -0.5),
        'ffn2_w3': nrm(ks[17], (DEPTH, D_MODEL, D_FF), D_MODEL ** -0.5),
        'ffn2_w2': nrm(ks[18], (DEPTH, D_FF, D_MODEL), D_FF ** -0.5),
        'w_in': nrm(ks[19], (DEPTH, D_MODEL, D_IN), D_MODEL ** -0.5),
        'g_q': 1.0 + nrm(ks[20], (DEPTH, HEAD_DIM), 0.02),
        'g_k': 1.0 + nrm(ks[21], (DEPTH, HEAD_DIM), 0.02),
        'sinks': nrm(ks[22], (DEPTH, N_Q_HEADS), 0.5),
        'conv_w': nrm(ks[23], (DEPTH, CONV_WIDTH, D_RNN), CONV_WIDTH ** -0.5),
        'conv_b': nrm(ks[24], (DEPTH, D_RNN), 0.02),
        'w_rg': nrm(ks[25], (DEPTH, N_RNN_BLOCKS, RNN_BLOCK, RNN_BLOCK), RNN_BLOCK ** -0.5),
        'b_rg': nrm(ks[26], (DEPTH, D_RNN), 0.02),
        'w_ig': nrm(ks[27], (DEPTH, N_RNN_BLOCKS, RNN_BLOCK, RNN_BLOCK), RNN_BLOCK ** -0.5),
        'b_ig': nrm(ks[28], (DEPTH, D_RNN), 0.02),
        'lru_lambda': lru_lambda,
        'w_pa': nrm(ks[31], (DEPTH, D_ATTN, D_MODEL), D_ATTN ** -0.5),
        'w_pr': nrm(ks[32], (DEPTH, D_RNN, D_MODEL), D_RNN ** -0.5),
        'w_out': nrm(ks[33], (DEPTH, D_MODEL, D_MODEL), D_MODEL ** -0.5),
    }


def reference(x_prompt, x_sample, c_prompt, c_sample, cache_k, cache_v, state_h, state_conv,
              w_ada, b_ada, g_norm_ffn1, g_norm_mix, g_norm_ffn2,
              ffn1_w1, ffn1_w3, ffn1_w2, ffn2_w1, ffn2_w3, ffn2_w2,
              w_in, g_q, g_k, sinks, conv_w, conv_b, w_rg, b_rg, w_ig, b_ig, lru_lambda,
              w_pa, w_pr, w_out):
    B, S = x_prompt.shape[0], x_prompt.shape[1]
    DB, T = x_sample.shape[0], x_sample.shape[1]
    pos_p = jnp.arange(S)
    pos_s = PAST_LEN + jnp.arange(T)
    conv0 = jnp.zeros((B, CONV_WIDTH - 1, D_RNN), x_prompt.dtype)
    h_zero = jnp.zeros((B, D_RNN), x_prompt.dtype)
    yp, ys = x_prompt, x_sample
    kp_l, vp_l, ks_l, vs_l, hp_l, hs_l, cp_l, cs_l = [], [], [], [], [], [], [], []
    for l in range(DEPTH):
        p = dict(w_ada=w_ada[l], b_ada=b_ada[l], g_norm_ffn1=g_norm_ffn1[l], g_norm_mix=g_norm_mix[l],
                 g_norm_ffn2=g_norm_ffn2[l], ffn1_w1=ffn1_w1[l], ffn1_w3=ffn1_w3[l], ffn1_w2=ffn1_w2[l],
                 ffn2_w1=ffn2_w1[l], ffn2_w3=ffn2_w3[l], ffn2_w2=ffn2_w2[l], w_in=w_in[l],
                 g_q=g_q[l], g_k=g_k[l], sinks=sinks[l], conv_w=conv_w[l], conv_b=conv_b[l],
                 w_rg=w_rg[l], b_rg=b_rg[l], w_ig=w_ig[l], b_ig=b_ig[l], lru_lambda=lru_lambda[l],
                 w_pa=w_pa[l], w_pr=w_pr[l], w_out=w_out[l])
        yp, kp, vp, hp, cp = trunk_layer(yp, c_prompt, pos_p, conv0, h_zero, None, None, True, p)
        ys, ksn, vsn, hs, cs = trunk_layer(ys, c_sample, pos_s, state_conv[l], state_h[l],
                                           cache_k[l], cache_v[l], False, p)
        kp_l.append(kp); vp_l.append(vp); ks_l.append(ksn); vs_l.append(vsn)
        hp_l.append(hp); hs_l.append(hs); cp_l.append(cp); cs_l.append(cs)
    k_prompt = jnp.stack(kp_l)
    v_prompt = jnp.stack(vp_l)
    k_sample = jnp.stack(ks_l)
    v_sample = jnp.stack(vs_l)
    h_prompt = jnp.stack(hp_l)
    h_sample = jnp.stack(hs_l)
    conv_prompt = jnp.stack(cp_l)
    conv_sample = jnp.stack(cs_l)
    return (yp, ys, k_prompt, v_prompt, k_sample, v_sample, h_prompt, h_sample, conv_prompt, conv_sample)
```

```cpp
#include <hip/hip_runtime.h>
#include <hip/hip_cooperative_groups.h>
#include <cstdio>
#include <cstdint>
#include <cmath>
namespace pg8 {
#define PG8_LAS __attribute__((address_space(3)))
typedef unsigned short bf16_t;
typedef short bf16x8 __attribute__((ext_vector_type(8)));
typedef float f32x4 __attribute__((ext_vector_type(4)));
typedef unsigned u32x4 __attribute__((ext_vector_type(4)));
constexpr int BM = 256, BK = 64, HALF = 128, HTB = HALF * BK * 2  , STAGE_BYTES = 8 * HTB, NXCD = 8, WGM = 8;

__host__ __device__ __forceinline__ int lds_byte(int r, int c) { const int st = (r >> 4) * 2 + (c >> 5), rr = r & 15, cc = c & 31, ob = rr * 64 + cc * 2; return st * 1024 + (ob ^ (((ob >> 9) & 1) << 5)); }
__host__ __device__ __forceinline__ void stage_rc(int b, int& R, int& C) { const int st = b / 1024, sb = b % 1024, swz = sb ^ (((sb >> 9) & 1) << 5); R = (st >> 1) * 16 + swz / 64; C = (st & 1) * 32 + (swz % 64) / 2; }
__host__ __device__ __forceinline__ int perm32(int rho) { const int n = rho >> 4, i = rho & 15; return 8 * (i >> 2) + 4 * n + (i & 3); }

struct Unit { int pm, pn; };
struct Gemm { const bf16_t* A; const bf16_t* Bt; int M, N, K; };

struct StaticOrder {
    int nM, nN, nwg, G, c;
    __host__ __device__ void init(int M, int N, int G_, int c_) { nM = M / BM; nN = N / BM; nwg = nM * nN; G = G_; c = c_; }
    __host__ __device__ bool next(int i, Unit& u) const {
        const long L = (long)i * G + c; if (L >= nwg) return false;
        int wgid = (int)L; { const int q = nwg / NXCD, r = nwg % NXCD, xcd = wgid % NXCD, off = wgid / NXCD; wgid = (xcd < r ? xcd * (q + 1) : r * (q + 1) + (xcd - r) * q) + off; }
        const int nig = WGM * nN, gid = wgid / nig, fm = gid * WGM, gsz = (nM - fm) < WGM ? (nM - fm) : WGM;
        u.pm = fm + ((wgid % nig) % gsz); u.pn = (wgid % nig) / gsz; return true;
    }
    __device__ __forceinline__ void a_ready(const Unit&) const {}
    __device__ __forceinline__ void done(const Unit&) const {}
};

__device__ __forceinline__ unsigned cvt_pk_bf16(float lo, float hi) { unsigned r; asm volatile("v_cvt_pk_bf16_f32 %0, %1, %2" : "=v"(r) : "v"(lo), "v"(hi)); return r; }
typedef float f32x2 __attribute__((ext_vector_type(2)));
__device__ __forceinline__ f32x2 gelu_pk(f32x2 v) {
    const f32x2 av = __builtin_elementwise_abs(v), d = av * 0.2316418882f + 1.0f;
    f32x2 t; t.x = __builtin_amdgcn_rcpf(d.x); t.y = __builtin_amdgcn_rcpf(d.y);
    f32x2 q = t * 0.5307027145f + (-0.7265760135f); q = q * t + 0.7107068705f; q = q * t + (-0.142248368f); q = q * t + 0.127414796f; q = q * t;
    const f32x2 s = (v * v) * (-0.72134752044f);
    f32x2 e; e.x = __builtin_amdgcn_exp2f(s.x); e.y = __builtin_amdgcn_exp2f(s.y);
    const f32x2 m = v * (q * e), r = v - m;
    f32x2 o; o.x = v.x < 0.f ? m.x : r.x; o.y = v.y < 0.f ? m.y : r.y; return o;
}

template <int ACT  > struct EpiBf16 {
    static constexpr bool PERM = true, AFTER_DRAIN = false; static_assert(ACT == 0 || ACT == 1, "EpiBf16: ACT is 0 (none) or 1 (gelu_pk)");
    bf16_t* O; int ldc; const float* bias; int split_cols; size_t split_stride; float scale0;
    __device__ __forceinline__ void operator()(const f32x4 (&acc)[2][2][4][2], const Unit& u, int wr, int wc, int fr, int fq) const {
        const int row0 = u.pm * BM + wr * 64 + fr; int colt = u.pn * BM; bf16_t* base = O;
        float sc = 1.f; if (split_cols) { const int t = colt / split_cols; base += (size_t)t * split_stride; colt -= t * split_cols; if (t == 0) sc = scale0; }
        const int col0 = colt + wc * 32 + 8 * fq, bcol0 = u.pn * BM + wc * 32 + 8 * fq;
        f32x4 bv[2][2];
#pragma unroll
        for (int bj = 0; bj < 2; ++bj)
#pragma unroll
            for (int n = 0; n < 2; ++n) bv[bj][n] = bias ? *(const f32x4*)(bias + bcol0 + bj * HALF + 4 * n) : (f32x4){0.f, 0.f, 0.f, 0.f};
#pragma unroll
        for (int ai = 0; ai < 2; ++ai)
#pragma unroll
            for (int m = 0; m < 4; ++m) { bf16_t* rowp = base + (size_t)(row0 + ai * HALF + m * 16) * ldc + col0;
#pragma unroll
                for (int bj = 0; bj < 2; ++bj) { f32x4 v0 = acc[ai][bj][m][0] + bv[bj][0], v1 = acc[ai][bj][m][1] + bv[bj][1];
                    if (ACT == 1) { f32x2 a = gelu_pk((f32x2){v0[0], v0[1]}), b = gelu_pk((f32x2){v0[2], v0[3]}), c = gelu_pk((f32x2){v1[0], v1[1]}), d = gelu_pk((f32x2){v1[2], v1[3]});
                        v0 = (f32x4){a.x, a.y, b.x, b.y}; v1 = (f32x4){c.x, c.y, d.x, d.y}; }
                    v0 = v0 * sc; v1 = v1 * sc; u32x4 w; w.x = cvt_pk_bf16(v0[0], v0[1]); w.y = cvt_pk_bf16(v0[2], v0[3]); w.z = cvt_pk_bf16(v1[0], v1[1]); w.w = cvt_pk_bf16(v1[2], v1[3]);
                    *(u32x4*)(rowp + bj * HALF) = w; } }
    }
};
constexpr int MROWS_VALID = 8224, MROWS_PROMPT = 8192;
__device__ __forceinline__ float fsigmoid(float x) { return __builtin_amdgcn_rcpf(1.f + __builtin_amdgcn_exp2f(-1.44269504f * x)); }
__device__ __forceinline__ float fsilu(float x) { return x * fsigmoid(x); }
__device__ __forceinline__ float bflo(unsigned w) { return __uint_as_float(w << 16); }
__device__ __forceinline__ float bfhi(unsigned w) { return __uint_as_float(w & 0xffff0000u); }

struct EpiSwiGLU {
    static constexpr bool PERM = true, AFTER_DRAIN = false;
    bf16_t* O; int ldc;
    __device__ __forceinline__ void operator()(const f32x4 (&acc)[2][2][4][2], const Unit& u, int wr, int wc, int fr, int fq) const {
        const int row0 = u.pm * BM + wr * 64 + fr, col0 = u.pn * HALF + wc * 32 + 8 * fq;
#pragma unroll
        for (int ai = 0; ai < 2; ++ai)
#pragma unroll
            for (int m = 0; m < 4; ++m) {
                bf16_t* p = O + (size_t)(row0 + ai * HALF + m * 16) * ldc + col0;
                const f32x4 a0 = acc[ai][0][m][0], a1 = acc[ai][0][m][1], b0 = acc[ai][1][m][0], b1 = acc[ai][1][m][1];
                u32x4 w;
                w.x = cvt_pk_bf16(fsilu(a0[0]) * b0[0], fsilu(a0[1]) * b0[1]); w.y = cvt_pk_bf16(fsilu(a0[2]) * b0[2], fsilu(a0[3]) * b0[3]);
                w.z = cvt_pk_bf16(fsilu(a1[0]) * b1[0], fsilu(a1[1]) * b1[1]); w.w = cvt_pk_bf16(fsilu(a1[2]) * b1[2], fsilu(a1[3]) * b1[3]);
                *(u32x4*)p = w;
            }
    }
};
struct EpiRes {
    static constexpr bool PERM = false, AFTER_DRAIN = false;
    const float* base_p; const float* base_s; float* out; const float* gate; float gs;
    __device__ __forceinline__ void operator()(const f32x4 (&acc)[2][2][4][2], const Unit& u, int wr, int wc, int fr, int fq) const {
        const int col0 = u.pn * BM + wc * 32 + 4 * fq;
#pragma unroll
        for (int ai = 0; ai < 2; ++ai)
#pragma unroll
            for (int m = 0; m < 4; ++m) {
                const int row = u.pm * BM + ai * HALF + wr * 64 + m * 16 + fr;
                if (row < MROWS_VALID) {
                    const int br = row < MROWS_PROMPT ? (row >> 12) : (2 + row - MROWS_PROMPT);
                    const float* bp = row < MROWS_PROMPT ? base_p + (size_t)row * 2048 : base_s + (size_t)(row - MROWS_PROMPT) * 2048;
                    const float* gp = gate + (size_t)br * 18432; float* op = out + (size_t)row * 2048;
#pragma unroll
                    for (int bj = 0; bj < 2; ++bj)
#pragma unroll
                        for (int n = 0; n < 2; ++n) { const int c = col0 + bj * HALF + n * 16;
                            const f32x4 g = *(const f32x4*)(gp + c), b = *(const f32x4*)(bp + c);
                            *(f32x4*)(op + c) = b + (g * gs) * acc[ai][bj][m][n]; }
                }
            }
    }
};
template <bool ACCUM> struct EpiGateMix {
    static constexpr bool PERM = true, AFTER_DRAIN = false;
    bf16_t* O; const bf16_t* Zg;
    __device__ __forceinline__ void operator()(const f32x4 (&acc)[2][2][4][2], const Unit& u, int wr, int wc, int fr, int fq) const {
        const int row0 = u.pm * BM + wr * 64 + fr, col0 = u.pn * BM + wc * 32 + 8 * fq;
#pragma unroll
        for (int ai = 0; ai < 2; ++ai)
#pragma unroll
            for (int m = 0; m < 4; ++m) { const int row = row0 + ai * HALF + m * 16;
#pragma unroll
                for (int bj = 0; bj < 2; ++bj) { const int c = col0 + bj * HALF;
                    const u32x4 gz = *(const u32x4*)(Zg + (size_t)row * 7680 + c);
                    bf16_t* op = O + (size_t)row * 2048 + c;
                    const f32x4 v0 = acc[ai][bj][m][0], v1 = acc[ai][bj][m][1];
                    float r0 = fsigmoid(bflo(gz.x)) * v0[0], r1 = fsigmoid(bfhi(gz.x)) * v0[1], r2 = fsigmoid(bflo(gz.y)) * v0[2], r3 = fsigmoid(bfhi(gz.y)) * v0[3];
                    float r4 = fsigmoid(bflo(gz.z)) * v1[0], r5 = fsigmoid(bfhi(gz.z)) * v1[1], r6 = fsigmoid(bflo(gz.w)) * v1[2], r7 = fsigmoid(bfhi(gz.w)) * v1[3];
                    if (ACCUM) { const u32x4 pv = *(const u32x4*)op;
                        r0 += bflo(pv.x); r1 += bfhi(pv.x); r2 += bflo(pv.y); r3 += bfhi(pv.y); r4 += bflo(pv.z); r5 += bfhi(pv.z); r6 += bflo(pv.w); r7 += bfhi(pv.w); }
                    u32x4 w; w.x = cvt_pk_bf16(r0, r1); w.y = cvt_pk_bf16(r2, r3); w.z = cvt_pk_bf16(r4, r5); w.w = cvt_pk_bf16(r6, r7);
                    *(u32x4*)op = w; }
            }
    }
};
template <class Epi, class Sched, bool ALIGN_EPI = false, bool SP2 = false>
__device__ __forceinline__ void gemm_phase(PG8_LAS unsigned char* lds, const Gemm g, const Sched& S, const Epi& E) {
    const int tid = threadIdx.x, wid = __builtin_amdgcn_readfirstlane(tid >> 6), lane = tid & 63, wr = wid >> 2, wc = wid & 3, fr = lane & 15, fq = lane >> 4;
    const int K = g.K, nt = K / BK;
    unsigned voffA[2], voffB[2];
#pragma unroll
    for (int i = 0; i < 2; ++i) { int R, C; stage_rc(tid * 16 + i * 8192, R, C); const int Rb = Epi::PERM ? ((R & ~31) + perm32(R & 31)) : R;
        voffA[i] = (unsigned)(R * K + C) * 2u; voffB[i] = (unsigned)(Rb * K + C) * 2u; }
    const size_t kstep = (size_t)(BK * 2);
    const size_t hstep = (size_t)HALF * K * 2;
    const size_t tstep = 2 * hstep;
    const unsigned ldsw = (unsigned)wid * 1024u;
    const int aoff = lds_byte(wr * 64 + fr, fq * 8), boff = lds_byte(wc * 32 + fr, fq * 8);
#define PG8_SA(b, h) (((b) * 2 + (h)) * HTB)
#define PG8_SB(b, h) ((4 + (b) * 2 + (h)) * HTB)
#define PG8_STAGE(bufoff, gbase, voff) do { _Pragma("unroll") for (int _i = 0; _i < 2; ++_i) \
        __builtin_amdgcn_global_load_lds((const unsigned*)((const char*)(gbase) + (voff)[_i]), (PG8_LAS unsigned*)(lds + (bufoff) + ldsw + _i * 8192), 16, 0, 0); } while (0)
#define PG8_LDA(dst, b, h) do { _Pragma("unroll") for (int m = 0; m < 4; ++m) _Pragma("unroll") for (int k = 0; k < 2; ++k) dst[m][k] = *(const PG8_LAS bf16x8*)(lds + PG8_SA(b, h) + aoff + m * 2048 + k * 1024); } while (0)
#define PG8_LDB(dst, b, h) do { _Pragma("unroll") for (int n = 0; n < 2; ++n) _Pragma("unroll") for (int k = 0; k < 2; ++k) dst[n][k] = *(const PG8_LAS bf16x8*)(lds + PG8_SB(b, h) + boff + n * 2048 + k * 1024); } while (0)
#define PG8_MMA(ai, bj, At, Bt) do { __builtin_amdgcn_s_setprio(1); _Pragma("unroll") for (int m = 0; m < 4; ++m) _Pragma("unroll") for (int n = 0; n < 2; ++n) _Pragma("unroll") for (int k = 0; k < 2; ++k) \
        acc[ai][bj][m][n] = __builtin_amdgcn_mfma_f32_16x16x32_bf16(Bt[n][k], At[m][k], acc[ai][bj][m][n], 0, 0, 0); __builtin_amdgcn_s_setprio(0); } while (0)
#define PG8_WAIT_V(n) asm volatile("s_waitcnt vmcnt(" #n ")" ::: "memory")
#define PG8_WAIT_L(n) asm volatile("s_waitcnt lgkmcnt(" #n ")" ::: "memory")
#define PG8_BAR __builtin_amdgcn_s_barrier()
#define PG8_SCHED __builtin_amdgcn_sched_barrier(0)
    Unit cur, nxt; int ui = 0;
    if (!S.next(0, cur)) return;
    f32x4 acc[2][2][4][2];
#pragma unroll
    for (int a = 0; a < 2; ++a)
#pragma unroll
        for (int b = 0; b < 2; ++b)
#pragma unroll
            for (int m = 0; m < 4; ++m)
#pragma unroll
                for (int n = 0; n < 2; ++n) acc[a][b][m][n] = (f32x4){0.f, 0.f, 0.f, 0.f};
    bf16x8 At[4][2], B0[2][2], B1[2][2];
    const char* cA = (const char*)g.A + (size_t)cur.pm * tstep; const char* cB = (const char*)g.Bt + (size_t)cur.pn * tstep;
    S.a_ready(cur);
    if constexpr (SP2) {
        PG8_STAGE(PG8_SB(0, 0), cB, voffB); PG8_STAGE(PG8_SB(0, 1), cB + hstep, voffB); PG8_STAGE(PG8_SA(0, 0), cA, voffA); PG8_STAGE(PG8_SA(0, 1), cA + hstep, voffA);
        if (wr == 1) PG8_BAR;
        PG8_WAIT_V(2); PG8_BAR;
        PG8_STAGE(PG8_SB(1, 0), cB + kstep, voffB); PG8_STAGE(PG8_SA(1, 0), cA + kstep, voffA); PG8_STAGE(PG8_SB(1, 1), cB + hstep + kstep, voffB);
        PG8_WAIT_V(6); PG8_BAR;
    } else {
        PG8_STAGE(PG8_SB(0, 0), cB, voffB); PG8_STAGE(PG8_SA(0, 0), cA, voffA); PG8_STAGE(PG8_SB(0, 1), cB + hstep, voffB); PG8_STAGE(PG8_SA(0, 1), cA + hstep, voffA);
        if (wr == 1) PG8_BAR;
        PG8_WAIT_V(4); PG8_BAR;
        PG8_STAGE(PG8_SB(1, 0), cB + kstep, voffB); PG8_STAGE(PG8_SA(1, 0), cA + kstep, voffA); PG8_STAGE(PG8_SB(1, 1), cB + hstep + kstep, voffB);
        PG8_WAIT_V(6); PG8_BAR;
    }
    for (;;) {
        const bool has_next = S.next(ui + 1, nxt);
        const char* nA = has_next ? (const char*)g.A + (size_t)nxt.pm * tstep : cA; const char* nB = has_next ? (const char*)g.Bt + (size_t)nxt.pn * tstep : cB;
        for (int t = 0; t < nt; t += 2) {
            const bool last = (t == nt - 2);
            const char* a1 = cA + (size_t)(t + 1) * kstep;
            const char* a2 = last ? nA : cA + (size_t)(t + 2) * kstep; const char* b2 = last ? nB : cB + (size_t)(t + 2) * kstep;
            const char* a3 = a2 + kstep; const char* b3 = b2 + kstep;
            if (last && has_next) S.a_ready(nxt);
            if constexpr (SP2) {
            PG8_LDB(B0, 0, 0); PG8_LDB(B1, 0, 1); PG8_SCHED; PG8_LDA(At, 0, 0); PG8_STAGE(PG8_SA(1, 1), a1 + hstep, voffA);
            PG8_WAIT_V(8); PG8_WAIT_L(0); PG8_BAR; PG8_MMA(0, 0, At, B0); PG8_MMA(0, 1, At, B1); PG8_BAR; PG8_SCHED;
            PG8_LDA(At, 0, 1); PG8_STAGE(PG8_SB(0, 0), b2, voffB); PG8_STAGE(PG8_SB(0, 1), b2 + hstep, voffB); PG8_STAGE(PG8_SA(0, 0), a2, voffA);
            PG8_WAIT_V(8); PG8_WAIT_L(0); PG8_BAR; PG8_MMA(1, 0, At, B0); PG8_MMA(1, 1, At, B1); PG8_BAR; PG8_SCHED;
            PG8_LDB(B0, 1, 0); PG8_LDB(B1, 1, 1); PG8_SCHED; PG8_LDA(At, 1, 0); PG8_STAGE(PG8_SA(0, 1), a2 + hstep, voffA);
            PG8_WAIT_V(8); PG8_WAIT_L(0); PG8_BAR; PG8_MMA(0, 0, At, B0); PG8_MMA(0, 1, At, B1); PG8_BAR; PG8_SCHED;
            PG8_LDA(At, 1, 1); PG8_STAGE(PG8_SB(1, 0), b3, voffB); PG8_STAGE(PG8_SB(1, 1), b3 + hstep, voffB); PG8_STAGE(PG8_SA(1, 0), a3, voffA);
            PG8_WAIT_V(8); PG8_WAIT_L(0); PG8_BAR; PG8_MMA(1, 0, At, B0); PG8_MMA(1, 1, At, B1); PG8_BAR; PG8_SCHED;
            } else {
            PG8_LDB(B0, 0, 0); PG8_SCHED; PG8_LDA(At, 0, 0); PG8_STAGE(PG8_SA(1, 1), a1 + hstep, voffA);
            PG8_WAIT_L(8); PG8_BAR; PG8_WAIT_L(0); PG8_MMA(0, 0, At, B0); PG8_BAR; PG8_SCHED;
            PG8_LDB(B1, 0, 1); PG8_STAGE(PG8_SB(0, 0), b2, voffB);
            PG8_BAR; PG8_WAIT_L(0); PG8_MMA(0, 1, At, B1); PG8_BAR;
            PG8_LDA(At, 0, 1); PG8_STAGE(PG8_SA(0, 0), a2, voffA);
            PG8_BAR; PG8_WAIT_L(0); PG8_MMA(1, 0, At, B0); PG8_BAR; PG8_SCHED;
            PG8_STAGE(PG8_SB(0, 1), b2 + hstep, voffB);
            PG8_WAIT_V(6); PG8_BAR; PG8_MMA(1, 1, At, B1); PG8_BAR;
            PG8_LDB(B0, 1, 0); PG8_SCHED; PG8_LDA(At, 1, 0); PG8_STAGE(PG8_SA(0, 1), a2 + hstep, voffA);
            PG8_WAIT_L(8); PG8_BAR; PG8_WAIT_L(0); PG8_MMA(0, 0, At, B0); PG8_BAR; PG8_SCHED;
            PG8_LDB(B1, 1, 1); PG8_STAGE(PG8_SB(1, 0), b3, voffB);
            PG8_BAR; PG8_WAIT_L(0); PG8_MMA(0, 1, At, B1); PG8_BAR;
            PG8_LDA(At, 1, 1); PG8_STAGE(PG8_SA(1, 0), a3, voffA);
            PG8_BAR; PG8_WAIT_L(0); PG8_MMA(1, 0, At, B0); PG8_BAR; PG8_SCHED;
            PG8_STAGE(PG8_SB(1, 1), b3 + hstep, voffB);
            PG8_WAIT_V(6); PG8_BAR; PG8_MMA(1, 1, At, B1); PG8_BAR;
            }
        }
        if constexpr (ALIGN_EPI) { if (wr == 0) PG8_BAR; }
        if constexpr (!Epi::AFTER_DRAIN) { E(acc, cur, wr, wc, fr, fq); S.done(cur); }
        if (!has_next) break;
#pragma unroll
        for (int a = 0; a < 2; ++a)
#pragma unroll
            for (int b = 0; b < 2; ++b)
#pragma unroll
                for (int m = 0; m < 4; ++m)
#pragma unroll
                    for (int n = 0; n < 2; ++n) acc[a][b][m][n] = (f32x4){0.f, 0.f, 0.f, 0.f};
        cur = nxt; cA = nA; cB = nB; ++ui;
        if constexpr (ALIGN_EPI) { if (wr == 1) PG8_BAR; }
    }
    PG8_WAIT_V(0);
    if constexpr (!ALIGN_EPI) { if (wr == 0) PG8_BAR; }
    PG8_BAR;
    if constexpr (Epi::AFTER_DRAIN) { E.fused(acc, cur, wr, wc, fr, fq, lds, wid, lane); S.done(cur); }
#undef PG8_SA
#undef PG8_SB
#undef PG8_STAGE
#undef PG8_LDA
#undef PG8_LDB
#undef PG8_MMA
#undef PG8_WAIT_V
#undef PG8_WAIT_L
#undef PG8_BAR
#undef PG8_SCHED
}
}
namespace cg = cooperative_groups;
#ifndef MK_ONE_LAUNCH
#define MK_ONE_LAUNCH 1
#endif
constexpr int NWAVES = 8, NTHREADS = 512;
constexpr int DM = 2048, SEQ = 4096, MPROMPT = 8192, NSAMP = 32, MROWS = 8224, MPAD = 8448;
constexpr int DFF = 5632, DIN = 7680, DATT = 1024, DRNN = 1024, MODW = 18432, NBROW = 34;
constexpr int ZQ = 0, ZK = 1024, ZV = 1280, ZRX = 1536, ZRG = 2560, ZGA = 3584, ZGR = 5632;
constexpr int NCHUNK = 64, TCHUNK = 64;
constexpr float EPSN = 1e-6f;
constexpr size_t O_Y = 0, O_KP = 16842752, O_VP = 16908288, O_KS = 16973824, O_VS = 16982016, O_HP = 16990208, O_HS = 16992256, O_CP = 17025024, O_CS = 17031168, O_END = 17129472;
constexpr size_t MiB = 1u << 20;
constexpr size_t WS_W13A = 0, WS_W2A = 44 * MiB, WS_W13B = 66 * MiB, WS_W2B = 110 * MiB, WS_WIN = 132 * MiB, WS_WPA = 162 * MiB, WS_WPR = 166 * MiB, WS_WOUT = 170 * MiB;
constexpr size_t WS_XN = 178 * MiB, WS_HZ = 211 * MiB, WS_X = 335 * MiB, WS_OATT = 401 * MiB, WS_ORNN = 418 * MiB, WS_MIX = 435 * MiB, WS_MOD = 468 * MiB, WS_ROPE = 471 * MiB;
constexpr size_t WS_CA = 473 * MiB, WS_CH = WS_CA + 512 * 1024, WS_END = 474 * MiB;
constexpr int LDS_BYTES = 147456;

#define LAS __attribute__((address_space(3)))
typedef unsigned short bf16;
typedef unsigned v4u __attribute__((ext_vector_type(4)));
typedef unsigned v2u __attribute__((ext_vector_type(2)));
typedef float f32x4 __attribute__((ext_vector_type(4)));
typedef float f32x16 __attribute__((ext_vector_type(16)));
typedef short bf16x8 __attribute__((ext_vector_type(8)));
#define LDS_WAIT() asm volatile("s_waitcnt lgkmcnt(0)" ::: "memory")
#define MFMA32(a, b, c) __builtin_amdgcn_mfma_f32_32x32x16_bf16((a), (b), (c), 0, 0, 0)
#define MFMA16(a, b, c) __builtin_amdgcn_mfma_f32_16x16x32_bf16((a), (b), (c), 0, 0, 0)
__device__ __forceinline__ unsigned pk2(float lo, float hi) { return pg8::cvt_pk_bf16(lo, hi); }
__device__ __forceinline__ float bflo(unsigned w) { return __uint_as_float(w << 16); }
__device__ __forceinline__ float bfhi(unsigned w) { return __uint_as_float(w & 0xffff0000u); }
__device__ __forceinline__ float bf1(bf16 h) { return __uint_as_float((unsigned)h << 16); }
__device__ __forceinline__ float fsig(float x) { return __builtin_amdgcn_rcpf(1.f + __builtin_amdgcn_exp2f(-1.44269504f * x)); }
__device__ __forceinline__ float fexp(float x) { return __builtin_amdgcn_exp2f(1.44269504f * x); }
__device__ __forceinline__ float gelu_tanh(float x) { const float t = 0.7978845608f * (x + 0.044715f * x * x * x); return x * fsig(2.f * t); }
__device__ __forceinline__ bf16x8 pack8(const float (&v)[8]) { v4u p; p.x = pk2(v[0], v[1]); p.y = pk2(v[2], v[3]); p.z = pk2(v[4], v[5]); p.w = pk2(v[6], v[7]); return __builtin_bit_cast(bf16x8, p); }
__device__ __forceinline__ float wave_sum(float v) {
#pragma unroll
    for (int o = 1; o < 64; o <<= 1) v += __shfl_xor(v, o);
    return v;
}
__device__ __forceinline__ float wave_max(float v) {
#pragma unroll
    for (int o = 1; o < 64; o <<= 1) v = fmaxf(v, __shfl_xor(v, o));
    return v;
}

struct Args { const float* in[33]; float* out; unsigned char* ws; int ph_lo, ph_hi; };

__device__ __forceinline__ void transpose_item64(const float* __restrict__ W, int N, int K, bf16* __restrict__ WT, int k0, int n0, int drow0, LAS float* scr, int lane) {
    f32x4 v[16];
#pragma unroll
    for (int i = 0; i < 16; ++i) v[i] = *(const f32x4*)(W + (size_t)(k0 + (lane >> 4) + 4 * i) * N + n0 + (lane & 15) * 4);
#pragma unroll
    for (int i = 0; i < 16; ++i) { LAS float* s = scr + ((lane >> 4) + 4 * i) * 65 + (lane & 15) * 4; s[0] = v[i].x; s[1] = v[i].y; s[2] = v[i].z; s[3] = v[i].w; }
    LDS_WAIT();
    const int c = lane & 7;
#pragma unroll
    for (int j = 0; j < 8; ++j) { const int n = (lane >> 3) + 8 * j; const LAS float* s = scr + (8 * c) * 65 + n;
        v4u o; o.x = pk2(s[0], s[65]); o.y = pk2(s[2 * 65], s[3 * 65]); o.z = pk2(s[4 * 65], s[5 * 65]); o.w = pk2(s[6 * 65], s[7 * 65]);
        *(v4u*)(WT + (size_t)(drow0 + n) * K + k0 + 8 * c) = o; }
    LDS_WAIT();
}
__device__ __forceinline__ void ada_item(const Args& A, int nb, LAS float* red, float* MOD, int tid, int wave, int lane) {
    const float* cpv = A.in[2]; const float* csv = A.in[3]; const float* W = A.in[8]; const float* bias = A.in[9];
    const int n0 = nb * 64, kq = lane >> 4, l15 = lane & 15;
    f32x4 acc[3][4];
#pragma unroll
    for (int bt = 0; bt < 3; ++bt)
#pragma unroll
        for (int nt = 0; nt < 4; ++nt) acc[bt][nt] = (f32x4){0.f, 0.f, 0.f, 0.f};
    for (int ks = 0; ks < 8; ++ks) {
        const int k0 = wave * 256 + ks * 32 + 8 * kq;
        bf16x8 af[3];
#pragma unroll
        for (int bt = 0; bt < 3; ++bt) { const int b = 16 * bt + l15; float v[8];
            if (b < NBROW) { const float* cp = (b < 2 ? cpv + (size_t)b * DM : csv + (size_t)(b - 2) * DM) + k0; const f32x4 x0 = *(const f32x4*)cp, x1 = *(const f32x4*)(cp + 4);
                v[0] = x0.x * fsig(x0.x); v[1] = x0.y * fsig(x0.y); v[2] = x0.z * fsig(x0.z); v[3] = x0.w * fsig(x0.w); v[4] = x1.x * fsig(x1.x); v[5] = x1.y * fsig(x1.y); v[6] = x1.z * fsig(x1.z); v[7] = x1.w * fsig(x1.w); }
            else {
#pragma unroll
                for (int e = 0; e < 8; ++e) v[e] = 0.f; }
            af[bt] = pack8(v); }
#pragma unroll
        for (int nt = 0; nt < 4; ++nt) { const float* wp = W + (size_t)k0 * MODW + n0 + 16 * nt + l15; float v[8];
#pragma unroll
            for (int e = 0; e < 8; ++e) v[e] = wp[(size_t)e * MODW];
            const bf16x8 bfr = pack8(v);
#pragma unroll
            for (int bt = 0; bt < 3; ++bt) acc[bt][nt] = MFMA16(af[bt], bfr, acc[bt][nt]); }
    }
#pragma unroll
    for (int bt = 0; bt < 3; ++bt)
#pragma unroll
        for (int nt = 0; nt < 4; ++nt)
#pragma unroll
            for (int r = 0; r < 4; ++r) red[(wave * 48 + bt * 16 + nt * 4 + r) * 64 + lane] = acc[bt][nt][r];
    __syncthreads();
    for (int v = tid; v < 48 * 64; v += NTHREADS) { const int ln = v & 63, q = v >> 6, bt = q >> 4, nt = (q >> 2) & 3, r = q & 3; float s = 0.f;
#pragma unroll
        for (int w = 0; w < 8; ++w) s += red[(w * 48 + q) * 64 + ln];
        const int b = 16 * bt + 4 * (ln >> 4) + r, n = n0 + 16 * nt + (ln & 15);
        if (b < NBROW) MOD[(size_t)b * MODW + n] = s + bias[n]; }
    __syncthreads();
}
__device__ __forceinline__ void p0_prologue(const Args& A, LAS unsigned char* lds, int tid, int wave, int lane) {
    unsigned char* ws = A.ws;
    const int G = gridDim.x, bx = blockIdx.x;
    { float* rope = (float*)(ws + WS_ROPE);
      for (int i = bx * NTHREADS + tid; i < 4097 * 32; i += G * NTHREADS) { const int p = i >> 5, f = i & 31; const float pos = p < 4096 ? (float)p : 16384.f;
          const float inv = exp2f(-(float)f * (13.287712379549449f / 32.f)); const float ang = pos * inv; rope[p * 64 + f] = cosf(ang); rope[p * 64 + 32 + f] = sinf(ang); } }
    for (int nb = bx; nb < MODW / 64; nb += G) ada_item(A, nb, (LAS float*)lds, (float*)(ws + WS_MOD), tid, wave, lane);
    LAS float* scr = (LAS float*)(lds + wave * 16640);
    const int gw = bx * NWAVES + wave, NGW = G * NWAVES;
#define TR_MAT(Wp, WTp, Kv, Nv, kind) { constexpr int nblk = (Nv) / 64, items = ((Kv) / 64) * nblk; if (r < items) { const int kb = r / nblk, n0 = (r % nblk) * 64; \
        const int dr = (kind) == 0 ? n0 : (256 * (n0 >> 7) + (n0 & 127) + ((kind) == 2 ? 128 : 0)); transpose_item64((Wp), (Nv), (Kv), (bf16*)(WTp), kb * 64, n0, dr, scr, lane); continue; } r -= items; }
    constexpr int TOTAL = 6 * (DM / 64) * (DFF / 64) + (DM / 64) * (DIN / 64) + 2 * (DATT / 64) * (DM / 64) + (DM / 64) * (DM / 64);
    for (int it = gw; it < TOTAL; it += NGW) {
        int r = it;
        TR_MAT(A.in[13], ws + WS_W13A, DM, DFF, 1)
        TR_MAT(A.in[14], ws + WS_W13A, DM, DFF, 2)
        TR_MAT(A.in[15], ws + WS_W2A, DFF, DM, 0)
        TR_MAT(A.in[16], ws + WS_W13B, DM, DFF, 1)
        TR_MAT(A.in[17], ws + WS_W13B, DM, DFF, 2)
        TR_MAT(A.in[18], ws + WS_W2B, DFF, DM, 0)
        TR_MAT(A.in[19], ws + WS_WIN, DM, DIN, 0)
        TR_MAT(A.in[30], ws + WS_WPA, DATT, DM, 0)
        TR_MAT(A.in[31], ws + WS_WPR, DRNN, DM, 0)
        TR_MAT(A.in[32], ws + WS_WOUT, DM, DM, 0)
    }
#undef TR_MAT
}
__device__ __forceinline__ void norm_phase(const float* xp, const float* xs, const float* g, const float* MOD, int chunk_shift, bf16* XN, int wave, int lane) {
    const int gw = blockIdx.x * NWAVES + wave, NGW = gridDim.x * NWAVES;
    for (int row = gw; row < MPAD; row += NGW) {
        v2u* o8 = (v2u*)(XN + (size_t)row * DM) + lane;
        if (row >= MROWS) {
#pragma unroll
            for (int j = 0; j < 8; ++j) o8[64 * j] = (v2u){0u, 0u};
            continue; }
        const float* xr = row < MPROMPT ? xp + (size_t)row * DM : xs + (size_t)(row - MPROMPT) * DM;
        const int br = row < MPROMPT ? (row >> 12) : (2 + row - MPROMPT);
        const float* sh = MOD + (size_t)br * MODW + chunk_shift * DM; const float* sc = sh + DM;
        f32x4 v[8]; float ss = 0.f;
#pragma unroll
        for (int j = 0; j < 8; ++j) { v[j] = *((const f32x4*)xr + lane + 64 * j); ss += (v[j].x * v[j].x + v[j].y * v[j].y) + (v[j].z * v[j].z + v[j].w * v[j].w); }
        const float rstd = rsqrtf(wave_sum(ss) * (1.f / DM) + EPSN);
#pragma unroll
        for (int j = 0; j < 8; ++j) { const int c = (lane + 64 * j) * 4; const f32x4 gg = *(const f32x4*)(g + c), s1 = *(const f32x4*)(sc + c), s0 = *(const f32x4*)(sh + c);
            const f32x4 y = (v[j] * rstd) * gg * (s1 + 1.f) + s0; o8[64 * j] = (v2u){pk2(y.x, y.y), pk2(y.z, y.w)}; }
    }
}
template <int XORD> __device__ __forceinline__ void norm_rope_row(const bf16* rowp, int hh, const float* g, const float* rp, float scale, float (&o)[4][8]) {
    float v[4][8]; float ss = 0.f;
#pragma unroll
    for (int ks = 0; ks < 4; ++ks) { const v4u w = *(const v4u*)(rowp + 8 * hh + 16 * ks);
        v[ks][0] = bflo(w.x); v[ks][1] = bfhi(w.x); v[ks][2] = bflo(w.y); v[ks][3] = bfhi(w.y); v[ks][4] = bflo(w.z); v[ks][5] = bfhi(w.z); v[ks][6] = bflo(w.w); v[ks][7] = bfhi(w.w);
#pragma unroll
        for (int e = 0; e < 8; ++e) ss += v[ks][e] * v[ks][e]; }
    ss += __shfl_xor(ss, XORD);
    const float rstd = rsqrtf(ss * (1.f / 64.f) + EPSN);
#pragma unroll
    for (int ks = 0; ks < 2; ++ks) { const int d0 = 8 * hh + 16 * ks;
        const f32x4 g0 = *(const f32x4*)(g + d0), g1 = *(const f32x4*)(g + d0 + 4), h0 = *(const f32x4*)(g + d0 + 32), h1 = *(const f32x4*)(g + d0 + 36);
        const f32x4 c0 = *(const f32x4*)(rp + d0), c1 = *(const f32x4*)(rp + d0 + 4), s0 = *(const f32x4*)(rp + 32 + d0), s1 = *(const f32x4*)(rp + 36 + d0);
#pragma unroll
        for (int e = 0; e < 8; ++e) { const float ga = e < 4 ? g0[e & 3] : g1[e & 3], gb = e < 4 ? h0[e & 3] : h1[e & 3], cc = e < 4 ? c0[e & 3] : c1[e & 3], sn = e < 4 ? s0[e & 3] : s1[e & 3];
            const float x1 = v[ks][e] * rstd * ga, x2 = v[ks + 2][e] * rstd * gb;
            o[ks][e] = (x1 * cc - x2 * sn) * scale; o[ks + 2][e] = (x2 * cc + x1 * sn) * scale; } }
}
constexpr int KS_STRIDE = 144, VT_STRIDE = 520, KS_BYTES = 256 * KS_STRIDE, VT_BYTES = 64 * VT_STRIDE;
__device__ __forceinline__ void attn_item(const Args& A, LAS unsigned char* lds, int b, int blk, int kvh, int tid, int wave, int lane) {
    unsigned char* ws = A.ws; const bf16* Z = (const bf16*)(ws + WS_HZ); const float* rope = (const float*)(ws + WS_ROPE); bf16* OATT = (bf16*)(ws + WS_OATT);
    LAS unsigned char* Ks = lds; LAS unsigned char* Vt = lds + KS_BYTES;
    {
        const int key = tid >> 1, hh = tid & 1, t = blk * 128 - 128 + key;
        if (t >= 0) {
            const bf16* zr = Z + (size_t)(b * SEQ + t) * DIN;
            float o[4][8]; norm_rope_row<1>(zr + ZK + kvh * 64, hh, A.in[21], rope + (size_t)t * 64, 1.f, o);
#pragma unroll
            for (int ks = 0; ks < 4; ++ks) *(LAS bf16x8*)(Ks + key * KS_STRIDE + (8 * hh + 16 * ks) * 2) = pack8(o[ks]);
            v4u vv[4];
#pragma unroll
            for (int i = 0; i < 4; ++i) vv[i] = *(const v4u*)(zr + ZV + kvh * 64 + 32 * hh + 8 * i);
#pragma unroll
            for (int i = 0; i < 4; ++i) { const unsigned wv[4] = {vv[i].x, vv[i].y, vv[i].z, vv[i].w};
#pragma unroll
                for (int e = 0; e < 4; ++e) { const int d = 32 * hh + 8 * i + 2 * e;
                    *(LAS bf16*)(Vt + d * VT_STRIDE + key * 2) = (bf16)(wv[e] & 0xffffu); *(LAS bf16*)(Vt + (d + 1) * VT_STRIDE + key * 2) = (bf16)(wv[e] >> 16); } }
            if (blk == SEQ / 128 - 1 && key >= 128) {
                float* kp = A.out + O_KP + ((size_t)(b * 128 + key - 128) * 4 + kvh) * 64; float* vp = A.out + O_VP + ((size_t)(b * 128 + key - 128) * 4 + kvh) * 64;
#pragma unroll
                for (int ks = 0; ks < 4; ++ks) { *(f32x4*)(kp + 8 * hh + 16 * ks) = (f32x4){o[ks][0], o[ks][1], o[ks][2], o[ks][3]}; *(f32x4*)(kp + 8 * hh + 16 * ks + 4) = (f32x4){o[ks][4], o[ks][5], o[ks][6], o[ks][7]}; }
#pragma unroll
                for (int i = 0; i < 4; ++i) { *(f32x4*)(vp + 32 * hh + 8 * i) = (f32x4){bflo(vv[i].x), bfhi(vv[i].x), bflo(vv[i].y), bfhi(vv[i].y)}; *(f32x4*)(vp + 32 * hh + 8 * i + 4) = (f32x4){bflo(vv[i].z), bfhi(vv[i].z), bflo(vv[i].w), bfhi(vv[i].w)}; }
            }
        } else {
#pragma unroll
            for (int ks = 0; ks < 4; ++ks) *(LAS v4u*)(Ks + key * KS_STRIDE + (8 * hh + 16 * ks) * 2) = (v4u){0u, 0u, 0u, 0u};
#pragma unroll
            for (int d = 0; d < 32; ++d) *(LAS bf16*)(Vt + (32 * hh + d) * VT_STRIDE + key * 2) = (bf16)0;
        }
    }
    __syncthreads();
    const int g = wave >> 1, head = kvh * 4 + g, hh = lane >> 5, l31 = lane & 31;
    const float sink = A.in[22][head];
#pragma unroll 1
    for (int qt = 0; qt < 2; ++qt) {
        const int i0 = (wave & 1) * 64 + 32 * qt, qi = i0 + l31, t = blk * 128 + qi; const size_t row = (size_t)b * SEQ + t;
        bf16x8 qf[4];
        { float o[4][8]; norm_rope_row<32>(Z + row * DIN + ZQ + head * 64, hh, A.in[20], rope + (size_t)t * 64, 0.125f, o);
#pragma unroll
          for (int ks = 0; ks < 4; ++ks) qf[ks] = pack8(o[ks]); }
        const int kt0 = i0 >> 5;
        f32x16 s[5];
#pragma unroll
        for (int kk = 0; kk < 5; ++kk) {
#pragma unroll
            for (int r = 0; r < 16; ++r) s[kk][r] = 0.f;
#pragma unroll
            for (int ks = 0; ks < 4; ++ks) { const bf16x8 kf = *(const LAS bf16x8*)(Ks + (32 * (kt0 + kk) + l31) * KS_STRIDE + (8 * hh + 16 * ks) * 2); s[kk] = MFMA32(kf, qf[ks], s[kk]); } }
        float mx = sink;
#pragma unroll
        for (int kk = 0; kk < 5; ++kk)
#pragma unroll
            for (int r = 0; r < 16; ++r) { const int j = 32 * (kt0 + kk) + 8 * (r >> 2) + 4 * hh + (r & 3); const bool ok = (j > qi) && (j <= qi + 128) && (blk > 0 || j >= 128);
                s[kk][r] = ok ? s[kk][r] : -INFINITY; mx = fmaxf(mx, s[kk][r]); }
        mx = fmaxf(mx, __shfl_xor(mx, 32));
        float l = 0.f;
#pragma unroll
        for (int kk = 0; kk < 5; ++kk)
#pragma unroll
            for (int r = 0; r < 16; ++r) { const float p = fexp(s[kk][r] - mx); s[kk][r] = p; l += p; }
        l += __shfl_xor(l, 32);
        const float inv = 1.f / (l + fexp(sink - mx));
        f32x16 oacc[2];
#pragma unroll
        for (int dt = 0; dt < 2; ++dt)
#pragma unroll
            for (int r = 0; r < 16; ++r) oacc[dt][r] = 0.f;
#pragma unroll
        for (int kk = 0; kk < 5; ++kk)
#pragma unroll
            for (int s2 = 0; s2 < 2; ++s2) { float pv[8];
#pragma unroll
                for (int e = 0; e < 8; ++e) pv[e] = s[kk][8 * s2 + e];
                const bf16x8 pf = pack8(pv);
#pragma unroll
                for (int dt = 0; dt < 2; ++dt) { const LAS unsigned char* vp = Vt + (32 * dt + l31) * VT_STRIDE + (32 * (kt0 + kk) + 16 * s2 + 4 * hh) * 2;
                    const v2u lo = *(const LAS v2u*)vp, hi = *(const LAS v2u*)(vp + 16); const v4u a4 = (v4u){lo.x, lo.y, hi.x, hi.y};
                    oacc[dt] = MFMA32(__builtin_bit_cast(bf16x8, a4), pf, oacc[dt]); } }
        bf16* op = OATT + row * DATT + head * 64;
#pragma unroll
        for (int dt = 0; dt < 2; ++dt)
#pragma unroll
            for (int g4 = 0; g4 < 4; ++g4) *(v2u*)(op + 32 * dt + 8 * g4 + 4 * hh) = (v2u){pk2(oacc[dt][4 * g4] * inv, oacc[dt][4 * g4 + 1] * inv), pk2(oacc[dt][4 * g4 + 2] * inv, oacc[dt][4 * g4 + 3] * inv)};
    }
    __syncthreads();
}
__device__ __forceinline__ void attn_sample_item(const Args& A, LAS float* wl  , int bs, int head, int lane) {
    unsigned char* ws = A.ws; const bf16* Z = (const bf16*)(ws + WS_HZ); const float* rp = (const float*)(ws + WS_ROPE) + (size_t)4096 * 64; bf16* OATT = (bf16*)(ws + WS_OATT);
    const int kvh = head >> 2, d = lane, f = d & 31; const size_t row = MPROMPT + bs;
    const bf16* zr = Z + row * DIN;
    const float cs = rp[f], sn = rp[32 + f];
    float q = bf1(zr[ZQ + head * 64 + d]); { const float rstd = rsqrtf(wave_sum(q * q) * (1.f / 64.f) + EPSN); q = q * rstd * A.in[20][d]; const float qo = __shfl_xor(q, 32); q = (d < 32 ? q * cs - qo * sn : q * cs + qo * sn) * 0.125f; }
    float kn = bf1(zr[ZK + kvh * 64 + d]); { const float rstd = rsqrtf(wave_sum(kn * kn) * (1.f / 64.f) + EPSN); kn = kn * rstd * A.in[21][d]; const float ko = __shfl_xor(kn, 32); kn = d < 32 ? kn * cs - ko * sn : kn * cs + ko * sn; }
    const float vn = bf1(zr[ZV + kvh * 64 + d]);
    if ((head & 3) == 0) { A.out[O_KS + ((size_t)bs * 4 + kvh) * 64 + d] = kn; A.out[O_VS + ((size_t)bs * 4 + kvh) * 64 + d] = vn; }
    const float snew = wave_sum(q * kn);
    wl[d] = q; LDS_WAIT();
    const float* ck = A.in[4] + (size_t)bs * 128 * 256 + kvh * 64; const float* cv = A.in[5] + (size_t)bs * 128 * 256 + kvh * 64;
    float s0 = 0.f, s1 = 0.f;
    { const float* k0 = ck + (size_t)lane * 256; const float* k1 = ck + (size_t)(lane + 64) * 256;
#pragma unroll
      for (int i = 0; i < 16; ++i) { const f32x4 qv = *(const LAS f32x4*)(wl + 4 * i), a = *(const f32x4*)(k0 + 4 * i), c = *(const f32x4*)(k1 + 4 * i);
          s0 += (qv.x * a.x + qv.y * a.y) + (qv.z * a.z + qv.w * a.w); s1 += (qv.x * c.x + qv.y * c.y) + (qv.z * c.z + qv.w * c.w); } }
    if (lane == 0) s0 = snew;
    const float sink = A.in[22][head];
    const float mx = fmaxf(wave_max(fmaxf(s0, s1)), sink);
    const float p0 = fexp(s0 - mx), p1 = fexp(s1 - mx);
    const float inv = 1.f / (wave_sum(p0 + p1) + fexp(sink - mx));
    wl[64 + lane] = p0; wl[128 + lane] = p1; LDS_WAIT();
    float o = wl[64] * vn;
#pragma unroll 8
    for (int j = 1; j < 128; ++j) o += wl[64 + j] * cv[(size_t)j * 256 + d];
    OATT[row * DATT + head * 64 + d] = (bf16)(pk2(o * inv, 0.f) & 0xffffu);
    LDS_WAIT();
}
template <bool FINAL> __device__ __forceinline__ void rnn_item(const Args& A, LAS float* xcs  , int b, int c, int wave, int lane) {
    unsigned char* ws = A.ws; const bf16* Z = (const bf16*)(ws + WS_HZ); bf16* ORNN = (bf16*)(ws + WS_ORNN); float* CA = (float*)(ws + WS_CA); float* CH = (float*)(ws + WS_CH);
    const int hh = lane >> 5, l31 = lane & 31, t00 = c * TCHUNK;
#pragma unroll 1
    for (int hb2 = 0; hb2 < 2; ++hb2) {
        const int hb = 2 * wave + hb2, ch = hb * 64 + lane;
        {
            const float cw0 = A.in[23][ch], cw1 = A.in[23][DRNN + ch], cw2 = A.in[23][2 * DRNN + ch], cw3 = A.in[23][3 * DRNN + ch], cb = A.in[24][ch];
            const bf16* zc = Z + (size_t)b * SEQ * DIN + ZRX + ch;
            float x3 = t00 >= 3 ? bf1(zc[(size_t)(t00 - 3) * DIN]) : 0.f, x2 = t00 >= 2 ? bf1(zc[(size_t)(t00 - 2) * DIN]) : 0.f, x1 = t00 >= 1 ? bf1(zc[(size_t)(t00 - 1) * DIN]) : 0.f;
#pragma unroll 8
            for (int k = 0; k < TCHUNK; ++k) { const float x0 = bf1(zc[(size_t)(t00 + k) * DIN]); xcs[k * 65 + lane] = cb + cw3 * x0 + cw2 * x1 + cw1 * x2 + cw0 * x3; x3 = x2; x2 = x1; x1 = x0; }
            if (FINAL && c == NCHUNK - 1) { A.out[O_CP + ((size_t)b * 3 + 0) * DRNN + ch] = x3; A.out[O_CP + ((size_t)b * 3 + 1) * DRNN + ch] = x2; A.out[O_CP + ((size_t)b * 3 + 2) * DRNN + ch] = x1; }
        }
        LDS_WAIT();
#pragma unroll 1
        for (int nt = 0; nt < 2; ++nt) {
            const int j = hb * 64 + 32 * nt + l31;
            bf16x8 wf[2][4];
#pragma unroll
            for (int gt = 0; gt < 2; ++gt) { const float* wg = A.in[gt == 0 ? 25 : 27] + (size_t)hb * 4096 + 32 * nt + l31;
#pragma unroll
                for (int ks = 0; ks < 4; ++ks) { float v[8];
#pragma unroll
                    for (int e = 0; e < 8; ++e) v[e] = wg[(8 * hh + 16 * ks + e) * 64];
                    wf[gt][ks] = pack8(v); } }
            const float brg = A.in[26][j], big = A.in[28][j], sp = log1pf(expf(-A.in[29][j]));
            float H = 0.f, Ap = 1.f;
            if (FINAL) { for (int cc = 0; cc < c; ++cc) { const size_t o = ((size_t)b * NCHUNK + cc) * DRNN + j; H = CA[o] * H + CH[o]; } }
#pragma unroll 1
            for (int tt = 0; tt < 2; ++tt) {
                const int t0 = t00 + 32 * tt;
                f32x16 ar, ai;
#pragma unroll
                for (int r = 0; r < 16; ++r) { ar[r] = 0.f; ai[r] = 0.f; }
#pragma unroll
                for (int ks = 0; ks < 4; ++ks) { float v[8];
#pragma unroll
                    for (int e = 0; e < 8; ++e) v[e] = xcs[(32 * tt + l31) * 65 + 8 * hh + 16 * ks + e];
                    const bf16x8 af = pack8(v); ar = MFMA32(af, wf[0][ks], ar); ai = MFMA32(af, wf[1][ks], ai); }
                float rgv[16];
                if (FINAL) {
#pragma unroll
                    for (int r = 0; r < 16; ++r) { const int tk = 8 * (r >> 2) + 4 * hh + (r & 3); rgv[r] = bf1(Z[((size_t)b * SEQ + t0 + tk) * DIN + ZRG + j]); } }
#pragma unroll
                for (int r = 0; r < 16; ++r) { const int tk = 8 * (r >> 2) + 4 * hh + (r & 3);
                    const float rg_ = fsig(ar[r] + brg), ig_ = fsig(ai[r] + big); const float la = -8.f * rg_ * sp; const float a = fexp(la);
                    const float mult = sqrtf(fmaxf(-expm1f(2.f * la), 0.f)); ar[r] = a; ai[r] = mult * ig_ * xcs[(32 * tt + tk) * 65 + 32 * nt + l31]; }
                float Hs[4];
#pragma unroll
                for (int g4 = 0; g4 < 4; ++g4) { float Aa = 1.f, U = 0.f;
#pragma unroll
                    for (int r4 = 0; r4 < 4; ++r4) { const float a = ar[4 * g4 + r4]; U = a * U + ai[4 * g4 + r4]; Aa *= a; }
                    const float pA = __shfl_xor(Aa, 32), pU = __shfl_xor(U, 32);
                    const float A0 = hh == 0 ? Aa : pA, U0 = hh == 0 ? U : pU, A1 = hh == 0 ? pA : Aa, U1 = hh == 0 ? pU : U;
                    const float Hs0 = H; H = A0 * H + U0; const float Hs1 = H; H = A1 * H + U1; Hs[g4] = hh == 0 ? Hs0 : Hs1; Ap *= A0 * A1; }
                if (FINAL) {
#pragma unroll
                    for (int g4 = 0; g4 < 4; ++g4) { float h = Hs[g4];
#pragma unroll
                        for (int r4 = 0; r4 < 4; ++r4) { const int r = 4 * g4 + r4, tk = 8 * g4 + 4 * hh + r4; h = ar[r] * h + ai[r];
                            ORNN[((size_t)b * SEQ + t0 + tk) * DRNN + j] = (bf16)(pk2(h * gelu_tanh(rgv[r]), 0.f) & 0xffffu); } } }
            }
            if (!FINAL) { if (hh == 0) { const size_t o = ((size_t)b * NCHUNK + c) * DRNN + j; CA[o] = Ap; CH[o] = H; } }
            else if (c == NCHUNK - 1 && hh == 0) A.out[O_HP + (size_t)b * DRNN + j] = H;
        }
        LDS_WAIT();
    }
}
__device__ __forceinline__ void rnn_sample_item(const Args& A, int bs, int hb, int lane) {
    unsigned char* ws = A.ws; const bf16* Z = (const bf16*)(ws + WS_HZ); bf16* ORNN = (bf16*)(ws + WS_ORNN);
    const int ch = hb * 64 + lane; const size_t row = MPROMPT + bs;
    const float* sc = A.in[7] + (size_t)bs * 3 * DRNN + ch; const float b0 = sc[0], b1 = sc[DRNN], b2 = sc[2 * DRNN];
    const float rx = bf1(Z[row * DIN + ZRX + ch]), rg = bf1(Z[row * DIN + ZRG + ch]);
    const float xc = A.in[24][ch] + A.in[23][ch] * b0 + A.in[23][DRNN + ch] * b1 + A.in[23][2 * DRNN + ch] * b2 + A.in[23][3 * DRNN + ch] * rx;
    const float* wr = A.in[25] + (size_t)hb * 4096 + lane; const float* wi = A.in[27] + (size_t)hb * 4096 + lane;
    float ar = A.in[26][ch], ai = A.in[28][ch];
#pragma unroll 16
    for (int i = 0; i < 64; ++i) { const float xi = __shfl(xc, i); ar += xi * wr[i * 64]; ai += xi * wi[i * 64]; }
    const float rg_ = fsig(ar), ig_ = fsig(ai), la = -8.f * rg_ * log1pf(expf(-A.in[29][ch])), a = expf(la), mult = sqrtf(fmaxf(-expm1f(2.f * la), 0.f));
    const float h = a * A.in[6][(size_t)bs * DRNN + ch] + mult * ig_ * xc;
    A.out[O_HS + (size_t)bs * DRNN + ch] = h;
    ORNN[row * DRNN + ch] = (bf16)(pk2(h * gelu_tanh(rg), 0.f) & 0xffffu);
    float* co = A.out + O_CS + (size_t)bs * 3 * DRNN + ch; co[0] = b1; co[DRNN] = b2; co[2 * DRNN] = rx;
}

__global__ void __launch_bounds__(NTHREADS, 2) mk_fwd(Args args) {
    extern __shared__ __attribute__((aligned(16))) unsigned char lds_raw[];
    LAS unsigned char* lds = (LAS unsigned char*)lds_raw;
    const int tid = threadIdx.x, lane = tid & 63, wave = __builtin_amdgcn_readfirstlane(tid >> 6);
    const int G = gridDim.x, bx = blockIdx.x;
    unsigned char* ws = args.ws;
    const int lo = args.ph_lo, hi = args.ph_hi;
    bf16* XN = (bf16*)(ws + WS_XN); bf16* HB = (bf16*)(ws + WS_HZ); bf16* ZB = (bf16*)(ws + WS_HZ); float* XB = (float*)(ws + WS_X); float* MOD = (float*)(ws + WS_MOD);
    bf16* OATT = (bf16*)(ws + WS_OATT); bf16* ORNN = (bf16*)(ws + WS_ORNN); bf16* MIX = (bf16*)(ws + WS_MIX);
#ifndef PH_MASK
#define PH_MASK 0x1fff
#endif
#define IN(k) (((PH_MASK >> (k)) & 1) && lo <= (k) && (k) < hi)
#define SEAM(k) do { if (IN(k) && IN((k) + 1)) { __threadfence(); cg::this_grid().sync(); } } while (0)

    if (IN(0)) { p0_prologue(args, lds, tid, wave, lane); } SEAM(0);
    if (IN(1)) { norm_phase(args.in[0], args.in[1], args.in[10], MOD, 0, XN, wave, lane); } SEAM(1);
    if (IN(2)) { pg8::Gemm g{XN, (const bf16*)(ws + WS_W13A), MPAD, 2 * DFF, DM}; pg8::StaticOrder S; S.init(MPAD, 2 * DFF, G, bx); pg8::EpiSwiGLU E{HB, DFF};
        pg8::gemm_phase<pg8::EpiSwiGLU, pg8::StaticOrder, true, true>(lds, g, S, E); } SEAM(2);
    if (IN(3)) { pg8::Gemm g{HB, (const bf16*)(ws + WS_W2A), MPAD, DM, DFF}; pg8::StaticOrder S; S.init(MPAD, DM, G, bx); pg8::EpiRes E{args.in[0], args.in[1], XB, MOD + 2 * DM, 0.5f};
        pg8::gemm_phase<pg8::EpiRes, pg8::StaticOrder, true, true>(lds, g, S, E); } SEAM(3);
    if (IN(4)) { norm_phase(XB, XB + (size_t)MPROMPT * DM, args.in[11], MOD, 3, XN, wave, lane); } SEAM(4);
    if (IN(5)) { pg8::Gemm g{XN, (const bf16*)(ws + WS_WIN), MPAD, DIN, DM}; pg8::StaticOrder S; S.init(MPAD, DIN, G, bx); pg8::EpiBf16<0> E{ZB, DIN, nullptr, 0, 0, 1.f};
        pg8::gemm_phase<pg8::EpiBf16<0>, pg8::StaticOrder, true, true>(lds, g, S, E); } SEAM(5);
    if (IN(6)) {
#ifndef NO_ATTN
        for (int it = bx; it < 256; it += G) attn_item(args, lds, it >> 7, (it >> 2) & 31, it & 3, tid, wave, lane);
#endif
#ifndef NO_RNN
        for (int it = bx; it < 2 * NCHUNK; it += G) rnn_item<false>(args, (LAS float*)(lds + wave * 16640), it / NCHUNK, it % NCHUNK, wave, lane);
#endif
        __syncthreads();
#ifndef NO_SATTN
        for (int it = (G - 1 - bx) * NWAVES + wave; it < NSAMP * 16; it += G * NWAVES) attn_sample_item(args, (LAS float*)(lds + wave * 768), it >> 4, it & 15, lane);
#endif
    } SEAM(6);
    if (IN(7)) {
        for (int it = bx; it < 2 * NCHUNK; it += G) rnn_item<true>(args, (LAS float*)(lds + wave * 16640), it / NCHUNK, it % NCHUNK, wave, lane);
        for (int it = (G - 1 - bx) * NWAVES + wave; it < NSAMP * 16; it += G * NWAVES) rnn_sample_item(args, it >> 4, it & 15, lane);
        __syncthreads();
        pg8::Gemm g{OATT, (const bf16*)(ws + WS_WPA), MPAD, DM, DATT}; pg8::StaticOrder S; S.init(MPAD, DM, G, bx); pg8::EpiGateMix<false> E{MIX, ZB + ZGA};
        pg8::gemm_phase<pg8::EpiGateMix<false>, pg8::StaticOrder, true, true>(lds, g, S, E); } SEAM(7);
    if (IN(8)) { pg8::Gemm g{ORNN, (const bf16*)(ws + WS_WPR), MPAD, DM, DRNN}; pg8::StaticOrder S; S.init(MPAD, DM, G, bx); pg8::EpiGateMix<true> E{MIX, ZB + ZGR};
        pg8::gemm_phase<pg8::EpiGateMix<true>, pg8::StaticOrder, true, true>(lds, g, S, E); } SEAM(8);
    if (IN(9)) { pg8::Gemm g{MIX, (const bf16*)(ws + WS_WOUT), MPAD, DM, DM}; pg8::StaticOrder S; S.init(MPAD, DM, G, bx); pg8::EpiRes E{XB, XB + (size_t)MPROMPT * DM, XB, MOD + 5 * DM, 1.f};
        pg8::gemm_phase<pg8::EpiRes, pg8::StaticOrder, true, true>(lds, g, S, E); } SEAM(9);
    if (IN(10)) { norm_phase(XB, XB + (size_t)MPROMPT * DM, args.in[12], MOD, 6, XN, wave, lane); } SEAM(10);
    if (IN(11)) { pg8::Gemm g{XN, (const bf16*)(ws + WS_W13B), MPAD, 2 * DFF, DM}; pg8::StaticOrder S; S.init(MPAD, 2 * DFF, G, bx); pg8::EpiSwiGLU E{HB, DFF};
        pg8::gemm_phase<pg8::EpiSwiGLU, pg8::StaticOrder, true, true>(lds, g, S, E); } SEAM(11);
    if (IN(12)) { pg8::Gemm g{HB, (const bf16*)(ws + WS_W2B), MPAD, DM, DFF}; pg8::StaticOrder S; S.init(MPAD, DM, G, bx); pg8::EpiRes E{XB, XB + (size_t)MPROMPT * DM, args.out + O_Y, MOD + 8 * DM, 0.5f};
        pg8::gemm_phase<pg8::EpiRes, pg8::StaticOrder, true, true>(lds, g, S, E); }
#undef IN
#undef SEAM
}

extern "C" void kernel_launch(void* const* d_in, const int* in_sizes, int n_in, void* d_out, int out_size, void* d_ws, size_t ws_size, hipStream_t stream) {
    static int grid = 0;
    if (grid == 0) {
        if (n_in != 33 || out_size != (int)O_END || ws_size < WS_END) { fprintf(stderr, "kernel_launch: unexpected shapes: n_in %d out %d ws %zu\n", n_in, out_size, ws_size); grid = -1; return; }
        int dev = 0, cus = 0, per_cu = 0;
        hipGetDevice(&dev); hipDeviceGetAttribute(&cus, hipDeviceAttributeMultiprocessorCount, dev);
        hipFuncSetAttribute((const void*)mk_fwd, hipFuncAttributeMaxDynamicSharedMemorySize, LDS_BYTES);
        hipOccupancyMaxActiveBlocksPerMultiprocessor(&per_cu, (const void*)mk_fwd, NTHREADS, LDS_BYTES);
        if (per_cu < 1) { fprintf(stderr, "kernel_launch: occupancy query says %d blocks per CU\n", per_cu); grid = -1; return; }
        grid = cus;
    }
    if (grid < 0) return;
    Args a{};
    for (int i = 0; i < 33; ++i) a.in[i] = (const float*)d_in[i];
    a.out = (float*)d_out; a.ws = (unsigned char*)d_ws;
#if MK_ONE_LAUNCH
    a.ph_lo = 0; a.ph_hi = 13;
    void* kargs[] = {&a};
    hipError_t e = hipLaunchCooperativeKernel((const void*)mk_fwd, dim3(grid), dim3(NTHREADS), kargs, LDS_BYTES, stream);
    if (e != hipSuccess) fprintf(stderr, "cooperative launch failed: %s (grid %d)\n", hipGetErrorString(e), grid);
#else
    for (int p = 0; p < 13; ++p) { a.ph_lo = p; a.ph_hi = p + 1; hipLaunchKernelGGL(mk_fwd, dim3(grid), dim3(NTHREADS), LDS_BYTES, stream, a); }
#endif
}
```

```cpp
#include <hip/hip_runtime.h>
#include <hip/hip_cooperative_groups.h>
#include <cstdio>
#include <cstdint>
#include <cmath>
namespace pg8 {
#define PG8_LAS __attribute__((address_space(3)))
typedef unsigned short bf16_t;
typedef short bf16x8 __attribute__((ext_vector_type(8)));
typedef float f32x4 __attribute__((ext_vector_type(4)));
typedef unsigned u32x4 __attribute__((ext_vector_type(4)));
constexpr int BM = 256, BK = 64, HALF = 128, HTB = HALF * BK * 2  , STAGE_BYTES = 8 * HTB, NXCD = 8, WGM = 8;

__host__ __device__ __forceinline__ int lds_byte(int r, int c) { const int st = (r >> 4) * 2 + (c >> 5), rr = r & 15, cc = c & 31, ob = rr * 64 + cc * 2; return st * 1024 + (ob ^ (((ob >> 9) & 1) << 5)); }
__host__ __device__ __forceinline__ void stage_rc(int b, int& R, int& C) { const int st = b / 1024, sb = b % 1024, swz = sb ^ (((sb >> 9) & 1) << 5); R = (st >> 1) * 16 + swz / 64; C = (st & 1) * 32 + (swz % 64) / 2; }
__host__ __device__ __forceinline__ int perm32(int rho) { const int n = rho >> 4, i = rho & 15; return 8 * (i >> 2) + 4 * n + (i & 3); }

struct Unit { int pm, pn; };
struct Gemm { const bf16_t* A; const bf16_t* Bt; int M, N, K; };

struct StaticOrder {
    int nM, nN, nwg, G, c;
    __host__ __device__ void init(int M, int N, int G_, int c_) { nM = M / BM; nN = N / BM; nwg = nM * nN; G = G_; c = c_; }
    __host__ __device__ bool next(int i, Unit& u) const {
        const long L = (long)i * G + c; if (L >= nwg) return false;
        int wgid = (int)L; { const int q = nwg / NXCD, r = nwg % NXCD, xcd = wgid % NXCD, off = wgid / NXCD; wgid = (xcd < r ? xcd * (q + 1) : r * (q + 1) + (xcd - r) * q) + off; }
        const int nig = WGM * nN, gid = wgid / nig, fm = gid * WGM, gsz = (nM - fm) < WGM ? (nM - fm) : WGM;
        u.pm = fm + ((wgid % nig) % gsz); u.pn = (wgid % nig) / gsz; return true;
    }
    __device__ __forceinline__ void a_ready(const Unit&) const {}
    __device__ __forceinline__ void done(const Unit&) const {}
};

__device__ __forceinline__ unsigned cvt_pk_bf16(float lo, float hi) { unsigned r; asm volatile("v_cvt_pk_bf16_f32 %0, %1, %2" : "=v"(r) : "v"(lo), "v"(hi)); return r; }
typedef float f32x2 __attribute__((ext_vector_type(2)));
__device__ __forceinline__ f32x2 gelu_pk(f32x2 v) {
    const f32x2 av = __builtin_elementwise_abs(v), d = av * 0.2316418882f + 1.0f;
    f32x2 t; t.x = __builtin_amdgcn_rcpf(d.x); t.y = __builtin_amdgcn_rcpf(d.y);
    f32x2 q = t * 0.5307027145f + (-0.7265760135f); q = q * t + 0.7107068705f; q = q * t + (-0.142248368f); q = q * t + 0.127414796f; q = q * t;
    const f32x2 s = (v * v) * (-0.72134752044f);
    f32x2 e; e.x = __builtin_amdgcn_exp2f(s.x); e.y = __builtin_amdgcn_exp2f(s.y);
    const f32x2 m = v * (q * e), r = v - m;
    f32x2 o; o.x = v.x < 0.f ? m.x : r.x; o.y = v.y < 0.f ? m.y : r.y; return o;
}

template <int ACT  > struct EpiBf16 {
    static constexpr bool PERM = true, AFTER_DRAIN = false; static_assert(ACT == 0 || ACT == 1, "EpiBf16: ACT is 0 (none) or 1 (gelu_pk)");
    bf16_t* O; int ldc; const float* bias; int split_cols; size_t split_stride; float scale0;
    __device__ __forceinline__ void operator()(const f32x4 (&acc)[2][2][4][2], const Unit& u, int wr, int wc, int fr, int fq) const {
        const int row0 = u.pm * BM + wr * 64 + fr; int colt = u.pn * BM; bf16_t* base = O;
        float sc = 1.f; if (split_cols) { const int t = colt / split_cols; base += (size_t)t * split_stride; colt -= t * split_cols; if (t == 0) sc = scale0; }
        const int col0 = colt + wc * 32 + 8 * fq, bcol0 = u.pn * BM + wc * 32 + 8 * fq;
        f32x4 bv[2][2];
#pragma unroll
        for (int bj = 0; bj < 2; ++bj)
#pragma unroll
            for (int n = 0; n < 2; ++n) bv[bj][n] = bias ? *(const f32x4*)(bias + bcol0 + bj * HALF + 4 * n) : (f32x4){0.f, 0.f, 0.f, 0.f};
#pragma unroll
        for (int ai = 0; ai < 2; ++ai)
#pragma unroll
            for (int m = 0; m < 4; ++m) { bf16_t* rowp = base + (size_t)(row0 + ai * HALF + m * 16) * ldc + col0;
#pragma unroll
                for (int bj = 0; bj < 2; ++bj) { f32x4 v0 = acc[ai][bj][m][0] + bv[bj][0], v1 = acc[ai][bj][m][1] + bv[bj][1];
                    if (ACT == 1) { f32x2 a = gelu_pk((f32x2){v0[0], v0[1]}), b = gelu_pk((f32x2){v0[2], v0[3]}), c = gelu_pk((f32x2){v1[0], v1[1]}), d = gelu_pk((f32x2){v1[2], v1[3]});
                        v0 = (f32x4){a.x, a.y, b.x, b.y}; v1 = (f32x4){c.x, c.y, d.x, d.y}; }
                    v0 = v0 * sc; v1 = v1 * sc; u32x4 w; w.x = cvt_pk_bf16(v0[0], v0[1]); w.y = cvt_pk_bf16(v0[2], v0[3]); w.z = cvt_pk_bf16(v1[0], v1[1]); w.w = cvt_pk_bf16(v1[2], v1[3]);
                    *(u32x4*)(rowp + bj * HALF) = w; } }
    }
};
constexpr int MROWS_VALID = 8224, MROWS_PROMPT = 8192;
__device__ __forceinline__ float fsigmoid(float x) { return __builtin_amdgcn_rcpf(1.f + __builtin_amdgcn_exp2f(-1.44269504f * x)); }
__device__ __forceinline__ float fsilu(float x) { return x * fsigmoid(x); }
__device__ __forceinline__ float bflo(unsigned w) { return __uint_as_float(w << 16); }
__device__ __forceinline__ float bfhi(unsigned w) { return __uint_as_float(w & 0xffff0000u); }

struct EpiSwiGLU {
    static constexpr bool PERM = true, AFTER_DRAIN = false;
    bf16_t* O; int ldc;
    __device__ __forceinline__ void operator()(const f32x4 (&acc)[2][2][4][2], const Unit& u, int wr, int wc, int fr, int fq) const {
        const int row0 = u.pm * BM + wr * 64 + fr, col0 = u.pn * HALF + wc * 32 + 8 * fq;
#pragma unroll
        for (int ai = 0; ai < 2; ++ai)
#pragma unroll
            for (int m = 0; m < 4; ++m) {
                bf16_t* p = O + (size_t)(row0 + ai * HALF + m * 16) * ldc + col0;
                const f32x4 a0 = acc[ai][0][m][0], a1 = acc[ai][0][m][1], b0 = acc[ai][1][m][0], b1 = acc[ai][1][m][1];
                u32x4 w;
                w.x = cvt_pk_bf16(fsilu(a0[0]) * b0[0], fsilu(a0[1]) * b0[1]); w.y = cvt_pk_bf16(fsilu(a0[2]) * b0[2], fsilu(a0[3]) * b0[3]);
                w.z = cvt_pk_bf16(fsilu(a1[0]) * b1[0], fsilu(a1[1]) * b1[1]); w.w = cvt_pk_bf16(fsilu(a1[2]) * b1[2], fsilu(a1[3]) * b1[3]);
                *(u32x4*)p = w;
            }
    }
};
struct EpiRes {
    static constexpr bool PERM = false, AFTER_DRAIN = false;
    const float* base_p; const float* base_s; float* out; const float* gate; float gs;
    __device__ __forceinline__ void operator()(const f32x4 (&acc)[2][2][4][2], const Unit& u, int wr, int wc, int fr, int fq) const {
        const int col0 = u.pn * BM + wc * 32 + 4 * fq;
#pragma unroll
        for (int ai = 0; ai < 2; ++ai)
#pragma unroll
            for (int m = 0; m < 4; ++m) {
                const int row = u.pm * BM + ai * HALF + wr * 64 + m * 16 + fr;
                if (row < MROWS_VALID) {
                    const int br = row < MROWS_PROMPT ? (row >> 12) : (2 + row - MROWS_PROMPT);
                    const float* bp = row < MROWS_PROMPT ? base_p + (size_t)row * 2048 : base_s + (size_t)(row - MROWS_PROMPT) * 2048;
                    const float* gp = gate + (size_t)br * 18432; float* op = out + (size_t)row * 2048;
#pragma unroll
                    for (int bj = 0; bj < 2; ++bj)
#pragma unroll
                        for (int n = 0; n < 2; ++n) { const int c = col0 + bj * HALF + n * 16;
                            const f32x4 g = *(const f32x4*)(gp + c), b = *(const f32x4*)(bp + c);
                            *(f32x4*)(op + c) = b + (g * gs) * acc[ai][bj][m][n]; }
                }
            }
    }
};
template <bool ACCUM> struct EpiGateMix {
    static constexpr bool PERM = true, AFTER_DRAIN = false;
    bf16_t* O; const bf16_t* Zg;
    __device__ __forceinline__ void operator()(const f32x4 (&acc)[2][2][4][2], const Unit& u, int wr, int wc, int fr, int fq) const {
        const int row0 = u.pm * BM + wr * 64 + fr, col0 = u.pn * BM + wc * 32 + 8 * fq;
#pragma unroll
        for (int ai = 0; ai < 2; ++ai)
#pragma unroll
            for (int m = 0; m < 4; ++m) { const int row = row0 + ai * HALF + m * 16;
#pragma unroll
                for (int bj = 0; bj < 2; ++bj) { const int c = col0 + bj * HALF;
                    const u32x4 gz = *(const u32x4*)(Zg + (size_t)row * 7680 + c);
                    bf16_t* op = O + (size_t)row * 2048 + c;
                    const f32x4 v0 = acc[ai][bj][m][0], v1 = acc[ai][bj][m][1];
                    float r0 = fsigmoid(bflo(gz.x)) * v0[0], r1 = fsigmoid(bfhi(gz.x)) * v0[1], r2 = fsigmoid(bflo(gz.y)) * v0[2], r3 = fsigmoid(bfhi(gz.y)) * v0[3];
                    float r4 = fsigmoid(bflo(gz.z)) * v1[0], r5 = fsigmoid(bfhi(gz.z)) * v1[1], r6 = fsigmoid(bflo(gz.w)) * v1[2], r7 = fsigmoid(bfhi(gz.w)) * v1[3];
                    if (ACCUM) { const u32x4 pv = *(const u32x4*)op;
                        r0 += bflo(pv.x); r1 += bfhi(pv.x); r2 += bflo(pv.y); r3 += bfhi(pv.y); r4 += bflo(pv.z); r5 += bfhi(pv.z); r6 += bflo(pv.w); r7 += bfhi(pv.w); }
                    u32x4 w; w.x = cvt_pk_bf16(r0, r1); w.y = cvt_pk_bf16(r2, r3); w.z = cvt_pk_bf16(r4, r5); w.w = cvt_pk_bf16(r6, r7);
                    *(u32x4*)op = w; }
            }
    }
};
template <class Epi, class Sched, bool ALIGN_EPI = false, bool SP2 = false>
__device__ __forceinline__ void gemm_phase(PG8_LAS unsigned char* lds, const Gemm g, const Sched& S, const Epi& E) {
    const int tid = threadIdx.x, wid = __builtin_amdgcn_readfirstlane(tid >> 6), lane = tid & 63, wr = wid >> 2, wc = wid & 3, fr = lane & 15, fq = lane >> 4;
    const int K = g.K, nt = K / BK;
    unsigned voffA[2], voffB[2];
#pragma unroll
    for (int i = 0; i < 2; ++i) { int R, C; stage_rc(tid * 16 + i * 8192, R, C); const int Rb = Epi::PERM ? ((R & ~31) + perm32(R & 31)) : R;
        voffA[i] = (unsigned)(R * K + C) * 2u; voffB[i] = (unsigned)(Rb * K + C) * 2u; }
    const size_t kstep = (size_t)(BK * 2);
    const size_t hstep = (size_t)HALF * K * 2;
    const size_t tstep = 2 * hstep;
    const unsigned ldsw = (unsigned)wid * 1024u;
    const int aoff = lds_byte(wr * 64 + fr, fq * 8), boff = lds_byte(wc * 32 + fr, fq * 8);
#define PG8_SA(b, h) (((b) * 2 + (h)) * HTB)
#define PG8_SB(b, h) ((4 + (b) * 2 + (h)) * HTB)
#define PG8_STAGE(bufoff, gbase, voff) do { _Pragma("unroll") for (int _i = 0; _i < 2; ++_i) \
        __builtin_amdgcn_global_load_lds((const unsigned*)((const char*)(gbase) + (voff)[_i]), (PG8_LAS unsigned*)(lds + (bufoff) + ldsw + _i * 8192), 16, 0, 0); } while (0)
#define PG8_LDA(dst, b, h) do { _Pragma("unroll") for (int m = 0; m < 4; ++m) _Pragma("unroll") for (int k = 0; k < 2; ++k) dst[m][k] = *(const PG8_LAS bf16x8*)(lds + PG8_SA(b, h) + aoff + m * 2048 + k * 1024); } while (0)
#define PG8_LDB(dst, b, h) do { _Pragma("unroll") for (int n = 0; n < 2; ++n) _Pragma("unroll") for (int k = 0; k < 2; ++k) dst[n][k] = *(const PG8_LAS bf16x8*)(lds + PG8_SB(b, h) + boff + n * 2048 + k * 1024); } while (0)
#define PG8_MMA(ai, bj, At, Bt) do { __builtin_amdgcn_s_setprio(1); _Pragma("unroll") for (int m = 0; m < 4; ++m) _Pragma("unroll") for (int n = 0; n < 2; ++n) _Pragma("unroll") for (int k = 0; k < 2; ++k) \
        acc[ai][bj][m][n] = __builtin_amdgcn_mfma_f32_16x16x32_bf16(Bt[n][k], At[m][k], acc[ai][bj][m][n], 0, 0, 0); __builtin_amdgcn_s_setprio(0); } while (0)
#define PG8_WAIT_V(n) asm volatile("s_waitcnt vmcnt(" #n ")" ::: "memory")
#define PG8_WAIT_L(n) asm volatile("s_waitcnt lgkmcnt(" #n ")" ::: "memory")
#define PG8_BAR __builtin_amdgcn_s_barrier()
#define PG8_SCHED __builtin_amdgcn_sched_barrier(0)
    Unit cur, nxt; int ui = 0;
    if (!S.next(0, cur)) return;
    f32x4 acc[2][2][4][2];
#pragma unroll
    for (int a = 0; a < 2; ++a)
#pragma unroll
        for (int b = 0; b < 2; ++b)
#pragma unroll
            for (int m = 0; m < 4; ++m)
#pragma unroll
                for (int n = 0; n < 2; ++n) acc[a][b][m][n] = (f32x4){0.f, 0.f, 0.f, 0.f};
    bf16x8 At[4][2], B0[2][2], B1[2][2];
    const char* cA = (const char*)g.A + (size_t)cur.pm * tstep; const char* cB = (const char*)g.Bt + (size_t)cur.pn * tstep;
    S.a_ready(cur);
    if constexpr (SP2) {
        PG8_STAGE(PG8_SB(0, 0), cB, voffB); PG8_STAGE(PG8_SB(0, 1), cB + hstep, voffB); PG8_STAGE(PG8_SA(0, 0), cA, voffA); PG8_STAGE(PG8_SA(0, 1), cA + hstep, voffA);
        if (wr == 1) PG8_BAR;
        PG8_WAIT_V(2); PG8_BAR;
        PG8_STAGE(PG8_SB(1, 0), cB + kstep, voffB); PG8_STAGE(PG8_SA(1, 0), cA + kstep, voffA); PG8_STAGE(PG8_SB(1, 1), cB + hstep + kstep, voffB);
        PG8_WAIT_V(6); PG8_BAR;
    } else {
        PG8_STAGE(PG8_SB(0, 0), cB, voffB); PG8_STAGE(PG8_SA(0, 0), cA, voffA); PG8_STAGE(PG8_SB(0, 1), cB + hstep, voffB); PG8_STAGE(PG8_SA(0, 1), cA + hstep, voffA);
        if (wr == 1) PG8_BAR;
        PG8_WAIT_V(4); PG8_BAR;
        PG8_STAGE(PG8_SB(1, 0), cB + kstep, voffB); PG8_STAGE(PG8_SA(1, 0), cA + kstep, voffA); PG8_STAGE(PG8_SB(1, 1), cB + hstep + kstep, voffB);
        PG8_WAIT_V(6); PG8_BAR;
    }
    for (;;) {
        const bool has_next = S.next(ui + 1, nxt);
        const char* nA = has_next ? (const char*)g.A + (size_t)nxt.pm * tstep : cA; const char* nB = has_next ? (const char*)g.Bt + (size_t)nxt.pn * tstep : cB;
        for (int t = 0; t < nt; t += 2) {
            const bool last = (t == nt - 2);
            const char* a1 = cA + (size_t)(t + 1) * kstep;
            const char* a2 = last ? nA : cA + (size_t)(t + 2) * kstep; const char* b2 = last ? nB : cB + (size_t)(t + 2) * kstep;
            const char* a3 = a2 + kstep; const char* b3 = b2 + kstep;
            if (last && has_next) S.a_ready(nxt);
            if constexpr (SP2) {
            PG8_LDB(B0, 0, 0); PG8_LDB(B1, 0, 1); PG8_SCHED; PG8_LDA(At, 0, 0); PG8_STAGE(PG8_SA(1, 1), a1 + hstep, voffA);
            PG8_WAIT_V(8); PG8_WAIT_L(0); PG8_BAR; PG8_MMA(0, 0, At, B0); PG8_MMA(0, 1, At, B1); PG8_BAR; PG8_SCHED;
            PG8_LDA(At, 0, 1); PG8_STAGE(PG8_SB(0, 0), b2, voffB); PG8_STAGE(PG8_SB(0, 1), b2 + hstep, voffB); PG8_STAGE(PG8_SA(0, 0), a2, voffA);
            PG8_WAIT_V(8); PG8_WAIT_L(0); PG8_BAR; PG8_MMA(1, 0, At, B0); PG8_MMA(1, 1, At, B1); PG8_BAR; PG8_SCHED;
            PG8_LDB(B0, 1, 0); PG8_LDB(B1, 1, 1); PG8_SCHED; PG8_LDA(At, 1, 0); PG8_STAGE(PG8_SA(0, 1), a2 + hstep, voffA);
            PG8_WAIT_V(8); PG8_WAIT_L(0); PG8_BAR; PG8_MMA(0, 0, At, B0); PG8_MMA(0, 1, At, B1); PG8_BAR; PG8_SCHED;
            PG8_LDA(At, 1, 1); PG8_STAGE(PG8_SB(1, 0), b3, voffB); PG8_STAGE(PG8_SB(1, 1), b3 + hstep, voffB); PG8_STAGE(PG8_SA(1, 0), a3, voffA);
            PG8_WAIT_V(8); PG8_WAIT_L(0); PG8_BAR; PG8_MMA(1, 0, At, B0); PG8_MMA(1, 1, At, B1); PG8_BAR; PG8_SCHED;
            } else {
            PG8_LDB(B0, 0, 0); PG8_SCHED; PG8_LDA(At, 0, 0); PG8_STAGE(PG8_SA(1, 1), a1 + hstep, voffA);
            PG8_WAIT_L(8); PG8_BAR; PG8_WAIT_L(0); PG8_MMA(0, 0, At, B0); PG8_BAR; PG8_SCHED;
            PG8_LDB(B1, 0, 1); PG8_STAGE(PG8_SB(0, 0), b2, voffB);
            PG8_BAR; PG8_WAIT_L(0); PG8_MMA(0, 1, At, B1); PG8_BAR;
            PG8_LDA(At, 0, 1); PG8_STAGE(PG8_SA(0, 0), a2, voffA);
            PG8_BAR; PG8_WAIT_L(0); PG8_MMA(1, 0, At, B0); PG8_BAR; PG8_SCHED;
            PG8_STAGE(PG8_SB(0, 1), b2 + hstep, voffB);
            PG8_WAIT_V(6); PG8_BAR; PG8_MMA(1, 1, At, B1); PG8_BAR;
            PG8_LDB(B0, 1, 0); PG8_SCHED; PG8_LDA(At, 1, 0); PG8_STAGE(PG8_SA(0, 1), a2 + hstep, voffA);
            PG8_WAIT_L(8); PG8_BAR; PG8_WAIT_L(0); PG8_MMA(0, 0, At, B0); PG8_BAR; PG8_SCHED;
            PG8_LDB(B1, 1, 1); PG8_STAGE(PG8_SB(1, 0), b3, voffB);
            PG8_BAR; PG8_WAIT_L(0); PG8_MMA(0, 1, At, B1); PG8_BAR;
            PG8_LDA(At, 1, 1); PG8_STAGE(PG8_SA(1, 0), a3, voffA);
            PG8_BAR; PG8_WAIT_L(0); PG8_MMA(1, 0, At, B0); PG8_BAR; PG8_SCHED;
            PG8_STAGE(PG8_SB(1, 1), b3 + hstep, voffB);
            PG8_WAIT_V(6); PG8_BAR; PG8_MMA(1, 1, At, B1); PG8_BAR;
            }
        }
        if constexpr (ALIGN_EPI) { if (wr == 0) PG8_BAR; }
        if constexpr (!Epi::AFTER_DRAIN) { E(acc, cur, wr, wc, fr, fq); S.done(cur); }
        if (!has_next) break;
#pragma unroll
        for (int a = 0; a < 2; ++a)
#pragma unroll
            for (int b = 0; b < 2; ++b)
#pragma unroll
                for (int m = 0; m < 4; ++m)
#pragma unroll
                    for (int n = 0; n < 2; ++n) acc[a][b][m][n] = (f32x4){0.f, 0.f, 0.f, 0.f};
        cur = nxt; cA = nA; cB = nB; ++ui;
        if constexpr (ALIGN_EPI) { if (wr == 1) PG8_BAR; }
    }
    PG8_WAIT_V(0);
    if constexpr (!ALIGN_EPI) { if (wr == 0) PG8_BAR; }
    PG8_BAR;
    if constexpr (Epi::AFTER_DRAIN) { E.fused(acc, cur, wr, wc, fr, fq, lds, wid, lane); S.done(cur); }
#undef PG8_SA
#undef PG8_SB
#undef PG8_STAGE
#undef PG8_LDA
#undef PG8_LDB
#undef PG8_MMA
#undef PG8_WAIT_V
#undef PG8_WAIT_L
#undef PG8_BAR
#undef PG8_SCHED
}
}
namespace cg = cooperative_groups;
#ifndef MK_ONE_LAUNCH
#define MK_ONE_LAUNCH 1
#endif
constexpr int NWAVES = 8, NTHREADS = 512;
constexpr int DM = 2048, SEQ = 4096, MPROMPT = 8192, NSAMP = 32, MROWS = 8224, MPAD = 8448;
constexpr int DFF = 5632, DIN = 7680, DATT = 1024, DRNN = 1024, MODW = 18432, NBROW = 34;
constexpr int ZQ = 0, ZK = 1024, ZV = 1280, ZRX = 1536, ZRG = 2560, ZGA = 3584, ZGR = 5632;
constexpr int NCHUNK = 64, TCHUNK = 64;
constexpr float EPSN = 1e-6f;
constexpr size_t O_Y = 0, O_KP = 16842752, O_VP = 16908288, O_KS = 16973824, O_VS = 16982016, O_HP = 16990208, O_HS = 16992256, O_CP = 17025024, O_CS = 17031168, O_END = 17129472;
constexpr size_t MiB = 1u << 20;
constexpr size_t WS_W13A = 0, WS_W2A = 44 * MiB, WS_W13B = 66 * MiB, WS_W2B = 110 * MiB, WS_WIN = 132 * MiB, WS_WPA = 162 * MiB, WS_WPR = 166 * MiB, WS_WOUT = 170 * MiB;
constexpr size_t WS_XN = 178 * MiB, WS_HZ = 211 * MiB, WS_X = 335 * MiB, WS_OATT = 401 * MiB, WS_ORNN = 418 * MiB, WS_MIX = 435 * MiB, WS_MOD = 468 * MiB, WS_ROPE = 471 * MiB;
constexpr size_t WS_CA = 473 * MiB, WS_CH = WS_CA + 512 * 1024, WS_BAR = 474 * MiB, WS_END = 475 * MiB;
constexpr int MISC_OFF = 147456 - 64;
constexpr int LDS_BYTES = 147456;

#define LAS __attribute__((address_space(3)))
typedef unsigned short bf16;
typedef unsigned v4u __attribute__((ext_vector_type(4)));
typedef unsigned v2u __attribute__((ext_vector_type(2)));
typedef float f32x4 __attribute__((ext_vector_type(4)));
typedef float f32x16 __attribute__((ext_vector_type(16)));
typedef short bf16x8 __attribute__((ext_vector_type(8)));
#define LDS_WAIT() asm volatile("s_waitcnt lgkmcnt(0)" ::: "memory")
#define MFMA32(a, b, c) __builtin_amdgcn_mfma_f32_32x32x16_bf16((a), (b), (c), 0, 0, 0)
#define MFMA16(a, b, c) __builtin_amdgcn_mfma_f32_16x16x32_bf16((a), (b), (c), 0, 0, 0)
__device__ __forceinline__ unsigned pk2(float lo, float hi) { return pg8::cvt_pk_bf16(lo, hi); }
__device__ __forceinline__ float bflo(unsigned w) { return __uint_as_float(w << 16); }
__device__ __forceinline__ float bfhi(unsigned w) { return __uint_as_float(w & 0xffff0000u); }
__device__ __forceinline__ float bf1(bf16 h) { return __uint_as_float((unsigned)h << 16); }
__device__ __forceinline__ float fsig(float x) { return __builtin_amdgcn_rcpf(1.f + __builtin_amdgcn_exp2f(-1.44269504f * x)); }
__device__ __forceinline__ float fexp(float x) { return __builtin_amdgcn_exp2f(1.44269504f * x); }
__device__ __forceinline__ float gelu_tanh(float x) { const float t = 0.7978845608f * (x + 0.044715f * x * x * x); return x * fsig(2.f * t); }
__device__ __forceinline__ bf16x8 pack8(const float (&v)[8]) { v4u p; p.x = pk2(v[0], v[1]); p.y = pk2(v[2], v[3]); p.z = pk2(v[4], v[5]); p.w = pk2(v[6], v[7]); return __builtin_bit_cast(bf16x8, p); }
__device__ __forceinline__ float wave_sum(float v) {
#pragma unroll
    for (int o = 1; o < 64; o <<= 1) v += __shfl_xor(v, o);
    return v;
}
__device__ __forceinline__ float wave_max(float v) {
#pragma unroll
    for (int o = 1; o < 64; o <<= 1) v = fmaxf(v, __shfl_xor(v, o));
    return v;
}

struct Args { const float* in[33]; float* out; unsigned char* ws; int ph_lo, ph_hi; };

__device__ __forceinline__ void transpose_item64(const float* __restrict__ W, int N, int K, bf16* __restrict__ WT, int k0, int n0, int drow0, LAS float* scr, int lane) {
    f32x4 v[16];
#pragma unroll
    for (int i = 0; i < 16; ++i) v[i] = *(const f32x4*)(W + (size_t)(k0 + (lane >> 4) + 4 * i) * N + n0 + (lane & 15) * 4);
#pragma unroll
    for (int i = 0; i < 16; ++i) { LAS float* s = scr + ((lane >> 4) + 4 * i) * 65 + (lane & 15) * 4; s[0] = v[i].x; s[1] = v[i].y; s[2] = v[i].z; s[3] = v[i].w; }
    LDS_WAIT();
    const int c = lane & 7;
#pragma unroll
    for (int j = 0; j < 8; ++j) { const int n = (lane >> 3) + 8 * j; const LAS float* s = scr + (8 * c) * 65 + n;
        v4u o; o.x = pk2(s[0], s[65]); o.y = pk2(s[2 * 65], s[3 * 65]); o.z = pk2(s[4 * 65], s[5 * 65]); o.w = pk2(s[6 * 65], s[7 * 65]);
        *(v4u*)(WT + (size_t)(drow0 + n) * K + k0 + 8 * c) = o; }
    LDS_WAIT();
}
__device__ __forceinline__ void ada_item(const Args& A, int nb, LAS float* red, float* MOD, int tid, int wave, int lane) {
    const float* cpv = A.in[2]; const float* csv = A.in[3]; const float* W = A.in[8]; const float* bias = A.in[9];
    const int n0 = nb * 64, kq = lane >> 4, l15 = lane & 15;
    f32x4 acc[3][4];
#pragma unroll
    for (int bt = 0; bt < 3; ++bt)
#pragma unroll
        for (int nt = 0; nt < 4; ++nt) acc[bt][nt] = (f32x4){0.f, 0.f, 0.f, 0.f};
    for (int ks = 0; ks < 8; ++ks) {
        const int k0 = wave * 256 + ks * 32 + 8 * kq;
        bf16x8 af[3];
#pragma unroll
        for (int bt = 0; bt < 3; ++bt) { const int b = 16 * bt + l15; float v[8];
            if (b < NBROW) { const float* cp = (b < 2 ? cpv + (size_t)b * DM : csv + (size_t)(b - 2) * DM) + k0; const f32x4 x0 = *(const f32x4*)cp, x1 = *(const f32x4*)(cp + 4);
                v[0] = x0.x * fsig(x0.x); v[1] = x0.y * fsig(x0.y); v[2] = x0.z * fsig(x0.z); v[3] = x0.w * fsig(x0.w); v[4] = x1.x * fsig(x1.x); v[5] = x1.y * fsig(x1.y); v[6] = x1.z * fsig(x1.z); v[7] = x1.w * fsig(x1.w); }
            else {
#pragma unroll
                for (int e = 0; e < 8; ++e) v[e] = 0.f; }
            af[bt] = pack8(v); }
#pragma unroll
        for (int nt = 0; nt < 4; ++nt) { const float* wp = W + (size_t)k0 * MODW + n0 + 16 * nt + l15; float v[8];
#pragma unroll
            for (int e = 0; e < 8; ++e) v[e] = wp[(size_t)e * MODW];
            const bf16x8 bfr = pack8(v);
#pragma unroll
            for (int bt = 0; bt < 3; ++bt) acc[bt][nt] = MFMA16(af[bt], bfr, acc[bt][nt]); }
    }
#pragma unroll
    for (int bt = 0; bt < 3; ++bt)
#pragma unroll
        for (int nt = 0; nt < 4; ++nt)
#pragma unroll
            for (int r = 0; r < 4; ++r) red[(wave * 48 + bt * 16 + nt * 4 + r) * 64 + lane] = acc[bt][nt][r];
    __syncthreads();
    for (int v = tid; v < 48 * 64; v += NTHREADS) { const int ln = v & 63, q = v >> 6, bt = q >> 4, nt = (q >> 2) & 3, r = q & 3; float s = 0.f;
#pragma unroll
        for (int w = 0; w < 8; ++w) s += red[(w * 48 + q) * 64 + ln];
        const int b = 16 * bt + 4 * (ln >> 4) + r, n = n0 + 16 * nt + (ln & 15);
        if (b < NBROW) MOD[(size_t)b * MODW + n] = s + bias[n]; }
    __syncthreads();
}
__device__ __forceinline__ void p0_prologue(const Args& A, LAS unsigned char* lds, int tid, int wave, int lane) {
    unsigned char* ws = A.ws;
    const int G = gridDim.x, bx = blockIdx.x;
    { float* rope = (float*)(ws + WS_ROPE);
      for (int i = bx * NTHREADS + tid; i < 4097 * 32; i += G * NTHREADS) { const int p = i >> 5, f = i & 31; const float pos = p < 4096 ? (float)p : 16384.f;
          const float inv = exp2f(-(float)f * (13.287712379549449f / 32.f)); const float ang = pos * inv; rope[p * 64 + f] = cosf(ang); rope[p * 64 + 32 + f] = sinf(ang); } }
    for (int nb = bx; nb < MODW / 64; nb += G) ada_item(A, nb, (LAS float*)lds, (float*)(ws + WS_MOD), tid, wave, lane);
    LAS float* scr = (LAS float*)(lds + wave * 16640);
    const int gw = bx * NWAVES + wave, NGW = G * NWAVES;
#define TR_MAT(Wp, WTp, Kv, Nv, kind) { constexpr int nblk = (Nv) / 64, items = ((Kv) / 64) * nblk; if (r < items) { const int kb = r / nblk, n0 = (r % nblk) * 64; \
        const int dr = (kind) == 0 ? n0 : (256 * (n0 >> 7) + (n0 & 127) + ((kind) == 2 ? 128 : 0)); transpose_item64((Wp), (Nv), (Kv), (bf16*)(WTp), kb * 64, n0, dr, scr, lane); continue; } r -= items; }
    constexpr int TOTAL = 6 * (DM / 64) * (DFF / 64) + (DM / 64) * (DIN / 64) + 2 * (DATT / 64) * (DM / 64) + (DM / 64) * (DM / 64);
    for (int it = gw; it < TOTAL; it += NGW) {
        int r = it;
        TR_MAT(A.in[13], ws + WS_W13A, DM, DFF, 1)
        TR_MAT(A.in[14], ws + WS_W13A, DM, DFF, 2)
        TR_MAT(A.in[15], ws + WS_W2A, DFF, DM, 0)
        TR_MAT(A.in[16], ws + WS_W13B, DM, DFF, 1)
        TR_MAT(A.in[17], ws + WS_W13B, DM, DFF, 2)
        TR_MAT(A.in[18], ws + WS_W2B, DFF, DM, 0)
        TR_MAT(A.in[19], ws + WS_WIN, DM, DIN, 0)
        TR_MAT(A.in[30], ws + WS_WPA, DATT, DM, 0)
        TR_MAT(A.in[31], ws + WS_WPR, DRNN, DM, 0)
        TR_MAT(A.in[32], ws + WS_WOUT, DM, DM, 0)
    }
#undef TR_MAT
}
__device__ __forceinline__ void norm_phase(const float* xp, const float* xs, const float* g, const float* MOD, int chunk_shift, bf16* XN, int wave, int lane) {
    const int gw = blockIdx.x * NWAVES + wave, NGW = gridDim.x * NWAVES;
    for (int row = gw; row < MPAD; row += NGW) {
        v2u* o8 = (v2u*)(XN + (size_t)row * DM) + lane;
        if (row >= MROWS) {
#pragma unroll
            for (int j = 0; j < 8; ++j) o8[64 * j] = (v2u){0u, 0u};
            continue; }
        const float* xr = row < MPROMPT ? xp + (size_t)row * DM : xs + (size_t)(row - MPROMPT) * DM;
        const int br = row < MPROMPT ? (row >> 12) : (2 + row - MPROMPT);
        const float* sh = MOD + (size_t)br * MODW + chunk_shift * DM; const float* sc = sh + DM;
        f32x4 v[8]; float ss = 0.f;
#pragma unroll
        for (int j = 0; j < 8; ++j) { v[j] = *((const f32x4*)xr + lane + 64 * j); ss += (v[j].x * v[j].x + v[j].y * v[j].y) + (v[j].z * v[j].z + v[j].w * v[j].w); }
        const float rstd = rsqrtf(wave_sum(ss) * (1.f / DM) + EPSN);
#pragma unroll
        for (int j = 0; j < 8; ++j) { const int c = (lane + 64 * j) * 4; const f32x4 gg = *(const f32x4*)(g + c), s1 = *(const f32x4*)(sc + c), s0 = *(const f32x4*)(sh + c);
            const f32x4 y = (v[j] * rstd) * gg * (s1 + 1.f) + s0; o8[64 * j] = (v2u){pk2(y.x, y.y), pk2(y.z, y.w)}; }
    }
}
template <int XORD> __device__ __forceinline__ void norm_rope_row(const bf16* rowp, int hh, const float* g, const float* rp, float scale, float (&o)[4][8]) {
    float v[4][8]; float ss = 0.f;
#pragma unroll
    for (int ks = 0; ks < 4; ++ks) { const v4u w = *(const v4u*)(rowp + 8 * hh + 16 * ks);
        v[ks][0] = bflo(w.x); v[ks][1] = bfhi(w.x); v[ks][2] = bflo(w.y); v[ks][3] = bfhi(w.y); v[ks][4] = bflo(w.z); v[ks][5] = bfhi(w.z); v[ks][6] = bflo(w.w); v[ks][7] = bfhi(w.w);
#pragma unroll
        for (int e = 0; e < 8; ++e) ss += v[ks][e] * v[ks][e]; }
    ss += __shfl_xor(ss, XORD);
    const float rstd = rsqrtf(ss * (1.f / 64.f) + EPSN);
#pragma unroll
    for (int ks = 0; ks < 2; ++ks) { const int d0 = 8 * hh + 16 * ks;
        const f32x4 g0 = *(const f32x4*)(g + d0), g1 = *(const f32x4*)(g + d0 + 4), h0 = *(const f32x4*)(g + d0 + 32), h1 = *(const f32x4*)(g + d0 + 36);
        const f32x4 c0 = *(const f32x4*)(rp + d0), c1 = *(const f32x4*)(rp + d0 + 4), s0 = *(const f32x4*)(rp + 32 + d0), s1 = *(const f32x4*)(rp + 36 + d0);
#pragma unroll
        for (int e = 0; e < 8; ++e) { const float ga = e < 4 ? g0[e & 3] : g1[e & 3], gb = e < 4 ? h0[e & 3] : h1[e & 3], cc = e < 4 ? c0[e & 3] : c1[e & 3], sn = e < 4 ? s0[e & 3] : s1[e & 3];
            const float x1 = v[ks][e] * rstd * ga, x2 = v[ks + 2][e] * rstd * gb;
            o[ks][e] = (x1 * cc - x2 * sn) * scale; o[ks + 2][e] = (x2 * cc + x1 * sn) * scale; } }
}
constexpr int KS_STRIDE = 144, VT_STRIDE = 520, KS_BYTES = 256 * KS_STRIDE, VT_BYTES = 64 * VT_STRIDE;
__device__ __forceinline__ void attn_item(const Args& A, LAS unsigned char* lds, int b, int blk, int kvh, int tid, int wave, int lane) {
    unsigned char* ws = A.ws; const bf16* Z = (const bf16*)(ws + WS_HZ); const float* rope = (const float*)(ws + WS_ROPE); bf16* OATT = (bf16*)(ws + WS_OATT);
    LAS unsigned char* Ks = lds; LAS unsigned char* Vt = lds + KS_BYTES;
    {
        const int key = tid >> 1, hh = tid & 1, t = blk * 128 - 128 + key;
        if (t >= 0) {
            const bf16* zr = Z + (size_t)(b * SEQ + t) * DIN;
            float o[4][8]; norm_rope_row<1>(zr + ZK + kvh * 64, hh, A.in[21], rope + (size_t)t * 64, 1.f, o);
#pragma unroll
            for (int ks = 0; ks < 4; ++ks) *(LAS bf16x8*)(Ks + key * KS_STRIDE + (8 * hh + 16 * ks) * 2) = pack8(o[ks]);
            v4u vv[4];
#pragma unroll
            for (int i = 0; i < 4; ++i) vv[i] = *(const v4u*)(zr + ZV + kvh * 64 + 32 * hh + 8 * i);
#pragma unroll
            for (int i = 0; i < 4; ++i) { const unsigned wv[4] = {vv[i].x, vv[i].y, vv[i].z, vv[i].w};
#pragma unroll
                for (int e = 0; e < 4; ++e) { const int d = 32 * hh + 8 * i + 2 * e;
                    *(LAS bf16*)(Vt + d * VT_STRIDE + key * 2) = (bf16)(wv[e] & 0xffffu); *(LAS bf16*)(Vt + (d + 1) * VT_STRIDE + key * 2) = (bf16)(wv[e] >> 16); } }
            if (blk == SEQ / 128 - 1 && key >= 128) {
                float* kp = A.out + O_KP + ((size_t)(b * 128 + key - 128) * 4 + kvh) * 64; float* vp = A.out + O_VP + ((size_t)(b * 128 + key - 128) * 4 + kvh) * 64;
#pragma unroll
                for (int ks = 0; ks < 4; ++ks) { *(f32x4*)(kp + 8 * hh + 16 * ks) = (f32x4){o[ks][0], o[ks][1], o[ks][2], o[ks][3]}; *(f32x4*)(kp + 8 * hh + 16 * ks + 4) = (f32x4){o[ks][4], o[ks][5], o[ks][6], o[ks][7]}; }
#pragma unroll
                for (int i = 0; i < 4; ++i) { *(f32x4*)(vp + 32 * hh + 8 * i) = (f32x4){bflo(vv[i].x), bfhi(vv[i].x), bflo(vv[i].y), bfhi(vv[i].y)}; *(f32x4*)(vp + 32 * hh + 8 * i + 4) = (f32x4){bflo(vv[i].z), bfhi(vv[i].z), bflo(vv[i].w), bfhi(vv[i].w)}; }
            }
        } else {
#pragma unroll
            for (int ks = 0; ks < 4; ++ks) *(LAS v4u*)(Ks + key * KS_STRIDE + (8 * hh + 16 * ks) * 2) = (v4u){0u, 0u, 0u, 0u};
#pragma unroll
            for (int d = 0; d < 32; ++d) *(LAS bf16*)(Vt + (32 * hh + d) * VT_STRIDE + key * 2) = (bf16)0;
        }
    }
    __syncthreads();
    const int g = wave >> 1, head = kvh * 4 + g, hh = lane >> 5, l31 = lane & 31;
    const float sink = A.in[22][head];
#pragma unroll 1
    for (int qt = 0; qt < 2; ++qt) {
        const int i0 = (wave & 1) * 64 + 32 * qt, qi = i0 + l31, t = blk * 128 + qi; const size_t row = (size_t)b * SEQ + t;
        bf16x8 qf[4];
        { float o[4][8]; norm_rope_row<32>(Z + row * DIN + ZQ + head * 64, hh, A.in[20], rope + (size_t)t * 64, 0.125f, o);
#pragma unroll
          for (int ks = 0; ks < 4; ++ks) qf[ks] = pack8(o[ks]); }
        const int kt0 = i0 >> 5;
        f32x16 s[5];
#pragma unroll
        for (int kk = 0; kk < 5; ++kk) {
#pragma unroll
            for (int r = 0; r < 16; ++r) s[kk][r] = 0.f;
#pragma unroll
            for (int ks = 0; ks < 4; ++ks) { const bf16x8 kf = *(const LAS bf16x8*)(Ks + (32 * (kt0 + kk) + l31) * KS_STRIDE + (8 * hh + 16 * ks) * 2); s[kk] = MFMA32(kf, qf[ks], s[kk]); } }
        float mx = sink;
#pragma unroll
        for (int kk = 0; kk < 5; ++kk)
#pragma unroll
            for (int r = 0; r < 16; ++r) { const int j = 32 * (kt0 + kk) + 8 * (r >> 2) + 4 * hh + (r & 3); const bool ok = (j > qi) && (j <= qi + 128) && (blk > 0 || j >= 128);
                s[kk][r] = ok ? s[kk][r] : -INFINITY; mx = fmaxf(mx, s[kk][r]); }
        mx = fmaxf(mx, __shfl_xor(mx, 32));
        float l = 0.f;
#pragma unroll
        for (int kk = 0; kk < 5; ++kk)
#pragma unroll
            for (int r = 0; r < 16; ++r) { const float p = fexp(s[kk][r] - mx); s[kk][r] = p; l += p; }
        l += __shfl_xor(l, 32);
        const float inv = 1.f / (l + fexp(sink - mx));
        f32x16 oacc[2];
#pragma unroll
        for (int dt = 0; dt < 2; ++dt)
#pragma unroll
            for (int r = 0; r < 16; ++r) oacc[dt][r] = 0.f;
#pragma unroll
        for (int kk = 0; kk < 5; ++kk)
#pragma unroll
            for (int s2 = 0; s2 < 2; ++s2) { float pv[8];
#pragma unroll
                for (int e = 0; e < 8; ++e) pv[e] = s[kk][8 * s2 + e];
                const bf16x8 pf = pack8(pv);
#pragma unroll
                for (int dt = 0; dt < 2; ++dt) { const LAS unsigned char* vp = Vt + (32 * dt + l31) * VT_STRIDE + (32 * (kt0 + kk) + 16 * s2 + 4 * hh) * 2;
                    const v2u lo = *(const LAS v2u*)vp, hi = *(const LAS v2u*)(vp + 16); const v4u a4 = (v4u){lo.x, lo.y, hi.x, hi.y};
                    oacc[dt] = MFMA32(__builtin_bit_cast(bf16x8, a4), pf, oacc[dt]); } }
        bf16* op = OATT + row * DATT + head * 64;
#pragma unroll
        for (int dt = 0; dt < 2; ++dt)
#pragma unroll
            for (int g4 = 0; g4 < 4; ++g4) *(v2u*)(op + 32 * dt + 8 * g4 + 4 * hh) = (v2u){pk2(oacc[dt][4 * g4] * inv, oacc[dt][4 * g4 + 1] * inv), pk2(oacc[dt][4 * g4 + 2] * inv, oacc[dt][4 * g4 + 3] * inv)};
    }
    __syncthreads();
}
__device__ __forceinline__ void attn_sample_item(const Args& A, LAS float* wl  , int bs, int head, int lane) {
    unsigned char* ws = A.ws; const bf16* Z = (const bf16*)(ws + WS_HZ); const float* rp = (const float*)(ws + WS_ROPE) + (size_t)4096 * 64; bf16* OATT = (bf16*)(ws + WS_OATT);
    const int kvh = head >> 2, d = lane, f = d & 31; const size_t row = MPROMPT + bs;
    const bf16* zr = Z + row * DIN;
    const float cs = rp[f], sn = rp[32 + f];
    float q = bf1(zr[ZQ + head * 64 + d]); { const float rstd = rsqrtf(wave_sum(q * q) * (1.f / 64.f) + EPSN); q = q * rstd * A.in[20][d]; const float qo = __shfl_xor(q, 32); q = (d < 32 ? q * cs - qo * sn : q * cs + qo * sn) * 0.125f; }
    float kn = bf1(zr[ZK + kvh * 64 + d]); { const float rstd = rsqrtf(wave_sum(kn * kn) * (1.f / 64.f) + EPSN); kn = kn * rstd * A.in[21][d]; const float ko = __shfl_xor(kn, 32); kn = d < 32 ? kn * cs - ko * sn : kn * cs + ko * sn; }
    const float vn = bf1(zr[ZV + kvh * 64 + d]);
    if ((head & 3) == 0) { A.out[O_KS + ((size_t)bs * 4 + kvh) * 64 + d] = kn; A.out[O_VS + ((size_t)bs * 4 + kvh) * 64 + d] = vn; }
    const float snew = wave_sum(q * kn);
    wl[d] = q; LDS_WAIT();
    const float* ck = A.in[4] + (size_t)bs * 128 * 256 + kvh * 64; const float* cv = A.in[5] + (size_t)bs * 128 * 256 + kvh * 64;
    float s0 = 0.f, s1 = 0.f;
    { const float* k0 = ck + (size_t)lane * 256; const float* k1 = ck + (size_t)(lane + 64) * 256;
#pragma unroll
      for (int i = 0; i < 16; ++i) { const f32x4 qv = *(const LAS f32x4*)(wl + 4 * i), a = *(const f32x4*)(k0 + 4 * i), c = *(const f32x4*)(k1 + 4 * i);
          s0 += (qv.x * a.x + qv.y * a.y) + (qv.z * a.z + qv.w * a.w); s1 += (qv.x * c.x + qv.y * c.y) + (qv.z * c.z + qv.w * c.w); } }
    if (lane == 0) s0 = snew;
    const float sink = A.in[22][head];
    const float mx = fmaxf(wave_max(fmaxf(s0, s1)), sink);
    const float p0 = fexp(s0 - mx), p1 = fexp(s1 - mx);
    const float inv = 1.f / (wave_sum(p0 + p1) + fexp(sink - mx));
    wl[64 + lane] = p0; wl[128 + lane] = p1; LDS_WAIT();
    float o = wl[64] * vn;
#pragma unroll 8
    for (int j = 1; j < 128; ++j) o += wl[64 + j] * cv[(size_t)j * 256 + d];
    OATT[row * DATT + head * 64 + d] = (bf16)(pk2(o * inv, 0.f) & 0xffffu);
    LDS_WAIT();
}
template <bool FINAL> __device__ __forceinline__ void rnn_item(const Args& A, LAS float* xcs  , int b, int c, int wave, int lane) {
    unsigned char* ws = A.ws; const bf16* Z = (const bf16*)(ws + WS_HZ); bf16* ORNN = (bf16*)(ws + WS_ORNN); float* CA = (float*)(ws + WS_CA); float* CH = (float*)(ws + WS_CH);
    const int hh = lane >> 5, l31 = lane & 31, t00 = c * TCHUNK;
#pragma unroll 1
    for (int hb2 = 0; hb2 < 2; ++hb2) {
        const int hb = 2 * wave + hb2, ch = hb * 64 + lane;
        {
            const float cw0 = A.in[23][ch], cw1 = A.in[23][DRNN + ch], cw2 = A.in[23][2 * DRNN + ch], cw3 = A.in[23][3 * DRNN + ch], cb = A.in[24][ch];
            const bf16* zc = Z + (size_t)b * SEQ * DIN + ZRX + ch;
            float x3 = t00 >= 3 ? bf1(zc[(size_t)(t00 - 3) * DIN]) : 0.f, x2 = t00 >= 2 ? bf1(zc[(size_t)(t00 - 2) * DIN]) : 0.f, x1 = t00 >= 1 ? bf1(zc[(size_t)(t00 - 1) * DIN]) : 0.f;
#pragma unroll 8
            for (int k = 0; k < TCHUNK; ++k) { const float x0 = bf1(zc[(size_t)(t00 + k) * DIN]); xcs[k * 65 + lane] = cb + cw3 * x0 + cw2 * x1 + cw1 * x2 + cw0 * x3; x3 = x2; x2 = x1; x1 = x0; }
            if (FINAL && c == NCHUNK - 1) { A.out[O_CP + ((size_t)b * 3 + 0) * DRNN + ch] = x3; A.out[O_CP + ((size_t)b * 3 + 1) * DRNN + ch] = x2; A.out[O_CP + ((size_t)b * 3 + 2) * DRNN + ch] = x1; }
        }
        LDS_WAIT();
#pragma unroll 1
        for (int nt = 0; nt < 2; ++nt) {
            const int j = hb * 64 + 32 * nt + l31;
            bf16x8 wf[2][4];
#pragma unroll
            for (int gt = 0; gt < 2; ++gt) { const float* wg = A.in[gt == 0 ? 25 : 27] + (size_t)hb * 4096 + 32 * nt + l31;
#pragma unroll
                for (int ks = 0; ks < 4; ++ks) { float v[8];
#pragma unroll
                    for (int e = 0; e < 8; ++e) v[e] = wg[(8 * hh + 16 * ks + e) * 64];
                    wf[gt][ks] = pack8(v); } }
            const float brg = A.in[26][j], big = A.in[28][j], sp = log1pf(expf(-A.in[29][j]));
            float H = 0.f, Ap = 1.f;
            if (FINAL) { for (int cc = 0; cc < c; ++cc) { const size_t o = ((size_t)b * NCHUNK + cc) * DRNN + j; H = CA[o] * H + CH[o]; } }
#pragma unroll 1
            for (int tt = 0; tt < 2; ++tt) {
                const int t0 = t00 + 32 * tt;
                f32x16 ar, ai;
#pragma unroll
                for (int r = 0; r < 16; ++r) { ar[r] = 0.f; ai[r] = 0.f; }
#pragma unroll
                for (int ks = 0; ks < 4; ++ks) { float v[8];
#pragma unroll
                    for (int e = 0; e < 8; ++e) v[e] = xcs[(32 * tt + l31) * 65 + 8 * hh + 16 * ks + e];
                    const bf16x8 af = pack8(v); ar = MFMA32(af, wf[0][ks], ar); ai = MFMA32(af, wf[1][ks], ai); }
                float rgv[16];
                if (FINAL) {
#pragma unroll
                    for (int r = 0; r < 16; ++r) { const int tk = 8 * (r >> 2) + 4 * hh + (r & 3); rgv[r] = bf1(Z[((size_t)b * SEQ + t0 + tk) * DIN + ZRG + j]); } }
#pragma unroll
                for (int r = 0; r < 16; ++r) { const int tk = 8 * (r >> 2) + 4 * hh + (r & 3);
                    const float rg_ = fsig(ar[r] + brg), ig_ = fsig(ai[r] + big); const float la = -8.f * rg_ * sp; const float a = fexp(la);
                    const float mult = sqrtf(fmaxf(-expm1f(2.f * la), 0.f)); ar[r] = a; ai[r] = mult * ig_ * xcs[(32 * tt + tk) * 65 + 32 * nt + l31]; }
                float Hs[4];
#pragma unroll
                for (int g4 = 0; g4 < 4; ++g4) { float Aa = 1.f, U = 0.f;
#pragma unroll
                    for (int r4 = 0; r4 < 4; ++r4) { const float a = ar[4 * g4 + r4]; U = a * U + ai[4 * g4 + r4]; Aa *= a; }
                    const float pA = __shfl_xor(Aa, 32), pU = __shfl_xor(U, 32);
                    const float A0 = hh == 0 ? Aa : pA, U0 = hh == 0 ? U : pU, A1 = hh == 0 ? pA : Aa, U1 = hh == 0 ? pU : U;
                    const float Hs0 = H; H = A0 * H + U0; const float Hs1 = H; H = A1 * H + U1; Hs[g4] = hh == 0 ? Hs0 : Hs1; Ap *= A0 * A1; }
                if (FINAL) {
#pragma unroll
                    for (int g4 = 0; g4 < 4; ++g4) { float h = Hs[g4];
#pragma unroll
                        for (int r4 = 0; r4 < 4; ++r4) { const int r = 4 * g4 + r4, tk = 8 * g4 + 4 * hh + r4; h = ar[r] * h + ai[r];
                            ORNN[((size_t)b * SEQ + t0 + tk) * DRNN + j] = (bf16)(pk2(h * gelu_tanh(rgv[r]), 0.f) & 0xffffu); } } }
            }
            if (!FINAL) { if (hh == 0) { const size_t o = ((size_t)b * NCHUNK + c) * DRNN + j; CA[o] = Ap; CH[o] = H; } }
            else if (c == NCHUNK - 1 && hh == 0) A.out[O_HP + (size_t)b * DRNN + j] = H;
        }
        LDS_WAIT();
    }
}
__device__ __forceinline__ void rnn_sample_item(const Args& A, int bs, int hb, int lane) {
    unsigned char* ws = A.ws; const bf16* Z = (const bf16*)(ws + WS_HZ); bf16* ORNN = (bf16*)(ws + WS_ORNN);
    const int ch = hb * 64 + lane; const size_t row = MPROMPT + bs;
    const float* sc = A.in[7] + (size_t)bs * 3 * DRNN + ch; const float b0 = sc[0], b1 = sc[DRNN], b2 = sc[2 * DRNN];
    const float rx = bf1(Z[row * DIN + ZRX + ch]), rg = bf1(Z[row * DIN + ZRG + ch]);
    const float xc = A.in[24][ch] + A.in[23][ch] * b0 + A.in[23][DRNN + ch] * b1 + A.in[23][2 * DRNN + ch] * b2 + A.in[23][3 * DRNN + ch] * rx;
    const float* wr = A.in[25] + (size_t)hb * 4096 + lane; const float* wi = A.in[27] + (size_t)hb * 4096 + lane;
    float ar = A.in[26][ch], ai = A.in[28][ch];
#pragma unroll 16
    for (int i = 0; i < 64; ++i) { const float xi = __shfl(xc, i); ar += xi * wr[i * 64]; ai += xi * wi[i * 64]; }
    const float rg_ = fsig(ar), ig_ = fsig(ai), la = -8.f * rg_ * log1pf(expf(-A.in[29][ch])), a = expf(la), mult = sqrtf(fmaxf(-expm1f(2.f * la), 0.f));
    const float h = a * A.in[6][(size_t)bs * DRNN + ch] + mult * ig_ * xc;
    A.out[O_HS + (size_t)bs * DRNN + ch] = h;
    ORNN[row * DRNN + ch] = (bf16)(pk2(h * gelu_tanh(rg), 0.f) & 0xffffu);
    float* co = A.out + O_CS + (size_t)bs * 3 * DRNN + ch; co[0] = b1; co[DRNN] = b2; co[2 * DRNN] = rx;
}

#define XB_TMO      128
#define XB_XCNT(j)  (256  + 64 * (j))
#define XB_XSUB(j)  (1280 + 64 * (j))
#define XB_XGEN(j)  (2304 + 64 * (j))
#define XB_TOP      3328
#define XB_TOPGEN   3392
#define XCD_BAR_WORDS 3456
#define XB_SPIN_CAP (1u << 18)

__device__ __forceinline__ unsigned xb_ld(unsigned* p)              { return __hip_atomic_load(p, __ATOMIC_RELAXED, __HIP_MEMORY_SCOPE_AGENT); }
__device__ __forceinline__ unsigned xb_add(unsigned* p, unsigned v) { return __hip_atomic_fetch_add(p, v, __ATOMIC_RELAXED, __HIP_MEMORY_SCOPE_AGENT); }
__device__ __forceinline__ unsigned xb_xcc_id() { return (unsigned)__builtin_amdgcn_s_getreg((3 << 11) | 20) & 0xFu; }
#define XB_SPIN(cond, bar) do { unsigned _sp = 0; while (cond) { __builtin_amdgcn_s_sleep(1); \
    if ((++_sp & 255u) == 0u) { if (xb_ld(&(bar)[XB_TMO])) break; if (_sp > XB_SPIN_CAP) { atomicAdd(&(bar)[XB_TMO], 1u); break; } } } } while (0)

struct XcdBarrier {
    unsigned* bar; unsigned x;
    volatile LAS unsigned* st;
};

__device__ __forceinline__ XcdBarrier xcd_barrier_post(unsigned* bar, volatile LAS unsigned* st) {
    XcdBarrier b; b.bar = bar; b.x = xb_xcc_id(); b.st = st;
    if (threadIdx.x == 0) (void)xb_add(&bar[XB_XCNT(b.x)], 1u);
    return b;
}
__device__ __forceinline__ void xcd_barrier_complete(unsigned* bar, unsigned x, unsigned& nloc, unsigned& nx) {
    const unsigned G = gridDim.x * gridDim.y * gridDim.z;
    unsigned sum, cnt, mine, sp = 0u;
    for (;;) {
        sum = 0u; cnt = 0u; mine = 0u;
#pragma unroll
        for (unsigned j = 0; j < 16; ++j) { const unsigned c = xb_ld(&bar[XB_XCNT(j)]); sum += c; cnt += (c > 0u) ? 1u : 0u; mine = (j == x) ? c : mine; }
        if (sum == G) break;
        __builtin_amdgcn_s_sleep(1);
        if ((++sp & 255u) == 0u) { if (xb_ld(&bar[XB_TMO])) break; if (sp > XB_SPIN_CAP) { atomicAdd(&bar[XB_TMO], 1u); break; } }
    }
    nloc = mine > 0u ? mine : 1u; nx = cnt > 0u ? cnt : 1u;
}

__device__ __forceinline__ void xcd_barrier(const XcdBarrier& b) {
    asm volatile("s_waitcnt vmcnt(0)" ::: "memory");
    __syncthreads();
    if (threadIdx.x == 0) {
        unsigned* bar = b.bar;
        __builtin_amdgcn_s_waitcnt(0);
        unsigned nloc = b.st[0], nx = b.st[1];
        if (nloc == 0u) { xcd_barrier_complete(bar, b.x, nloc, nx); b.st[0] = nloc; b.st[1] = nx; }
        const unsigned old = xb_add(&bar[XB_XSUB(b.x)], 1u);
        const unsigned gen = old / nloc;
        if (old + 1u == (gen + 1u) * nloc) {
            __builtin_amdgcn_fence(__ATOMIC_RELEASE, "agent");
            asm volatile("s_waitcnt vmcnt(0)" ::: "memory");
            const unsigned og = xb_add(&bar[XB_TOP], 1u);
            const unsigned tg = og / nx;
            if (og + 1u == (tg + 1u) * nx) xb_add(&bar[XB_TOPGEN], 1u);
            else XB_SPIN(xb_ld(&bar[XB_TOPGEN]) == tg, bar);
            __builtin_amdgcn_fence(__ATOMIC_ACQUIRE, "agent");
            xb_add(&bar[XB_XGEN(b.x)], 1u);
            asm volatile("s_waitcnt vmcnt(0)" ::: "memory");
        } else {
            XB_SPIN(xb_ld(&bar[XB_XGEN(b.x)]) == gen, bar);
            __builtin_amdgcn_fence(__ATOMIC_ACQUIRE, "agent");
            asm volatile("s_waitcnt vmcnt(0)" ::: "memory");
        }
    }
    __syncthreads();
}

__global__ void __launch_bounds__(NTHREADS, 2) mk_fwd(Args args) {
    extern __shared__ __attribute__((aligned(16))) unsigned char lds_raw[];
    LAS unsigned char* lds = (LAS unsigned char*)lds_raw;
    const int tid = threadIdx.x, lane = tid & 63, wave = __builtin_amdgcn_readfirstlane(tid >> 6);
    const int G = gridDim.x, bx = blockIdx.x;
    unsigned char* ws = args.ws;
    const int lo = args.ph_lo, hi = args.ph_hi;
    if (tid < 16) ((LAS unsigned*)(lds + MISC_OFF))[tid] = 0u;
    __syncthreads();
    XcdBarrier bar; bar.bar = (unsigned*)(ws + WS_BAR); bar.x = 0; bar.st = nullptr;
    if (hi - lo > 1) bar = xcd_barrier_post((unsigned*)(ws + WS_BAR), (volatile LAS unsigned*)(lds + MISC_OFF));
    bf16* XN = (bf16*)(ws + WS_XN); bf16* HB = (bf16*)(ws + WS_HZ); bf16* ZB = (bf16*)(ws + WS_HZ); float* XB = (float*)(ws + WS_X); float* MOD = (float*)(ws + WS_MOD);
    bf16* OATT = (bf16*)(ws + WS_OATT); bf16* ORNN = (bf16*)(ws + WS_ORNN); bf16* MIX = (bf16*)(ws + WS_MIX);
#ifndef PH_MASK
#define PH_MASK 0x1fff
#endif
#define IN(k) (((PH_MASK >> (k)) & 1) && lo <= (k) && (k) < hi)
#define SEAM(k) do { if (IN(k) && IN((k) + 1)) { if ((k) == 0) { __threadfence(); cg::this_grid().sync(); } else xcd_barrier(bar); } } while (0)

    if (IN(0)) { p0_prologue(args, lds, tid, wave, lane); } SEAM(0);
    if (IN(1)) { norm_phase(args.in[0], args.in[1], args.in[10], MOD, 0, XN, wave, lane); } SEAM(1);
    if (IN(2)) { pg8::Gemm g{XN, (const bf16*)(ws + WS_W13A), MPAD, 2 * DFF, DM}; pg8::StaticOrder S; S.init(MPAD, 2 * DFF, G, bx); pg8::EpiSwiGLU E{HB, DFF};
        pg8::gemm_phase<pg8::EpiSwiGLU, pg8::StaticOrder, true, true>(lds, g, S, E); } SEAM(2);
    if (IN(3)) { pg8::Gemm g{HB, (const bf16*)(ws + WS_W2A), MPAD, DM, DFF}; pg8::StaticOrder S; S.init(MPAD, DM, G, bx); pg8::EpiRes E{args.in[0], args.in[1], XB, MOD + 2 * DM, 0.5f};
        pg8::gemm_phase<pg8::EpiRes, pg8::StaticOrder, true, true>(lds, g, S, E); } SEAM(3);
    if (IN(4)) { norm_phase(XB, XB + (size_t)MPROMPT * DM, args.in[11], MOD, 3, XN, wave, lane); } SEAM(4);
    if (IN(5)) { pg8::Gemm g{XN, (const bf16*)(ws + WS_WIN), MPAD, DIN, DM}; pg8::StaticOrder S; S.init(MPAD, DIN, G, bx); pg8::EpiBf16<0> E{ZB, DIN, nullptr, 0, 0, 1.f};
        pg8::gemm_phase<pg8::EpiBf16<0>, pg8::StaticOrder, true, true>(lds, g, S, E); } SEAM(5);
    if (IN(6)) {
#ifndef NO_ATTN
        for (int it = bx; it < 256; it += G) attn_item(args, lds, it >> 7, (it >> 2) & 31, it & 3, tid, wave, lane);
#endif
#ifndef NO_RNN
        for (int it = bx; it < 2 * NCHUNK; it += G) rnn_item<false>(args, (LAS float*)(lds + wave * 16640), it / NCHUNK, it % NCHUNK, wave, lane);
#endif
        __syncthreads();
#ifndef NO_SATTN
        for (int it = (G - 1 - bx) * NWAVES + wave; it < NSAMP * 16; it += G * NWAVES) attn_sample_item(args, (LAS float*)(lds + wave * 768), it >> 4, it & 15, lane);
#endif
    } SEAM(6);
    if (IN(7)) {
        for (int it = bx; it < 2 * NCHUNK; it += G) rnn_item<true>(args, (LAS float*)(lds + wave * 16640), it / NCHUNK, it % NCHUNK, wave, lane);
        for (int it = (G - 1 - bx) * NWAVES + wave; it < NSAMP * 16; it += G * NWAVES) rnn_sample_item(args, it >> 4, it & 15, lane);
        __syncthreads();
        pg8::Gemm g{OATT, (const bf16*)(ws + WS_WPA), MPAD, DM, DATT}; pg8::StaticOrder S; S.init(MPAD, DM, G, bx); pg8::EpiGateMix<false> E{MIX, ZB + ZGA};
        pg8::gemm_phase<pg8::EpiGateMix<false>, pg8::StaticOrder, true, true>(lds, g, S, E); } SEAM(7);
    if (IN(8)) { pg8::Gemm g{ORNN, (const bf16*)(ws + WS_WPR), MPAD, DM, DRNN}; pg8::StaticOrder S; S.init(MPAD, DM, G, bx); pg8::EpiGateMix<true> E{MIX, ZB + ZGR};
        pg8::gemm_phase<pg8::EpiGateMix<true>, pg8::StaticOrder, true, true>(lds, g, S, E); } SEAM(8);
    if (IN(9)) { pg8::Gemm g{MIX, (const bf16*)(ws + WS_WOUT), MPAD, DM, DM}; pg8::StaticOrder S; S.init(MPAD, DM, G, bx); pg8::EpiRes E{XB, XB + (size_t)MPROMPT * DM, XB, MOD + 5 * DM, 1.f};
        pg8::gemm_phase<pg8::EpiRes, pg8::StaticOrder, true, true>(lds, g, S, E); } SEAM(9);
    if (IN(10)) { norm_phase(XB, XB + (size_t)MPROMPT * DM, args.in[12], MOD, 6, XN, wave, lane); } SEAM(10);
    if (IN(11)) { pg8::Gemm g{XN, (const bf16*)(ws + WS_W13B), MPAD, 2 * DFF, DM}; pg8::StaticOrder S; S.init(MPAD, 2 * DFF, G, bx); pg8::EpiSwiGLU E{HB, DFF};
        pg8::gemm_phase<pg8::EpiSwiGLU, pg8::StaticOrder, true, true>(lds, g, S, E); } SEAM(11);
    if (IN(12)) { pg8::Gemm g{HB, (const bf16*)(ws + WS_W2B), MPAD, DM, DFF}; pg8::StaticOrder S; S.init(MPAD, DM, G, bx); pg8::EpiRes E{XB, XB + (size_t)MPROMPT * DM, args.out + O_Y, MOD + 8 * DM, 0.5f};
        pg8::gemm_phase<pg8::EpiRes, pg8::StaticOrder, true, true>(lds, g, S, E); }
#undef IN
#undef SEAM
}

extern "C" void kernel_launch(void* const* d_in, const int* in_sizes, int n_in, void* d_out, int out_size, void* d_ws, size_t ws_size, hipStream_t stream) {
    static int grid = 0;
    if (grid == 0) {
        if (n_in != 33 || out_size != (int)O_END || ws_size < WS_END) { fprintf(stderr, "kernel_launch: unexpected shapes: n_in %d out %d ws %zu\n", n_in, out_size, ws_size); grid = -1; return; }
        int dev = 0, cus = 0, per_cu = 0;
        hipGetDevice(&dev); hipDeviceGetAttribute(&cus, hipDeviceAttributeMultiprocessorCount, dev);
        hipFuncSetAttribute((const void*)mk_fwd, hipFuncAttributeMaxDynamicSharedMemorySize, LDS_BYTES);
        hipOccupancyMaxActiveBlocksPerMultiprocessor(&per_cu, (const void*)mk_fwd, NTHREADS, LDS_BYTES);
        if (per_cu < 1) { fprintf(stderr, "kernel_launch: occupancy query says %d blocks per CU\n", per_cu); grid = -1; return; }
        grid = cus;
    }
    if (grid < 0) return;
    Args a{};
    for (int i = 0; i < 33; ++i) a.in[i] = (const float*)d_in[i];
    a.out = (float*)d_out; a.ws = (unsigned char*)d_ws;
#if MK_ONE_LAUNCH
    if (hipMemsetAsync((char*)d_ws + WS_BAR, 0, 65536, stream) != hipSuccess) { fprintf(stderr, "memset failed\n"); return; }
    a.ph_lo = 0; a.ph_hi = 13;
    void* kargs[] = {&a};
    hipError_t e = hipLaunchCooperativeKernel((const void*)mk_fwd, dim3(grid), dim3(NTHREADS), kargs, LDS_BYTES, stream);
    if (e != hipSuccess) fprintf(stderr, "cooperative launch failed: %s (grid %d)\n", hipGetErrorString(e), grid);
#else
    for (int p = 0; p < 13; ++p) { a.ph_lo = p; a.ph_hi = p + 1; hipLaunchKernelGGL(mk_fwd, dim3(grid), dim3(NTHREADS), LDS_BYTES, stream, a); }
#endif
}
```

```cpp
#include <hip/hip_runtime.h>
#include <hip/hip_cooperative_groups.h>
#include <cstdio>
#include <cstdint>
#include <cmath>
namespace pg8 {
#define PG8_LAS __attribute__((address_space(3)))
typedef unsigned short bf16_t;
typedef short bf16x8 __attribute__((ext_vector_type(8)));
typedef float f32x4 __attribute__((ext_vector_type(4)));
typedef unsigned u32x4 __attribute__((ext_vector_type(4)));
constexpr int BM = 256, BK = 64, HALF = 128, HTB = HALF * BK * 2  , STAGE_BYTES = 8 * HTB, NXCD = 8, WGM = 8;

__host__ __device__ __forceinline__ int lds_byte(int r, int c) { const int st = (r >> 4) * 2 + (c >> 5), rr = r & 15, cc = c & 31, ob = rr * 64 + cc * 2; return st * 1024 + (ob ^ (((ob >> 9) & 1) << 5)); }
__host__ __device__ __forceinline__ void stage_rc(int b, int& R, int& C) { const int st = b / 1024, sb = b % 1024, swz = sb ^ (((sb >> 9) & 1) << 5); R = (st >> 1) * 16 + swz / 64; C = (st & 1) * 32 + (swz % 64) / 2; }
__host__ __device__ __forceinline__ int perm32(int rho) { const int n = rho >> 4, i = rho & 15; return 8 * (i >> 2) + 4 * n + (i & 3); }

struct Unit { int pm, pn; };
struct Gemm { const bf16_t* A; const bf16_t* Bt; int M, N, K; };

struct StaticOrder {
    int nM, nN, nwg, G, c;
    __host__ __device__ void init(int M, int N, int G_, int c_) { nM = M / BM; nN = N / BM; nwg = nM * nN; G = G_; c = c_; }
    __host__ __device__ bool next(int i, Unit& u) const {
        const long L = (long)i * G + c; if (L >= nwg) return false;
        int wgid = (int)L; { const int q = nwg / NXCD, r = nwg % NXCD, xcd = wgid % NXCD, off = wgid / NXCD; wgid = (xcd < r ? xcd * (q + 1) : r * (q + 1) + (xcd - r) * q) + off; }
        const int nig = WGM * nN, gid = wgid / nig, fm = gid * WGM, gsz = (nM - fm) < WGM ? (nM - fm) : WGM;
        u.pm = fm + ((wgid % nig) % gsz); u.pn = (wgid % nig) / gsz; return true;
    }
    __device__ __forceinline__ void a_ready(const Unit&) const {}
    __device__ __forceinline__ void done(const Unit&) const {}
};

__device__ __forceinline__ unsigned cvt_pk_bf16(float lo, float hi) { unsigned r; asm volatile("v_cvt_pk_bf16_f32 %0, %1, %2" : "=v"(r) : "v"(lo), "v"(hi)); return r; }
typedef float f32x2 __attribute__((ext_vector_type(2)));
__device__ __forceinline__ f32x2 gelu_pk(f32x2 v) {
    const f32x2 av = __builtin_elementwise_abs(v), d = av * 0.2316418882f + 1.0f;
    f32x2 t; t.x = __builtin_amdgcn_rcpf(d.x); t.y = __builtin_amdgcn_rcpf(d.y);
    f32x2 q = t * 0.5307027145f + (-0.7265760135f); q = q * t + 0.7107068705f; q = q * t + (-0.142248368f); q = q * t + 0.127414796f; q = q * t;
    const f32x2 s = (v * v) * (-0.72134752044f);
    f32x2 e; e.x = __builtin_amdgcn_exp2f(s.x); e.y = __builtin_amdgcn_exp2f(s.y);
    const f32x2 m = v * (q * e), r = v - m;
    f32x2 o; o.x = v.x < 0.f ? m.x : r.x; o.y = v.y < 0.f ? m.y : r.y; return o;
}

template <int ACT  > struct EpiBf16 {
    static constexpr bool PERM = true, AFTER_DRAIN = false; static_assert(ACT == 0 || ACT == 1, "EpiBf16: ACT is 0 (none) or 1 (gelu_pk)");
    bf16_t* O; int ldc; const float* bias; int split_cols; size_t split_stride; float scale0;
    __device__ __forceinline__ void operator()(const f32x4 (&acc)[2][2][4][2], const Unit& u, int wr, int wc, int fr, int fq) const {
        const int row0 = u.pm * BM + wr * 64 + fr; int colt = u.pn * BM; bf16_t* base = O;
        float sc = 1.f; if (split_cols) { const int t = colt / split_cols; base += (size_t)t * split_stride; colt -= t * split_cols; if (t == 0) sc = scale0; }
        const int col0 = colt + wc * 32 + 8 * fq, bcol0 = u.pn * BM + wc * 32 + 8 * fq;
        f32x4 bv[2][2];
#pragma unroll
        for (int bj = 0; bj < 2; ++bj)
#pragma unroll
            for (int n = 0; n < 2; ++n) bv[bj][n] = bias ? *(const f32x4*)(bias + bcol0 + bj * HALF + 4 * n) : (f32x4){0.f, 0.f, 0.f, 0.f};
#pragma unroll
        for (int ai = 0; ai < 2; ++ai)
#pragma unroll
            for (int m = 0; m < 4; ++m) { bf16_t* rowp = base + (size_t)(row0 + ai * HALF + m * 16) * ldc + col0;
#pragma unroll
                for (int bj = 0; bj < 2; ++bj) { f32x4 v0 = acc[ai][bj][m][0] + bv[bj][0], v1 = acc[ai][bj][m][1] + bv[bj][1];
                    if (ACT == 1) { f32x2 a = gelu_pk((f32x2){v0[0], v0[1]}), b = gelu_pk((f32x2){v0[2], v0[3]}), c = gelu_pk((f32x2){v1[0], v1[1]}), d = gelu_pk((f32x2){v1[2], v1[3]});
                        v0 = (f32x4){a.x, a.y, b.x, b.y}; v1 = (f32x4){c.x, c.y, d.x, d.y}; }
                    v0 = v0 * sc; v1 = v1 * sc; u32x4 w; w.x = cvt_pk_bf16(v0[0], v0[1]); w.y = cvt_pk_bf16(v0[2], v0[3]); w.z = cvt_pk_bf16(v1[0], v1[1]); w.w = cvt_pk_bf16(v1[2], v1[3]);
                    *(u32x4*)(rowp + bj * HALF) = w; } }
    }
};
constexpr int MROWS_VALID = 8224, MROWS_PROMPT = 8192;
__device__ __forceinline__ float fsigmoid(float x) { return __builtin_amdgcn_rcpf(1.f + __builtin_amdgcn_exp2f(-1.44269504f * x)); }
__device__ __forceinline__ float fsilu(float x) { return x * fsigmoid(x); }
__device__ __forceinline__ float bflo(unsigned w) { return __uint_as_float(w << 16); }
__device__ __forceinline__ float bfhi(unsigned w) { return __uint_as_float(w & 0xffff0000u); }

struct EpiSwiGLU {
    static constexpr bool PERM = true, AFTER_DRAIN = false;
    bf16_t* O; int ldc;
    __device__ __forceinline__ void operator()(const f32x4 (&acc)[2][2][4][2], const Unit& u, int wr, int wc, int fr, int fq) const {
        const int row0 = u.pm * BM + wr * 64 + fr, col0 = u.pn * HALF + wc * 32 + 8 * fq;
#pragma unroll
        for (int ai = 0; ai < 2; ++ai)
#pragma unroll
            for (int m = 0; m < 4; ++m) {
                bf16_t* p = O + (size_t)(row0 + ai * HALF + m * 16) * ldc + col0;
                const f32x4 a0 = acc[ai][0][m][0], a1 = acc[ai][0][m][1], b0 = acc[ai][1][m][0], b1 = acc[ai][1][m][1];
                u32x4 w;
                w.x = cvt_pk_bf16(fsilu(a0[0]) * b0[0], fsilu(a0[1]) * b0[1]); w.y = cvt_pk_bf16(fsilu(a0[2]) * b0[2], fsilu(a0[3]) * b0[3]);
                w.z = cvt_pk_bf16(fsilu(a1[0]) * b1[0], fsilu(a1[1]) * b1[1]); w.w = cvt_pk_bf16(fsilu(a1[2]) * b1[2], fsilu(a1[3]) * b1[3]);
                *(u32x4*)p = w;
            }
    }
};
struct EpiRes {
    static constexpr bool PERM = false, AFTER_DRAIN = false;
    const float* base_p; const float* base_s; float* out; const float* gate; float gs;
    __device__ __forceinline__ void operator()(const f32x4 (&acc)[2][2][4][2], const Unit& u, int wr, int wc, int fr, int fq) const {
        const int col0 = u.pn * BM + wc * 32 + 4 * fq;
#pragma unroll
        for (int ai = 0; ai < 2; ++ai)
#pragma unroll
            for (int m = 0; m < 4; ++m) {
                const int row = u.pm * BM + ai * HALF + wr * 64 + m * 16 + fr;
                if (row < MROWS_VALID) {
                    const int br = row < MROWS_PROMPT ? (row >> 12) : (2 + row - MROWS_PROMPT);
                    const float* bp = row < MROWS_PROMPT ? base_p + (size_t)row * 2048 : base_s + (size_t)(row - MROWS_PROMPT) * 2048;
                    const float* gp = gate + (size_t)br * 18432; float* op = out + (size_t)row * 2048;
#pragma unroll
                    for (int bj = 0; bj < 2; ++bj)
#pragma unroll
                        for (int n = 0; n < 2; ++n) { const int c = col0 + bj * HALF + n * 16;
                            const f32x4 g = *(const f32x4*)(gp + c), b = *(const f32x4*)(bp + c);
                            *(f32x4*)(op + c) = b + (g * gs) * acc[ai][bj][m][n]; }
                }
            }
    }
};
template <bool ACCUM> struct EpiGateMix {
    static constexpr bool PERM = true, AFTER_DRAIN = false;
    bf16_t* O; const bf16_t* Zg;
    __device__ __forceinline__ void operator()(const f32x4 (&acc)[2][2][4][2], const Unit& u, int wr, int wc, int fr, int fq) const {
        const int row0 = u.pm * BM + wr * 64 + fr, col0 = u.pn * BM + wc * 32 + 8 * fq;
#pragma unroll
        for (int ai = 0; ai < 2; ++ai)
#pragma unroll
            for (int m = 0; m < 4; ++m) { const int row = row0 + ai * HALF + m * 16;
#pragma unroll
                for (int bj = 0; bj < 2; ++bj) { const int c = col0 + bj * HALF;
                    const u32x4 gz = *(const u32x4*)(Zg + (size_t)row * 7680 + c);
                    bf16_t* op = O + (size_t)row * 2048 + c;
                    const f32x4 v0 = acc[ai][bj][m][0], v1 = acc[ai][bj][m][1];
                    float r0 = fsigmoid(bflo(gz.x)) * v0[0], r1 = fsigmoid(bfhi(gz.x)) * v0[1], r2 = fsigmoid(bflo(gz.y)) * v0[2], r3 = fsigmoid(bfhi(gz.y)) * v0[3];
                    float r4 = fsigmoid(bflo(gz.z)) * v1[0], r5 = fsigmoid(bfhi(gz.z)) * v1[1], r6 = fsigmoid(bflo(gz.w)) * v1[2], r7 = fsigmoid(bfhi(gz.w)) * v1[3];
                    if (ACCUM) { const u32x4 pv = *(const u32x4*)op;
                        r0 += bflo(pv.x); r1 += bfhi(pv.x); r2 += bflo(pv.y); r3 += bfhi(pv.y); r4 += bflo(pv.z); r5 += bfhi(pv.z); r6 += bflo(pv.w); r7 += bfhi(pv.w); }
                    u32x4 w; w.x = cvt_pk_bf16(r0, r1); w.y = cvt_pk_bf16(r2, r3); w.z = cvt_pk_bf16(r4, r5); w.w = cvt_pk_bf16(r6, r7);
                    *(u32x4*)op = w; }
            }
    }
};
template <class Epi, class Sched, bool ALIGN_EPI = false, bool SP2 = false>
__device__ __forceinline__ void gemm_phase(PG8_LAS unsigned char* lds, const Gemm g, const Sched& S, const Epi& E) {
    const int tid = threadIdx.x, wid = __builtin_amdgcn_readfirstlane(tid >> 6), lane = tid & 63, wr = wid >> 2, wc = wid & 3, fr = lane & 15, fq = lane >> 4;
    const int K = g.K, nt = K / BK;
    unsigned voffA[2], voffB[2];
#pragma unroll
    for (int i = 0; i < 2; ++i) { int R, C; stage_rc(tid * 16 + i * 8192, R, C); const int Rb = Epi::PERM ? ((R & ~31) + perm32(R & 31)) : R;
        voffA[i] = (unsigned)(R * K + C) * 2u; voffB[i] = (unsigned)(Rb * K + C) * 2u; }
    const size_t kstep = (size_t)(BK * 2);
    const size_t hstep = (size_t)HALF * K * 2;
    const size_t tstep = 2 * hstep;
    const unsigned ldsw = (unsigned)wid * 1024u;
    const int aoff = lds_byte(wr * 64 + fr, fq * 8), boff = lds_byte(wc * 32 + fr, fq * 8);
#define PG8_SA(b, h) (((b) * 2 + (h)) * HTB)
#define PG8_SB(b, h) ((4 + (b) * 2 + (h)) * HTB)
#define PG8_STAGE(bufoff, gbase, voff) do { _Pragma("unroll") for (int _i = 0; _i < 2; ++_i) \
        __builtin_amdgcn_global_load_lds((const unsigned*)((const char*)(gbase) + (voff)[_i]), (PG8_LAS unsigned*)(lds + (bufoff) + ldsw + _i * 8192), 16, 0, 0); } while (0)
#define PG8_LDA(dst, b, h) do { _Pragma("unroll") for (int m = 0; m < 4; ++m) _Pragma("unroll") for (int k = 0; k < 2; ++k) dst[m][k] = *(const PG8_LAS bf16x8*)(lds + PG8_SA(b, h) + aoff + m * 2048 + k * 1024); } while (0)
#define PG8_LDB(dst, b, h) do { _Pragma("unroll") for (int n = 0; n < 2; ++n) _Pragma("unroll") for (int k = 0; k < 2; ++k) dst[n][k] = *(const PG8_LAS bf16x8*)(lds + PG8_SB(b, h) + boff + n * 2048 + k * 1024); } while (0)
#define PG8_MMA(ai, bj, At, Bt) do { __builtin_amdgcn_s_setprio(1); _Pragma("unroll") for (int m = 0; m < 4; ++m) _Pragma("unroll") for (int n = 0; n < 2; ++n) _Pragma("unroll") for (int k = 0; k < 2; ++k) \
        acc[ai][bj][m][n] = __builtin_amdgcn_mfma_f32_16x16x32_bf16(Bt[n][k], At[m][k], acc[ai][bj][m][n], 0, 0, 0); __builtin_amdgcn_s_setprio(0); } while (0)
#define PG8_WAIT_V(n) asm volatile("s_waitcnt vmcnt(" #n ")" ::: "memory")
#define PG8_WAIT_L(n) asm volatile("s_waitcnt lgkmcnt(" #n ")" ::: "memory")
#define PG8_BAR __builtin_amdgcn_s_barrier()
#define PG8_SCHED __builtin_amdgcn_sched_barrier(0)
    Unit cur, nxt; int ui = 0;
    if (!S.next(0, cur)) return;
    f32x4 acc[2][2][4][2];
#pragma unroll
    for (int a = 0; a < 2; ++a)
#pragma unroll
        for (int b = 0; b < 2; ++b)
#pragma unroll
            for (int m = 0; m < 4; ++m)
#pragma unroll
                for (int n = 0; n < 2; ++n) acc[a][b][m][n] = (f32x4){0.f, 0.f, 0.f, 0.f};
    bf16x8 At[4][2], B0[2][2], B1[2][2];
    const char* cA = (const char*)g.A + (size_t)cur.pm * tstep; const char* cB = (const char*)g.Bt + (size_t)cur.pn * tstep;
    S.a_ready(cur);
    if constexpr (SP2) {
        PG8_STAGE(PG8_SB(0, 0), cB, voffB); PG8_STAGE(PG8_SB(0, 1), cB + hstep, voffB); PG8_STAGE(PG8_SA(0, 0), cA, voffA); PG8_STAGE(PG8_SA(0, 1), cA + hstep, voffA);
        if (wr == 1) PG8_BAR;
        PG8_WAIT_V(2); PG8_BAR;
        PG8_STAGE(PG8_SB(1, 0), cB + kstep, voffB); PG8_STAGE(PG8_SA(1, 0), cA + kstep, voffA); PG8_STAGE(PG8_SB(1, 1), cB + hstep + kstep, voffB);
        PG8_WAIT_V(6); PG8_BAR;
    } else {
        PG8_STAGE(PG8_SB(0, 0), cB, voffB); PG8_STAGE(PG8_SA(0, 0), cA, voffA); PG8_STAGE(PG8_SB(0, 1), cB + hstep, voffB); PG8_STAGE(PG8_SA(0, 1), cA + hstep, voffA);
        if (wr == 1) PG8_BAR;
        PG8_WAIT_V(4); PG8_BAR;
        PG8_STAGE(PG8_SB(1, 0), cB + kstep, voffB); PG8_STAGE(PG8_SA(1, 0), cA + kstep, voffA); PG8_STAGE(PG8_SB(1, 1), cB + hstep + kstep, voffB);
        PG8_WAIT_V(6); PG8_BAR;
    }
    for (;;) {
        const bool has_next = S.next(ui + 1, nxt);
        const char* nA = has_next ? (const char*)g.A + (size_t)nxt.pm * tstep : cA; const char* nB = has_next ? (const char*)g.Bt + (size_t)nxt.pn * tstep : cB;
        for (int t = 0; t < nt; t += 2) {
            const bool last = (t == nt - 2);
            const char* a1 = cA + (size_t)(t + 1) * kstep;
            const char* a2 = last ? nA : cA + (size_t)(t + 2) * kstep; const char* b2 = last ? nB : cB + (size_t)(t + 2) * kstep;
            const char* a3 = a2 + kstep; const char* b3 = b2 + kstep;
            if (last && has_next) S.a_ready(nxt);
            if constexpr (SP2) {
            PG8_LDB(B0, 0, 0); PG8_LDB(B1, 0, 1); PG8_SCHED; PG8_LDA(At, 0, 0); PG8_STAGE(PG8_SA(1, 1), a1 + hstep, voffA);
            PG8_WAIT_V(8); PG8_WAIT_L(0); PG8_BAR; PG8_MMA(0, 0, At, B0); PG8_MMA(0, 1, At, B1); PG8_BAR; PG8_SCHED;
            PG8_LDA(At, 0, 1); PG8_STAGE(PG8_SB(0, 0), b2, voffB); PG8_STAGE(PG8_SB(0, 1), b2 + hstep, voffB); PG8_STAGE(PG8_SA(0, 0), a2, voffA);
            PG8_WAIT_V(8); PG8_WAIT_L(0); PG8_BAR; PG8_MMA(1, 0, At, B0); PG8_MMA(1, 1, At, B1); PG8_BAR; PG8_SCHED;
            PG8_LDB(B0, 1, 0); PG8_LDB(B1, 1, 1); PG8_SCHED; PG8_LDA(At, 1, 0); PG8_STAGE(PG8_SA(0, 1), a2 + hstep, voffA);
            PG8_WAIT_V(8); PG8_WAIT_L(0); PG8_BAR; PG8_MMA(0, 0, At, B0); PG8_MMA(0, 1, At, B1); PG8_BAR; PG8_SCHED;
            PG8_LDA(At, 1, 1); PG8_STAGE(PG8_SB(1, 0), b3, voffB); PG8_STAGE(PG8_SB(1, 1), b3 + hstep, voffB); PG8_STAGE(PG8_SA(1, 0), a3, voffA);
            PG8_WAIT_V(8); PG8_WAIT_L(0); PG8_BAR; PG8_MMA(1, 0, At, B0); PG8_MMA(1, 1, At, B1); PG8_BAR; PG8_SCHED;
            } else {
            PG8_LDB(B0, 0, 0); PG8_SCHED; PG8_LDA(At, 0, 0); PG8_STAGE(PG8_SA(1, 1), a1 + hstep, voffA);
            PG8_WAIT_L(8); PG8_BAR; PG8_WAIT_L(0); PG8_MMA(0, 0, At, B0); PG8_BAR; PG8_SCHED;
            PG8_LDB(B1, 0, 1); PG8_STAGE(PG8_SB(0, 0), b2, voffB);
            PG8_BAR; PG8_WAIT_L(0); PG8_MMA(0, 1, At, B1); PG8_BAR;
            PG8_LDA(At, 0, 1); PG8_STAGE(PG8_SA(0, 0), a2, voffA);
            PG8_BAR; PG8_WAIT_L(0); PG8_MMA(1, 0, At, B0); PG8_BAR; PG8_SCHED;
            PG8_STAGE(PG8_SB(0, 1), b2 + hstep, voffB);
            PG8_WAIT_V(6); PG8_BAR; PG8_MMA(1, 1, At, B1); PG8_BAR;
            PG8_LDB(B0, 1, 0); PG8_SCHED; PG8_LDA(At, 1, 0); PG8_STAGE(PG8_SA(0, 1), a2 + hstep, voffA);
            PG8_WAIT_L(8); PG8_BAR; PG8_WAIT_L(0); PG8_MMA(0, 0, At, B0); PG8_BAR; PG8_SCHED;
            PG8_LDB(B1, 1, 1); PG8_STAGE(PG8_SB(1, 0), b3, voffB);
            PG8_BAR; PG8_WAIT_L(0); PG8_MMA(0, 1, At, B1); PG8_BAR;
            PG8_LDA(At, 1, 1); PG8_STAGE(PG8_SA(1, 0), a3, voffA);
            PG8_BAR; PG8_WAIT_L(0); PG8_MMA(1, 0, At, B0); PG8_BAR; PG8_SCHED;
            PG8_STAGE(PG8_SB(1, 1), b3 + hstep, voffB);
            PG8_WAIT_V(6); PG8_BAR; PG8_MMA(1, 1, At, B1); PG8_BAR;
            }
        }
        if constexpr (ALIGN_EPI) { if (wr == 0) PG8_BAR; }
        if constexpr (!Epi::AFTER_DRAIN) { E(acc, cur, wr, wc, fr, fq); S.done(cur); }
        if (!has_next) break;
#pragma unroll
        for (int a = 0; a < 2; ++a)
#pragma unroll
            for (int b = 0; b < 2; ++b)
#pragma unroll
                for (int m = 0; m < 4; ++m)
#pragma unroll
                    for (int n = 0; n < 2; ++n) acc[a][b][m][n] = (f32x4){0.f, 0.f, 0.f, 0.f};
        cur = nxt; cA = nA; cB = nB; ++ui;
        if constexpr (ALIGN_EPI) { if (wr == 1) PG8_BAR; }
    }
    PG8_WAIT_V(0);
    if constexpr (!ALIGN_EPI) { if (wr == 0) PG8_BAR; }
    PG8_BAR;
    if constexpr (Epi::AFTER_DRAIN) { E.fused(acc, cur, wr, wc, fr, fq, lds, wid, lane); S.done(cur); }
#undef PG8_SA
#undef PG8_SB
#undef PG8_STAGE
#undef PG8_LDA
#undef PG8_LDB
#undef PG8_MMA
#undef PG8_WAIT_V
#undef PG8_WAIT_L
#undef PG8_BAR
#undef PG8_SCHED
}
}
namespace cg = cooperative_groups;
#ifndef MK_ONE_LAUNCH
#define MK_ONE_LAUNCH 1
#endif
constexpr int NWAVES = 8, NTHREADS = 512;
constexpr int DM = 2048, SEQ = 4096, MPROMPT = 8192, NSAMP = 32, MROWS = 8224, MPAD = 8448;
constexpr int DFF = 5632, DIN = 7680, DATT = 1024, DRNN = 1024, MODW = 18432, NBROW = 34;
constexpr int ZQ = 0, ZK = 1024, ZV = 1280, ZRX = 1536, ZRG = 2560, ZGA = 3584, ZGR = 5632;
constexpr int NCHUNK = 64, TCHUNK = 64;
constexpr float EPSN = 1e-6f;
constexpr size_t O_Y = 0, O_KP = 16842752, O_VP = 16908288, O_KS = 16973824, O_VS = 16982016, O_HP = 16990208, O_HS = 16992256, O_CP = 17025024, O_CS = 17031168, O_END = 17129472;
constexpr size_t MiB = 1u << 20;
constexpr size_t WS_W13A = 0, WS_W2A = 44 * MiB, WS_W13B = 66 * MiB, WS_W2B = 110 * MiB, WS_WIN = 132 * MiB, WS_WPA = 162 * MiB, WS_WPR = 166 * MiB, WS_WOUT = 170 * MiB;
constexpr size_t WS_XN = 178 * MiB, WS_HZ = 211 * MiB, WS_X = 335 * MiB, WS_OATT = 401 * MiB, WS_ORNN = 418 * MiB, WS_MIX = 435 * MiB, WS_MOD = 468 * MiB, WS_ROPE = 471 * MiB;
constexpr size_t WS_CA = 473 * MiB, WS_CH = WS_CA + 512 * 1024, WS_BAR = 474 * MiB, WS_END = 475 * MiB;
constexpr int MISC_OFF = 147456 - 64;
constexpr int LDS_BYTES = 147456;

#define LAS __attribute__((address_space(3)))
typedef unsigned short bf16;
typedef unsigned v4u __attribute__((ext_vector_type(4)));
typedef unsigned v2u __attribute__((ext_vector_type(2)));
typedef float f32x4 __attribute__((ext_vector_type(4)));
typedef float f32x16 __attribute__((ext_vector_type(16)));
typedef short bf16x8 __attribute__((ext_vector_type(8)));
#define LDS_WAIT() asm volatile("s_waitcnt lgkmcnt(0)" ::: "memory")
#define MFMA32(a, b, c) __builtin_amdgcn_mfma_f32_32x32x16_bf16((a), (b), (c), 0, 0, 0)
#define MFMA16(a, b, c) __builtin_amdgcn_mfma_f32_16x16x32_bf16((a), (b), (c), 0, 0, 0)
__device__ __forceinline__ unsigned pk2(float lo, float hi) { return pg8::cvt_pk_bf16(lo, hi); }
__device__ __forceinline__ float bflo(unsigned w) { return __uint_as_float(w << 16); }
__device__ __forceinline__ float bfhi(unsigned w) { return __uint_as_float(w & 0xffff0000u); }
__device__ __forceinline__ float bf1(bf16 h) { return __uint_as_float((unsigned)h << 16); }
__device__ __forceinline__ float fsig(float x) { return __builtin_amdgcn_rcpf(1.f + __builtin_amdgcn_exp2f(-1.44269504f * x)); }
__device__ __forceinline__ float fexp(float x) { return __builtin_amdgcn_exp2f(1.44269504f * x); }
__device__ __forceinline__ float gelu_tanh(float x) { const float t = 0.7978845608f * (x + 0.044715f * x * x * x); return x * fsig(2.f * t); }
__device__ __forceinline__ bf16x8 pack8(const float (&v)[8]) { v4u p; p.x = pk2(v[0], v[1]); p.y = pk2(v[2], v[3]); p.z = pk2(v[4], v[5]); p.w = pk2(v[6], v[7]); return __builtin_bit_cast(bf16x8, p); }
__device__ __forceinline__ float wave_sum(float v) {
#pragma unroll
    for (int o = 1; o < 64; o <<= 1) v += __shfl_xor(v, o);
    return v;
}
__device__ __forceinline__ float wave_max(float v) {
#pragma unroll
    for (int o = 1; o < 64; o <<= 1) v = fmaxf(v, __shfl_xor(v, o));
    return v;
}

struct Args { const float* in[33]; float* out; unsigned char* ws; int ph_lo, ph_hi; };

__device__ __forceinline__ void transpose_item64(const float* __restrict__ W, int N, int K, bf16* __restrict__ WT, int k0, int n0, int drow0, LAS float* scr, int lane) {
    f32x4 v[16];
#pragma unroll
    for (int i = 0; i < 16; ++i) v[i] = *(const f32x4*)(W + (size_t)(k0 + (lane >> 4) + 4 * i) * N + n0 + (lane & 15) * 4);
#pragma unroll
    for (int i = 0; i < 16; ++i) { LAS float* s = scr + ((lane >> 4) + 4 * i) * 65 + (lane & 15) * 4; s[0] = v[i].x; s[1] = v[i].y; s[2] = v[i].z; s[3] = v[i].w; }
    LDS_WAIT();
    const int c = lane & 7;
#pragma unroll
    for (int j = 0; j < 8; ++j) { const int n = (lane >> 3) + 8 * j; const LAS float* s = scr + (8 * c) * 65 + n;
        v4u o; o.x = pk2(s[0], s[65]); o.y = pk2(s[2 * 65], s[3 * 65]); o.z = pk2(s[4 * 65], s[5 * 65]); o.w = pk2(s[6 * 65], s[7 * 65]);
        *(v4u*)(WT + (size_t)(drow0 + n) * K + k0 + 8 * c) = o; }
    LDS_WAIT();
}
__device__ __forceinline__ void ada_item(const Args& A, int nb, LAS float* red, float* MOD, int tid, int wave, int lane) {
    const float* cpv = A.in[2]; const float* csv = A.in[3]; const float* W = A.in[8]; const float* bias = A.in[9];
    const int n0 = nb * 64, kq = lane >> 4, l15 = lane & 15;
    f32x4 acc[3][4];
#pragma unroll
    for (int bt = 0; bt < 3; ++bt)
#pragma unroll
        for (int nt = 0; nt < 4; ++nt) acc[bt][nt] = (f32x4){0.f, 0.f, 0.f, 0.f};
    for (int ks = 0; ks < 8; ++ks) {
        const int k0 = wave * 256 + ks * 32 + 8 * kq;
        bf16x8 af[3];
#pragma unroll
        for (int bt = 0; bt < 3; ++bt) { const int b = 16 * bt + l15; float v[8];
            if (b < NBROW) { const float* cp = (b < 2 ? cpv + (size_t)b * DM : csv + (size_t)(b - 2) * DM) + k0; const f32x4 x0 = *(const f32x4*)cp, x1 = *(const f32x4*)(cp + 4);
                v[0] = x0.x * fsig(x0.x); v[1] = x0.y * fsig(x0.y); v[2] = x0.z * fsig(x0.z); v[3] = x0.w * fsig(x0.w); v[4] = x1.x * fsig(x1.x); v[5] = x1.y * fsig(x1.y); v[6] = x1.z * fsig(x1.z); v[7] = x1.w * fsig(x1.w); }
            else {
#pragma unroll
                for (int e = 0; e < 8; ++e) v[e] = 0.f; }
            af[bt] = pack8(v); }
#pragma unroll
        for (int nt = 0; nt < 4; ++nt) { const float* wp = W + (size_t)k0 * MODW + n0 + 16 * nt + l15; float v[8];
#pragma unroll
            for (int e = 0; e < 8; ++e) v[e] = wp[(size_t)e * MODW];
            const bf16x8 bfr = pack8(v);
#pragma unroll
            for (int bt = 0; bt < 3; ++bt) acc[bt][nt] = MFMA16(af[bt], bfr, acc[bt][nt]); }
    }
#pragma unroll
    for (int bt = 0; bt < 3; ++bt)
#pragma unroll
        for (int nt = 0; nt < 4; ++nt)
#pragma unroll
            for (int r = 0; r < 4; ++r) red[(wave * 48 + bt * 16 + nt * 4 + r) * 64 + lane] = acc[bt][nt][r];
    __syncthreads();
    for (int v = tid; v < 48 * 64; v += NTHREADS) { const int ln = v & 63, q = v >> 6, bt = q >> 4, nt = (q >> 2) & 3, r = q & 3; float s = 0.f;
#pragma unroll
        for (int w = 0; w < 8; ++w) s += red[(w * 48 + q) * 64 + ln];
        const int b = 16 * bt + 4 * (ln >> 4) + r, n = n0 + 16 * nt + (ln & 15);
        if (b < NBROW) MOD[(size_t)b * MODW + n] = s + bias[n]; }
    __syncthreads();
}
__device__ __forceinline__ void p0_prologue(const Args& A, LAS unsigned char* lds, int tid, int wave, int lane) {
    unsigned char* ws = A.ws;
    const int G = gridDim.x, bx = blockIdx.x;
    { float* rope = (float*)(ws + WS_ROPE);
      for (int i = bx * NTHREADS + tid; i < 4097 * 32; i += G * NTHREADS) { const int p = i >> 5, f = i & 31; const float pos = p < 4096 ? (float)p : 16384.f;
          const float inv = exp2f(-(float)f * (13.287712379549449f / 32.f)); const float ang = pos * inv; rope[p * 64 + f] = cosf(ang); rope[p * 64 + 32 + f] = sinf(ang); } }
    for (int nb = bx; nb < MODW / 64; nb += G) ada_item(A, nb, (LAS float*)lds, (float*)(ws + WS_MOD), tid, wave, lane);
    LAS float* scr = (LAS float*)(lds + wave * 16640);
    const int gw = bx * NWAVES + wave, NGW = G * NWAVES;
#define TR_MAT(Wp, WTp, Kv, Nv, kind) { constexpr int nblk = (Nv) / 64, items = ((Kv) / 64) * nblk; if (r < items) { const int kb = r / nblk, n0 = (r % nblk) * 64; \
        const int dr = (kind) == 0 ? n0 : (256 * (n0 >> 7) + (n0 & 127) + ((kind) == 2 ? 128 : 0)); transpose_item64((Wp), (Nv), (Kv), (bf16*)(WTp), kb * 64, n0, dr, scr, lane); continue; } r -= items; }
    constexpr int TOTAL = 6 * (DM / 64) * (DFF / 64) + (DM / 64) * (DIN / 64) + 2 * (DATT / 64) * (DM / 64) + (DM / 64) * (DM / 64);
    for (int it = gw; it < TOTAL; it += NGW) {
        int r = it;
        TR_MAT(A.in[13], ws + WS_W13A, DM, DFF, 1)
        TR_MAT(A.in[14], ws + WS_W13A, DM, DFF, 2)
        TR_MAT(A.in[15], ws + WS_W2A, DFF, DM, 0)
        TR_MAT(A.in[16], ws + WS_W13B, DM, DFF, 1)
        TR_MAT(A.in[17], ws + WS_W13B, DM, DFF, 2)
        TR_MAT(A.in[18], ws + WS_W2B, DFF, DM, 0)
        TR_MAT(A.in[19], ws + WS_WIN, DM, DIN, 0)
        TR_MAT(A.in[30], ws + WS_WPA, DATT, DM, 0)
        TR_MAT(A.in[31], ws + WS_WPR, DRNN, DM, 0)
        TR_MAT(A.in[32], ws + WS_WOUT, DM, DM, 0)
    }
#undef TR_MAT
}
__device__ __forceinline__ void norm_phase(const float* xp, const float* xs, const float* g, const float* MOD, int chunk_shift, bf16* XN, int wave, int lane) {
    const int gw = blockIdx.x * NWAVES + wave, NGW = gridDim.x * NWAVES;
    for (int row = gw; row < MROWS; row += NGW) {
        v2u* o8 = (v2u*)(XN + (size_t)row * DM) + lane;
        const float* xr = row < MPROMPT ? xp + (size_t)row * DM : xs + (size_t)(row - MPROMPT) * DM;
        const int br = row < MPROMPT ? (row >> 12) : (2 + row - MPROMPT);
        const float* sh = MOD + (size_t)br * MODW + chunk_shift * DM; const float* sc = sh + DM;
        f32x4 v[8]; float ss = 0.f;
#pragma unroll
        for (int j = 0; j < 8; ++j) { v[j] = *((const f32x4*)xr + lane + 64 * j); ss += (v[j].x * v[j].x + v[j].y * v[j].y) + (v[j].z * v[j].z + v[j].w * v[j].w); }
        const float rstd = rsqrtf(wave_sum(ss) * (1.f / DM) + EPSN);
#pragma unroll
        for (int j = 0; j < 8; ++j) { const int c = (lane + 64 * j) * 4; const f32x4 gg = *(const f32x4*)(g + c), s1 = *(const f32x4*)(sc + c), s0 = *(const f32x4*)(sh + c);
            const f32x4 y = (v[j] * rstd) * gg * (s1 + 1.f) + s0; o8[64 * j] = (v2u){pk2(y.x, y.y), pk2(y.z, y.w)}; }
    }
}
template <int NT> __device__ __forceinline__ void sgemm_acc(const bf16* A, int lda, const bf16* Bt, int K, const int (&nrow)[NT], f32x16 (&acc)[NT], int wave, int lane) {
    const int hh = lane >> 5, l31 = lane & 31, kw = K >> 3;
    const bf16* ap = A + (size_t)l31 * lda + wave * kw + 8 * hh;
    const bf16* bp[NT];
#pragma unroll
    for (int t = 0; t < NT; ++t) { bp[t] = Bt + (size_t)(nrow[t] + l31) * K + wave * kw + 8 * hh;
#pragma unroll
        for (int r = 0; r < 16; ++r) acc[t][r] = 0.f; }
    for (int k = 0; k < kw; k += 64) {
        bf16x8 a[4], b[NT][4];
#pragma unroll
        for (int i = 0; i < 4; ++i) { a[i] = *(const bf16x8*)(ap + k + 16 * i);
#pragma unroll
            for (int t = 0; t < NT; ++t) b[t][i] = *(const bf16x8*)(bp[t] + k + 16 * i); }
#pragma unroll
        for (int i = 0; i < 4; ++i)
#pragma unroll
            for (int t = 0; t < NT; ++t) acc[t] = MFMA32(a[i], b[t][i], acc[t]);
    }
}
template <int NT> __device__ __forceinline__ void sgemm_reduce(const f32x16 (&acc)[NT], LAS float* red, float (&out)[NT][2], int wave, int lane) {
#pragma unroll
    for (int t = 0; t < NT; ++t)
#pragma unroll
        for (int r = 0; r < 16; ++r) red[((wave * NT + t) * 16 + r) * 64 + lane] = acc[t][r];
    __syncthreads();
#pragma unroll
    for (int t = 0; t < NT; ++t)
#pragma unroll
        for (int i = 0; i < 2; ++i) { float s = 0.f;
#pragma unroll
            for (int w = 0; w < 8; ++w) s += red[((w * NT + t) * 16 + wave + 8 * i) * 64 + lane];
            out[t][i] = s; }
    __syncthreads();
}
#define SG_M(i) (8 * ((wave + 8 * (i)) >> 2) + 4 * (lane >> 5) + ((wave + 8 * (i)) & 3))
__device__ __forceinline__ void sg_ffn_up(const bf16* XN, const bf16* W13, bf16* HB, int item, LAS float* red, int wave, int lane) {
    const int c0 = 32 * item, pn = c0 >> 7, cc = c0 & 127; const int nrow[2] = {256 * pn + cc, 256 * pn + 128 + cc};
    f32x16 acc[2]; float o[2][2];
    sgemm_acc<2>(XN + (size_t)MPROMPT * DM, DM, W13, DM, nrow, acc, wave, lane); sgemm_reduce<2>(acc, red, o, wave, lane);
#pragma unroll
    for (int i = 0; i < 2; ++i) { const int m = SG_M(i); HB[(size_t)(MPROMPT + m) * DFF + c0 + (lane & 31)] = (bf16)(pk2(o[0][i] * fsig(o[0][i]) * o[1][i], 0.f) & 0xffffu); }
}
__device__ __forceinline__ void sg_res(const bf16* Arow, int K, const bf16* Bt, const float* base, float* out, const float* gate, float gs, int item, LAS float* red, int wave, int lane) {
    const int nrow[1] = {32 * item}; f32x16 acc[1]; float o[1][2];
    sgemm_acc<1>(Arow, K, Bt, K, nrow, acc, wave, lane); sgemm_reduce<1>(acc, red, o, wave, lane);
#pragma unroll
    for (int i = 0; i < 2; ++i) { const int m = SG_M(i), c = 32 * item + (lane & 31); out[(size_t)m * DM + c] = base[(size_t)m * DM + c] + gs * gate[(size_t)(2 + m) * MODW + c] * o[0][i]; }
}
__device__ __forceinline__ void sg_z(const bf16* XN, const bf16* Win, bf16* ZB, int item, LAS float* red, int wave, int lane) {
    const int nrow[1] = {32 * item}; f32x16 acc[1]; float o[1][2];
    sgemm_acc<1>(XN + (size_t)MPROMPT * DM, DM, Win, DM, nrow, acc, wave, lane); sgemm_reduce<1>(acc, red, o, wave, lane);
#pragma unroll
    for (int i = 0; i < 2; ++i) { const int m = SG_M(i); ZB[(size_t)(MPROMPT + m) * DIN + 32 * item + (lane & 31)] = (bf16)(pk2(o[0][i], 0.f) & 0xffffu); }
}
__device__ __forceinline__ void sg_mix(const bf16* OATT, const bf16* ORNN, const bf16* Wpa, const bf16* Wpr, const bf16* ZB, bf16* MIX, int item, LAS float* red, int wave, int lane) {
    const int nrow[1] = {32 * item}; f32x16 acc[1]; float oa[1][2], orr[1][2];
    sgemm_acc<1>(OATT + (size_t)MPROMPT * DATT, DATT, Wpa, DATT, nrow, acc, wave, lane); sgemm_reduce<1>(acc, red, oa, wave, lane);
    sgemm_acc<1>(ORNN + (size_t)MPROMPT * DRNN, DRNN, Wpr, DRNN, nrow, acc, wave, lane); sgemm_reduce<1>(acc, red, orr, wave, lane);
#pragma unroll
    for (int i = 0; i < 2; ++i) { const int m = SG_M(i), c = 32 * item + (lane & 31); const bf16* zr = ZB + (size_t)(MPROMPT + m) * DIN;
        MIX[(size_t)(MPROMPT + m) * DM + c] = (bf16)(pk2(fsig(bf1(zr[ZGA + c])) * oa[0][i] + fsig(bf1(zr[ZGR + c])) * orr[0][i], 0.f) & 0xffffu); }
}
template <int XORD> __device__ __forceinline__ void norm_rope_row(const bf16* rowp, int hh, const float* g, const float* rp, float scale, float (&o)[4][8]) {
    float v[4][8]; float ss = 0.f;
#pragma unroll
    for (int ks = 0; ks < 4; ++ks) { const v4u w = *(const v4u*)(rowp + 8 * hh + 16 * ks);
        v[ks][0] = bflo(w.x); v[ks][1] = bfhi(w.x); v[ks][2] = bflo(w.y); v[ks][3] = bfhi(w.y); v[ks][4] = bflo(w.z); v[ks][5] = bfhi(w.z); v[ks][6] = bflo(w.w); v[ks][7] = bfhi(w.w);
#pragma unroll
        for (int e = 0; e < 8; ++e) ss += v[ks][e] * v[ks][e]; }
    ss += __shfl_xor(ss, XORD);
    const float rstd = rsqrtf(ss * (1.f / 64.f) + EPSN);
#pragma unroll
    for (int ks = 0; ks < 2; ++ks) { const int d0 = 8 * hh + 16 * ks;
        const f32x4 g0 = *(const f32x4*)(g + d0), g1 = *(const f32x4*)(g + d0 + 4), h0 = *(const f32x4*)(g + d0 + 32), h1 = *(const f32x4*)(g + d0 + 36);
        const f32x4 c0 = *(const f32x4*)(rp + d0), c1 = *(const f32x4*)(rp + d0 + 4), s0 = *(const f32x4*)(rp + 32 + d0), s1 = *(const f32x4*)(rp + 36 + d0);
#pragma unroll
        for (int e = 0; e < 8; ++e) { const float ga = e < 4 ? g0[e & 3] : g1[e & 3], gb = e < 4 ? h0[e & 3] : h1[e & 3], cc = e < 4 ? c0[e & 3] : c1[e & 3], sn = e < 4 ? s0[e & 3] : s1[e & 3];
            const float x1 = v[ks][e] * rstd * ga, x2 = v[ks + 2][e] * rstd * gb;
            o[ks][e] = (x1 * cc - x2 * sn) * scale; o[ks + 2][e] = (x2 * cc + x1 * sn) * scale; } }
}
constexpr int KS_STRIDE = 144, VT_STRIDE = 520, KS_BYTES = 256 * KS_STRIDE, VT_BYTES = 64 * VT_STRIDE;
__device__ __forceinline__ void attn_item(const Args& A, LAS unsigned char* lds, int b, int blk, int kvh, int tid, int wave, int lane) {
    unsigned char* ws = A.ws; const bf16* Z = (const bf16*)(ws + WS_HZ); const float* rope = (const float*)(ws + WS_ROPE); bf16* OATT = (bf16*)(ws + WS_OATT);
    LAS unsigned char* Ks = lds; LAS unsigned char* Vt = lds + KS_BYTES;
    {
        const int key = tid >> 1, hh = tid & 1, t = blk * 128 - 128 + key;
        if (t >= 0) {
            const bf16* zr = Z + (size_t)(b * SEQ + t) * DIN;
            float o[4][8]; norm_rope_row<1>(zr + ZK + kvh * 64, hh, A.in[21], rope + (size_t)t * 64, 1.f, o);
#pragma unroll
            for (int ks = 0; ks < 4; ++ks) *(LAS bf16x8*)(Ks + key * KS_STRIDE + (8 * hh + 16 * ks) * 2) = pack8(o[ks]);
            v4u vv[4];
#pragma unroll
            for (int i = 0; i < 4; ++i) vv[i] = *(const v4u*)(zr + ZV + kvh * 64 + 32 * hh + 8 * i);
#pragma unroll
            for (int i = 0; i < 4; ++i) { const unsigned wv[4] = {vv[i].x, vv[i].y, vv[i].z, vv[i].w};
#pragma unroll
                for (int e = 0; e < 4; ++e) { const int d = 32 * hh + 8 * i + 2 * e;
                    *(LAS bf16*)(Vt + d * VT_STRIDE + key * 2) = (bf16)(wv[e] & 0xffffu); *(LAS bf16*)(Vt + (d + 1) * VT_STRIDE + key * 2) = (bf16)(wv[e] >> 16); } }
            if (blk == SEQ / 128 - 1 && key >= 128) {
                float* kp = A.out + O_KP + ((size_t)(b * 128 + key - 128) * 4 + kvh) * 64; float* vp = A.out + O_VP + ((size_t)(b * 128 + key - 128) * 4 + kvh) * 64;
#pragma unroll
                for (int ks = 0; ks < 4; ++ks) { *(f32x4*)(kp + 8 * hh + 16 * ks) = (f32x4){o[ks][0], o[ks][1], o[ks][2], o[ks][3]}; *(f32x4*)(kp + 8 * hh + 16 * ks + 4) = (f32x4){o[ks][4], o[ks][5], o[ks][6], o[ks][7]}; }
#pragma unroll
                for (int i = 0; i < 4; ++i) { *(f32x4*)(vp + 32 * hh + 8 * i) = (f32x4){bflo(vv[i].x), bfhi(vv[i].x), bflo(vv[i].y), bfhi(vv[i].y)}; *(f32x4*)(vp + 32 * hh + 8 * i + 4) = (f32x4){bflo(vv[i].z), bfhi(vv[i].z), bflo(vv[i].w), bfhi(vv[i].w)}; }
            }
        } else {
#pragma unroll
            for (int ks = 0; ks < 4; ++ks) *(LAS v4u*)(Ks + key * KS_STRIDE + (8 * hh + 16 * ks) * 2) = (v4u){0u, 0u, 0u, 0u};
#pragma unroll
            for (int d = 0; d < 32; ++d) *(LAS bf16*)(Vt + (32 * hh + d) * VT_STRIDE + key * 2) = (bf16)0;
        }
    }
    __syncthreads();
    const int g = wave >> 1, head = kvh * 4 + g, hh = lane >> 5, l31 = lane & 31;
    const float sink = A.in[22][head];
#pragma unroll 1
    for (int qt = 0; qt < 2; ++qt) {
        const int i0 = (wave & 1) * 64 + 32 * qt, qi = i0 + l31, t = blk * 128 + qi; const size_t row = (size_t)b * SEQ + t;
        bf16x8 qf[4];
        { float o[4][8]; norm_rope_row<32>(Z + row * DIN + ZQ + head * 64, hh, A.in[20], rope + (size_t)t * 64, 0.125f, o);
#pragma unroll
          for (int ks = 0; ks < 4; ++ks) qf[ks] = pack8(o[ks]); }
        const int kt0 = i0 >> 5;
        f32x16 s[5];
#pragma unroll
        for (int kk = 0; kk < 5; ++kk) {
#pragma unroll
            for (int r = 0; r < 16; ++r) s[kk][r] = 0.f;
#pragma unroll
            for (int ks = 0; ks < 4; ++ks) { const bf16x8 kf = *(const LAS bf16x8*)(Ks + (32 * (kt0 + kk) + l31) * KS_STRIDE + (8 * hh + 16 * ks) * 2); s[kk] = MFMA32(kf, qf[ks], s[kk]); } }
        float mx = sink;
#pragma unroll
        for (int kk = 0; kk < 5; ++kk)
#pragma unroll
            for (int r = 0; r < 16; ++r) { const int j = 32 * (kt0 + kk) + 8 * (r >> 2) + 4 * hh + (r & 3); const bool ok = (j > qi) && (j <= qi + 128) && (blk > 0 || j >= 128);
                s[kk][r] = ok ? s[kk][r] : -INFINITY; mx = fmaxf(mx, s[kk][r]); }
        mx = fmaxf(mx, __shfl_xor(mx, 32));
        float l = 0.f;
#pragma unroll
        for (int kk = 0; kk < 5; ++kk)
#pragma unroll
            for (int r = 0; r < 16; ++r) { const float p = fexp(s[kk][r] - mx); s[kk][r] = p; l += p; }
        l += __shfl_xor(l, 32);
        const float inv = 1.f / (l + fexp(sink - mx));
        f32x16 oacc[2];
#pragma unroll
        for (int dt = 0; dt < 2; ++dt)
#pragma unroll
            for (int r = 0; r < 16; ++r) oacc[dt][r] = 0.f;
#pragma unroll
        for (int kk = 0; kk < 5; ++kk)
#pragma unroll
            for (int s2 = 0; s2 < 2; ++s2) { float pv[8];
#pragma unroll
                for (int e = 0; e < 8; ++e) pv[e] = s[kk][8 * s2 + e];
                const bf16x8 pf = pack8(pv);
#pragma unroll
                for (int dt = 0; dt < 2; ++dt) { const LAS unsigned char* vp = Vt + (32 * dt + l31) * VT_STRIDE + (32 * (kt0 + kk) + 16 * s2 + 4 * hh) * 2;
                    const v2u lo = *(const LAS v2u*)vp, hi = *(const LAS v2u*)(vp + 16); const v4u a4 = (v4u){lo.x, lo.y, hi.x, hi.y};
                    oacc[dt] = MFMA32(__builtin_bit_cast(bf16x8, a4), pf, oacc[dt]); } }
        bf16* op = OATT + row * DATT + head * 64;
#pragma unroll
        for (int dt = 0; dt < 2; ++dt)
#pragma unroll
            for (int g4 = 0; g4 < 4; ++g4) *(v2u*)(op + 32 * dt + 8 * g4 + 4 * hh) = (v2u){pk2(oacc[dt][4 * g4] * inv, oacc[dt][4 * g4 + 1] * inv), pk2(oacc[dt][4 * g4 + 2] * inv, oacc[dt][4 * g4 + 3] * inv)};
    }
    __syncthreads();
}
__device__ __forceinline__ void attn_sample_item(const Args& A, LAS float* wl  , int bs, int head, int lane) {
    unsigned char* ws = A.ws; const bf16* Z = (const bf16*)(ws + WS_HZ); const float* rp = (const float*)(ws + WS_ROPE) + (size_t)4096 * 64; bf16* OATT = (bf16*)(ws + WS_OATT);
    const int kvh = head >> 2, d = lane, f = d & 31; const size_t row = MPROMPT + bs;
    const bf16* zr = Z + row * DIN;
    const float cs = rp[f], sn = rp[32 + f];
    float q = bf1(zr[ZQ + head * 64 + d]); { const float rstd = rsqrtf(wave_sum(q * q) * (1.f / 64.f) + EPSN); q = q * rstd * A.in[20][d]; const float qo = __shfl_xor(q, 32); q = (d < 32 ? q * cs - qo * sn : q * cs + qo * sn) * 0.125f; }
    float kn = bf1(zr[ZK + kvh * 64 + d]); { const float rstd = rsqrtf(wave_sum(kn * kn) * (1.f / 64.f) + EPSN); kn = kn * rstd * A.in[21][d]; const float ko = __shfl_xor(kn, 32); kn = d < 32 ? kn * cs - ko * sn : kn * cs + ko * sn; }
    const float vn = bf1(zr[ZV + kvh * 64 + d]);
    if ((head & 3) == 0) { A.out[O_KS + ((size_t)bs * 4 + kvh) * 64 + d] = kn; A.out[O_VS + ((size_t)bs * 4 + kvh) * 64 + d] = vn; }
    const float snew = wave_sum(q * kn);
    wl[d] = q; LDS_WAIT();
    const float* ck = A.in[4] + (size_t)bs * 128 * 256 + kvh * 64; const float* cv = A.in[5] + (size_t)bs * 128 * 256 + kvh * 64;
    float s0 = 0.f, s1 = 0.f;
    { const float* k0 = ck + (size_t)lane * 256; const float* k1 = ck + (size_t)(lane + 64) * 256;
#pragma unroll
      for (int i = 0; i < 16; ++i) { const f32x4 qv = *(const LAS f32x4*)(wl + 4 * i), a = *(const f32x4*)(k0 + 4 * i), c = *(const f32x4*)(k1 + 4 * i);
          s0 += (qv.x * a.x + qv.y * a.y) + (qv.z * a.z + qv.w * a.w); s1 += (qv.x * c.x + qv.y * c.y) + (qv.z * c.z + qv.w * c.w); } }
    if (lane == 0) s0 = snew;
    const float sink = A.in[22][head];
    const float mx = fmaxf(wave_max(fmaxf(s0, s1)), sink);
    const float p0 = fexp(s0 - mx), p1 = fexp(s1 - mx);
    const float inv = 1.f / (wave_sum(p0 + p1) + fexp(sink - mx));
    wl[64 + lane] = p0; wl[128 + lane] = p1; LDS_WAIT();
    float o = wl[64] * vn;
#pragma unroll 8
    for (int j = 1; j < 128; ++j) o += wl[64 + j] * cv[(size_t)j * 256 + d];
    OATT[row * DATT + head * 64 + d] = (bf16)(pk2(o * inv, 0.f) & 0xffffu);
    LDS_WAIT();
}
template <bool FINAL> __device__ __forceinline__ void rnn_item(const Args& A, LAS float* xcs  , int b, int c, int wave, int lane) {
    unsigned char* ws = A.ws; const bf16* Z = (const bf16*)(ws + WS_HZ); bf16* ORNN = (bf16*)(ws + WS_ORNN); float* CA = (float*)(ws + WS_CA); float* CH = (float*)(ws + WS_CH);
    const int hh = lane >> 5, l31 = lane & 31, t00 = c * TCHUNK;
#pragma unroll 1
    for (int hb2 = 0; hb2 < 2; ++hb2) {
        const int hb = 2 * wave + hb2, ch = hb * 64 + lane;
        {
            const float cw0 = A.in[23][ch], cw1 = A.in[23][DRNN + ch], cw2 = A.in[23][2 * DRNN + ch], cw3 = A.in[23][3 * DRNN + ch], cb = A.in[24][ch];
            const bf16* zc = Z + (size_t)b * SEQ * DIN + ZRX + ch;
            float x3 = t00 >= 3 ? bf1(zc[(size_t)(t00 - 3) * DIN]) : 0.f, x2 = t00 >= 2 ? bf1(zc[(size_t)(t00 - 2) * DIN]) : 0.f, x1 = t00 >= 1 ? bf1(zc[(size_t)(t00 - 1) * DIN]) : 0.f;
#pragma unroll 8
            for (int k = 0; k < TCHUNK; ++k) { const float x0 = bf1(zc[(size_t)(t00 + k) * DIN]); xcs[k * 65 + lane] = cb + cw3 * x0 + cw2 * x1 + cw1 * x2 + cw0 * x3; x3 = x2; x2 = x1; x1 = x0; }
            if (FINAL && c == NCHUNK - 1) { A.out[O_CP + ((size_t)b * 3 + 0) * DRNN + ch] = x3; A.out[O_CP + ((size_t)b * 3 + 1) * DRNN + ch] = x2; A.out[O_CP + ((size_t)b * 3 + 2) * DRNN + ch] = x1; }
        }
        LDS_WAIT();
#pragma unroll 1
        for (int nt = 0; nt < 2; ++nt) {
            const int j = hb * 64 + 32 * nt + l31;
            bf16x8 wf[2][4];
#pragma unroll
            for (int gt = 0; gt < 2; ++gt) { const float* wg = A.in[gt == 0 ? 25 : 27] + (size_t)hb * 4096 + 32 * nt + l31;
#pragma unroll
                for (int ks = 0; ks < 4; ++ks) { float v[8];
#pragma unroll
                    for (int e = 0; e < 8; ++e) v[e] = wg[(8 * hh + 16 * ks + e) * 64];
                    wf[gt][ks] = pack8(v); } }
            const float brg = A.in[26][j], big = A.in[28][j], sp = log1pf(expf(-A.in[29][j]));
            float H = 0.f, Ap = 1.f;
            if (FINAL) { for (int cc = 0; cc < c; ++cc) { const size_t o = ((size_t)b * NCHUNK + cc) * DRNN + j; H = CA[o] * H + CH[o]; } }
#pragma unroll 1
            for (int tt = 0; tt < 2; ++tt) {
                const int t0 = t00 + 32 * tt;
                f32x16 ar, ai;
#pragma unroll
                for (int r = 0; r < 16; ++r) { ar[r] = 0.f; ai[r] = 0.f; }
#pragma unroll
                for (int ks = 0; ks < 4; ++ks) { float v[8];
#pragma unroll
                    for (int e = 0; e < 8; ++e) v[e] = xcs[(32 * tt + l31) * 65 + 8 * hh + 16 * ks + e];
                    const bf16x8 af = pack8(v); ar = MFMA32(af, wf[0][ks], ar); ai = MFMA32(af, wf[1][ks], ai); }
                float rgv[16];
                if (FINAL) {
#pragma unroll
                    for (int r = 0; r < 16; ++r) { const int tk = 8 * (r >> 2) + 4 * hh + (r & 3); rgv[r] = bf1(Z[((size_t)b * SEQ + t0 + tk) * DIN + ZRG + j]); } }
#pragma unroll
                for (int r = 0; r < 16; ++r) { const int tk = 8 * (r >> 2) + 4 * hh + (r & 3);
                    const float rg_ = fsig(ar[r] + brg), ig_ = fsig(ai[r] + big); const float la = -8.f * rg_ * sp; const float a = fexp(la);
                    const float mult = sqrtf(fmaxf(-expm1f(2.f * la), 0.f)); ar[r] = a; ai[r] = mult * ig_ * xcs[(32 * tt + tk) * 65 + 32 * nt + l31]; }
                float Hs[4];
#pragma unroll
                for (int g4 = 0; g4 < 4; ++g4) { float Aa = 1.f, U = 0.f;
#pragma unroll
                    for (int r4 = 0; r4 < 4; ++r4) { const float a = ar[4 * g4 + r4]; U = a * U + ai[4 * g4 + r4]; Aa *= a; }
                    const float pA = __shfl_xor(Aa, 32), pU = __shfl_xor(U, 32);
                    const float A0 = hh == 0 ? Aa : pA, U0 = hh == 0 ? U : pU, A1 = hh == 0 ? pA : Aa, U1 = hh == 0 ? pU : U;
                    const float Hs0 = H; H = A0 * H + U0; const float Hs1 = H; H = A1 * H + U1; Hs[g4] = hh == 0 ? Hs0 : Hs1; Ap *= A0 * A1; }
                if (FINAL) {
#pragma unroll
                    for (int g4 = 0; g4 < 4; ++g4) { float h = Hs[g4];
#pragma unroll
                        for (int r4 = 0; r4 < 4; ++r4) { const int r = 4 * g4 + r4, tk = 8 * g4 + 4 * hh + r4; h = ar[r] * h + ai[r];
                            ORNN[((size_t)b * SEQ + t0 + tk) * DRNN + j] = (bf16)(pk2(h * gelu_tanh(rgv[r]), 0.f) & 0xffffu); } } }
            }
            if (!FINAL) { if (hh == 0) { const size_t o = ((size_t)b * NCHUNK + c) * DRNN + j; CA[o] = Ap; CH[o] = H; } }
            else if (c == NCHUNK - 1 && hh == 0) A.out[O_HP + (size_t)b * DRNN + j] = H;
        }
        LDS_WAIT();
    }
}
__device__ __forceinline__ void rnn_sample_item(const Args& A, int bs, int hb, int lane) {
    unsigned char* ws = A.ws; const bf16* Z = (const bf16*)(ws + WS_HZ); bf16* ORNN = (bf16*)(ws + WS_ORNN);
    const int ch = hb * 64 + lane; const size_t row = MPROMPT + bs;
    const float* sc = A.in[7] + (size_t)bs * 3 * DRNN + ch; const float b0 = sc[0], b1 = sc[DRNN], b2 = sc[2 * DRNN];
    const float rx = bf1(Z[row * DIN + ZRX + ch]), rg = bf1(Z[row * DIN + ZRG + ch]);
    const float xc = A.in[24][ch] + A.in[23][ch] * b0 + A.in[23][DRNN + ch] * b1 + A.in[23][2 * DRNN + ch] * b2 + A.in[23][3 * DRNN + ch] * rx;
    const float* wr = A.in[25] + (size_t)hb * 4096 + lane; const float* wi = A.in[27] + (size_t)hb * 4096 + lane;
    float ar = A.in[26][ch], ai = A.in[28][ch];
#pragma unroll 16
    for (int i = 0; i < 64; ++i) { const float xi = __shfl(xc, i); ar += xi * wr[i * 64]; ai += xi * wi[i * 64]; }
    const float rg_ = fsig(ar), ig_ = fsig(ai), la = -8.f * rg_ * log1pf(expf(-A.in[29][ch])), a = expf(la), mult = sqrtf(fmaxf(-expm1f(2.f * la), 0.f));
    const float h = a * A.in[6][(size_t)bs * DRNN + ch] + mult * ig_ * xc;
    A.out[O_HS + (size_t)bs * DRNN + ch] = h;
    ORNN[row * DRNN + ch] = (bf16)(pk2(h * gelu_tanh(rg), 0.f) & 0xffffu);
    float* co = A.out + O_CS + (size_t)bs * 3 * DRNN + ch; co[0] = b1; co[DRNN] = b2; co[2 * DRNN] = rx;
}

#define XB_TMO      128
#define XB_XCNT(j)  (256  + 64 * (j))
#define XB_XSUB(j)  (1280 + 64 * (j))
#define XB_XGEN(j)  (2304 + 64 * (j))
#define XB_TOP      3328
#define XB_TOPGEN   3392
#define XCD_BAR_WORDS 3456
#define XB_SPIN_CAP (1u << 18)

__device__ __forceinline__ unsigned xb_ld(unsigned* p)              { return __hip_atomic_load(p, __ATOMIC_RELAXED, __HIP_MEMORY_SCOPE_AGENT); }
__device__ __forceinline__ unsigned xb_add(unsigned* p, unsigned v) { return __hip_atomic_fetch_add(p, v, __ATOMIC_RELAXED, __HIP_MEMORY_SCOPE_AGENT); }
__device__ __forceinline__ unsigned xb_xcc_id() { return (unsigned)__builtin_amdgcn_s_getreg((3 << 11) | 20) & 0xFu; }
#define XB_SPIN(cond, bar) do { unsigned _sp = 0; while (cond) { __builtin_amdgcn_s_sleep(1); \
    if ((++_sp & 255u) == 0u) { if (xb_ld(&(bar)[XB_TMO])) break; if (_sp > XB_SPIN_CAP) { atomicAdd(&(bar)[XB_TMO], 1u); break; } } } } while (0)

struct XcdBarrier {
    unsigned* bar; unsigned x;
    volatile LAS unsigned* st;
};

__device__ __forceinline__ XcdBarrier xcd_barrier_post(unsigned* bar, volatile LAS unsigned* st) {
    XcdBarrier b; b.bar = bar; b.x = xb_xcc_id(); b.st = st;
    if (threadIdx.x == 0) (void)xb_add(&bar[XB_XCNT(b.x)], 1u);
    return b;
}
__device__ __forceinline__ void xcd_barrier_complete(unsigned* bar, unsigned x, unsigned& nloc, unsigned& nx) {
    const unsigned G = gridDim.x * gridDim.y * gridDim.z;
    unsigned sum, cnt, mine, sp = 0u;
    for (;;) {
        sum = 0u; cnt = 0u; mine = 0u;
#pragma unroll
        for (unsigned j = 0; j < 16; ++j) { const unsigned c = xb_ld(&bar[XB_XCNT(j)]); sum += c; cnt += (c > 0u) ? 1u : 0u; mine = (j == x) ? c : mine; }
        if (sum == G) break;
        __builtin_amdgcn_s_sleep(1);
        if ((++sp & 255u) == 0u) { if (xb_ld(&bar[XB_TMO])) break; if (sp > XB_SPIN_CAP) { atomicAdd(&bar[XB_TMO], 1u); break; } }
    }
    nloc = mine > 0u ? mine : 1u; nx = cnt > 0u ? cnt : 1u;
}

__device__ __forceinline__ void xcd_barrier(const XcdBarrier& b) {
    asm volatile("s_waitcnt vmcnt(0)" ::: "memory");
    __syncthreads();
    if (threadIdx.x == 0) {
        unsigned* bar = b.bar;
        __builtin_amdgcn_s_waitcnt(0);
        unsigned nloc = b.st[0], nx = b.st[1];
        if (nloc == 0u) { xcd_barrier_complete(bar, b.x, nloc, nx); b.st[0] = nloc; b.st[1] = nx; }
        const unsigned old = xb_add(&bar[XB_XSUB(b.x)], 1u);
        const unsigned gen = old / nloc;
        if (old + 1u == (gen + 1u) * nloc) {
            __builtin_amdgcn_fence(__ATOMIC_RELEASE, "agent");
            asm volatile("s_waitcnt vmcnt(0)" ::: "memory");
            const unsigned og = xb_add(&bar[XB_TOP], 1u);
            const unsigned tg = og / nx;
            if (og + 1u == (tg + 1u) * nx) xb_add(&bar[XB_TOPGEN], 1u);
            else XB_SPIN(xb_ld(&bar[XB_TOPGEN]) == tg, bar);
            __builtin_amdgcn_fence(__ATOMIC_ACQUIRE, "agent");
            xb_add(&bar[XB_XGEN(b.x)], 1u);
            asm volatile("s_waitcnt vmcnt(0)" ::: "memory");
        } else {
            XB_SPIN(xb_ld(&bar[XB_XGEN(b.x)]) == gen, bar);
            __builtin_amdgcn_fence(__ATOMIC_ACQUIRE, "agent");
            asm volatile("s_waitcnt vmcnt(0)" ::: "memory");
        }
    }
    __syncthreads();
}

__global__ void __launch_bounds__(NTHREADS, 2) mk_fwd(Args args) {
    extern __shared__ __attribute__((aligned(16))) unsigned char lds_raw[];
    LAS unsigned char* lds = (LAS unsigned char*)lds_raw;
    const int tid = threadIdx.x, lane = tid & 63, wave = __builtin_amdgcn_readfirstlane(tid >> 6);
    const int G = gridDim.x, bx = blockIdx.x;
    unsigned char* ws = args.ws;
    const int lo = args.ph_lo, hi = args.ph_hi;
    if (tid < 16) ((LAS unsigned*)(lds + MISC_OFF))[tid] = 0u;
    __syncthreads();
    if (hi > 1000) cg::this_grid().sync();
    XcdBarrier bar; bar.bar = (unsigned*)(ws + WS_BAR); bar.x = 0; bar.st = nullptr;
    if (hi - lo > 1) bar = xcd_barrier_post((unsigned*)(ws + WS_BAR), (volatile LAS unsigned*)(lds + MISC_OFF));
    bf16* XN = (bf16*)(ws + WS_XN); bf16* HB = (bf16*)(ws + WS_HZ); bf16* ZB = (bf16*)(ws + WS_HZ); float* XB = (float*)(ws + WS_X); float* MOD = (float*)(ws + WS_MOD);
    bf16* OATT = (bf16*)(ws + WS_OATT); bf16* ORNN = (bf16*)(ws + WS_ORNN); bf16* MIX = (bf16*)(ws + WS_MIX);
#ifndef PH_MASK
#define PH_MASK 0x1fff
#endif
#define IN(k) (((PH_MASK >> (k)) & 1) && lo <= (k) && (k) < hi)
#define SEAM(k) do { if (IN(k) && IN((k) + 1)) { xcd_barrier(bar); } } while (0)

    if (IN(0)) { p0_prologue(args, lds, tid, wave, lane); } SEAM(0);
    if (IN(1)) { norm_phase(args.in[0], args.in[1], args.in[10], MOD, 0, XN, wave, lane); } SEAM(1);
    LAS float* red = (LAS float*)lds;
    const float* MODS = MOD;
    if (IN(2)) { for (int it = bx - 128; it >= 0 && it < DFF / 32; it += 128) sg_ffn_up(XN, (const bf16*)(ws + WS_W13A), HB, it, red, wave, lane);
        pg8::Gemm g{XN, (const bf16*)(ws + WS_W13A), MPROMPT, 2 * DFF, DM}; pg8::StaticOrder S; S.init(MPROMPT, 2 * DFF, G, bx); pg8::EpiSwiGLU E{HB, DFF};
        pg8::gemm_phase<pg8::EpiSwiGLU, pg8::StaticOrder, true, true>(lds, g, S, E); } SEAM(2);
    if (IN(3)) { for (int it = bx; it < DM / 32; it += G) sg_res(HB + (size_t)MPROMPT * DFF, DFF, (const bf16*)(ws + WS_W2A), args.in[1], XB + (size_t)MPROMPT * DM, MODS + 2 * DM, 0.5f, it, red, wave, lane);
        pg8::Gemm g{HB, (const bf16*)(ws + WS_W2A), MPROMPT, DM, DFF}; pg8::StaticOrder S; S.init(MPROMPT, DM, G, bx); pg8::EpiRes E{args.in[0], args.in[1], XB, MOD + 2 * DM, 0.5f};
        pg8::gemm_phase<pg8::EpiRes, pg8::StaticOrder, true, true>(lds, g, S, E); } SEAM(3);
    if (IN(4)) { norm_phase(XB, XB + (size_t)MPROMPT * DM, args.in[11], MOD, 3, XN, wave, lane); } SEAM(4);
    if (IN(5)) { for (int it = bx - 192; it >= 0 && it < DIN / 32; it += 64) sg_z(XN, (const bf16*)(ws + WS_WIN), ZB, it, red, wave, lane);
        pg8::Gemm g{XN, (const bf16*)(ws + WS_WIN), MPROMPT, DIN, DM}; pg8::StaticOrder S; S.init(MPROMPT, DIN, G, bx); pg8::EpiBf16<0> E{ZB, DIN, nullptr, 0, 0, 1.f};
        pg8::gemm_phase<pg8::EpiBf16<0>, pg8::StaticOrder, true, true>(lds, g, S, E); } SEAM(5);
    if (IN(6)) {
#ifndef NO_ATTN
        for (int it = bx; it < 256; it += G) attn_item(args, lds, it >> 7, (it >> 2) & 31, it & 3, tid, wave, lane);
#endif
#ifndef NO_RNN
        for (int it = bx; it < 2 * NCHUNK; it += G) rnn_item<false>(args, (LAS float*)(lds + wave * 16640), it / NCHUNK, it % NCHUNK, wave, lane);
#endif
        __syncthreads();
#ifndef NO_SATTN
        for (int it = (G - 1 - bx) * NWAVES + wave; it < NSAMP * 16; it += G * NWAVES) attn_sample_item(args, (LAS float*)(lds + wave * 768), it >> 4, it & 15, lane);
#endif
    } SEAM(6);
    if (IN(7)) {
        for (int it = bx; it < 2 * NCHUNK; it += G) rnn_item<true>(args, (LAS float*)(lds + wave * 16640), it / NCHUNK, it % NCHUNK, wave, lane);
        for (int it = (G - 1 - bx) * NWAVES + wave; it < NSAMP * 16; it += G * NWAVES) rnn_sample_item(args, it >> 4, it & 15, lane);
        __syncthreads();
        pg8::Gemm g{OATT, (const bf16*)(ws + WS_WPA), MPROMPT, DM, DATT}; pg8::StaticOrder S; S.init(MPROMPT, DM, G, bx); pg8::EpiGateMix<false> E{MIX, ZB + ZGA};
        pg8::gemm_phase<pg8::EpiGateMix<false>, pg8::StaticOrder, true, true>(lds, g, S, E); } SEAM(7);
    if (IN(8)) { for (int it = bx; it < DM / 32; it += G) sg_mix(OATT, ORNN, (const bf16*)(ws + WS_WPA), (const bf16*)(ws + WS_WPR), ZB, MIX, it, red, wave, lane);
        pg8::Gemm g{ORNN, (const bf16*)(ws + WS_WPR), MPROMPT, DM, DRNN}; pg8::StaticOrder S; S.init(MPROMPT, DM, G, bx); pg8::EpiGateMix<true> E{MIX, ZB + ZGR};
        pg8::gemm_phase<pg8::EpiGateMix<true>, pg8::StaticOrder, true, true>(lds, g, S, E); } SEAM(8);
    if (IN(9)) { for (int it = bx; it < DM / 32; it += G) sg_res(MIX + (size_t)MPROMPT * DM, DM, (const bf16*)(ws + WS_WOUT), XB + (size_t)MPROMPT * DM, XB + (size_t)MPROMPT * DM, MODS + 5 * DM, 1.f, it, red, wave, lane);
        pg8::Gemm g{MIX, (const bf16*)(ws + WS_WOUT), MPROMPT, DM, DM}; pg8::StaticOrder S; S.init(MPROMPT, DM, G, bx); pg8::EpiRes E{XB, XB + (size_t)MPROMPT * DM, XB, MOD + 5 * DM, 1.f};
        pg8::gemm_phase<pg8::EpiRes, pg8::StaticOrder, true, true>(lds, g, S, E); } SEAM(9);
    if (IN(10)) { norm_phase(XB, XB + (size_t)MPROMPT * DM, args.in[12], MOD, 6, XN, wave, lane); } SEAM(10);
    if (IN(11)) { for (int it = bx - 128; it >= 0 && it < DFF / 32; it += 128) sg_ffn_up(XN, (const bf16*)(ws + WS_W13B), HB, it, red, wave, lane);
        pg8::Gemm g{XN, (const bf16*)(ws + WS_W13B), MPROMPT, 2 * DFF, DM}; pg8::StaticOrder S; S.init(MPROMPT, 2 * DFF, G, bx); pg8::EpiSwiGLU E{HB, DFF};
        pg8::gemm_phase<pg8::EpiSwiGLU, pg8::StaticOrder, true, true>(lds, g, S, E); } SEAM(11);
    if (IN(12)) { for (int it = bx; it < DM / 32; it += G) sg_res(HB + (size_t)MPROMPT * DFF, DFF, (const bf16*)(ws + WS_W2B), XB + (size_t)MPROMPT * DM, args.out + O_Y + (size_t)MPROMPT * DM, MODS + 8 * DM, 0.5f, it, red, wave, lane);
        pg8::Gemm g{HB, (const bf16*)(ws + WS_W2B), MPROMPT, DM, DFF}; pg8::StaticOrder S; S.init(MPROMPT, DM, G, bx); pg8::EpiRes E{XB, XB + (size_t)MPROMPT * DM, args.out + O_Y, MOD + 8 * DM, 0.5f};
        pg8::gemm_phase<pg8::EpiRes, pg8::StaticOrder, true, true>(lds, g, S, E); }
#undef IN
#undef SEAM
}

extern "C" void kernel_launch(void* const* d_in, const int* in_sizes, int n_in, void* d_out, int out_size, void* d_ws, size_t ws_size, hipStream_t stream) {
    static int grid = 0;
    if (grid == 0) {
        if (n_in != 33 || out_size != (int)O_END || ws_size < WS_END) { fprintf(stderr, "kernel_launch: unexpected shapes: n_in %d out %d ws %zu\n", n_in, out_size, ws_size); grid = -1; return; }
        int dev = 0, cus = 0, per_cu = 0;
        hipGetDevice(&dev); hipDeviceGetAttribute(&cus, hipDeviceAttributeMultiprocessorCount, dev);
        hipFuncSetAttribute((const void*)mk_fwd, hipFuncAttributeMaxDynamicSharedMemorySize, LDS_BYTES);
        hipOccupancyMaxActiveBlocksPerMultiprocessor(&per_cu, (const void*)mk_fwd, NTHREADS, LDS_BYTES);
        if (per_cu < 1) { fprintf(stderr, "kernel_launch: occupancy query says %d blocks per CU\n", per_cu); grid = -1; return; }
        grid = cus;
    }
    if (grid < 0) return;
    Args a{};
    for (int i = 0; i < 33; ++i) a.in[i] = (const float*)d_in[i];
    a.out = (float*)d_out; a.ws = (unsigned char*)d_ws;
#if MK_ONE_LAUNCH
    if (hipMemsetAsync((char*)d_ws + WS_BAR, 0, 65536, stream) != hipSuccess) { fprintf(stderr, "memset failed\n"); return; }
    a.ph_lo = 0; a.ph_hi = 13;
    void* kargs[] = {&a};
    hipError_t e = hipLaunchCooperativeKernel((const void*)mk_fwd, dim3(grid), dim3(NTHREADS), kargs, LDS_BYTES, stream);
    if (e != hipSuccess) fprintf(stderr, "cooperative launch failed: %s (grid %d)\n", hipGetErrorString(e), grid);
#else
    for (int p = 0; p < 13; ++p) { a.ph_lo = p; a.ph_hi = p + 1; hipLaunchKernelGGL(mk_fwd, dim3(grid), dim3(NTHREADS), LDS_BYTES, stream, a); }
#endif
}
```

```cpp
#include <hip/hip_runtime.h>
#include <hip/hip_cooperative_groups.h>
#include <cstdio>
#include <cstdint>
#include <cmath>
namespace pg8 {
#define PG8_LAS __attribute__((address_space(3)))
typedef unsigned short bf16_t;
typedef short bf16x8 __attribute__((ext_vector_type(8)));
typedef float f32x4 __attribute__((ext_vector_type(4)));
typedef unsigned u32x4 __attribute__((ext_vector_type(4)));
constexpr int BM = 256, BK = 64, HALF = 128, HTB = HALF * BK * 2  , STAGE_BYTES = 8 * HTB, NXCD = 8, WGM = 8;

__host__ __device__ __forceinline__ int lds_byte(int r, int c) { const int st = (r >> 4) * 2 + (c >> 5), rr = r & 15, cc = c & 31, ob = rr * 64 + cc * 2; return st * 1024 + (ob ^ (((ob >> 9) & 1) << 5)); }
__host__ __device__ __forceinline__ void stage_rc(int b, int& R, int& C) { const int st = b / 1024, sb = b % 1024, swz = sb ^ (((sb >> 9) & 1) << 5); R = (st >> 1) * 16 + swz / 64; C = (st & 1) * 32 + (swz % 64) / 2; }
__host__ __device__ __forceinline__ int perm32(int rho) { const int n = rho >> 4, i = rho & 15; return 8 * (i >> 2) + 4 * n + (i & 3); }

struct Unit { int pm, pn; };
struct Gemm { const bf16_t* A; const bf16_t* Bt; int M, N, K; };

struct StaticOrder {
    int nM, nN, nwg, G, c;
    __host__ __device__ void init(int M, int N, int G_, int c_) { nM = M / BM; nN = N / BM; nwg = nM * nN; G = G_; c = c_; }
    __host__ __device__ bool next(int i, Unit& u) const {
        const long L = (long)i * G + c; if (L >= nwg) return false;
        int wgid = (int)L; { const int q = nwg / NXCD, r = nwg % NXCD, xcd = wgid % NXCD, off = wgid / NXCD; wgid = (xcd < r ? xcd * (q + 1) : r * (q + 1) + (xcd - r) * q) + off; }
        const int nig = WGM * nN, gid = wgid / nig, fm = gid * WGM, gsz = (nM - fm) < WGM ? (nM - fm) : WGM;
        u.pm = fm + ((wgid % nig) % gsz); u.pn = (wgid % nig) / gsz; return true;
    }
    __device__ __forceinline__ void a_ready(const Unit&) const {}
    __device__ __forceinline__ void done(const Unit&) const {}
};

__device__ __forceinline__ unsigned cvt_pk_bf16(float lo, float hi) { unsigned r; asm volatile("v_cvt_pk_bf16_f32 %0, %1, %2" : "=v"(r) : "v"(lo), "v"(hi)); return r; }
typedef float f32x2 __attribute__((ext_vector_type(2)));
__device__ __forceinline__ f32x2 gelu_pk(f32x2 v) {
    const f32x2 av = __builtin_elementwise_abs(v), d = av * 0.2316418882f + 1.0f;
    f32x2 t; t.x = __builtin_amdgcn_rcpf(d.x); t.y = __builtin_amdgcn_rcpf(d.y);
    f32x2 q = t * 0.5307027145f + (-0.7265760135f); q = q * t + 0.7107068705f; q = q * t + (-0.142248368f); q = q * t + 0.127414796f; q = q * t;
    const f32x2 s = (v * v) * (-0.72134752044f);
    f32x2 e; e.x = __builtin_amdgcn_exp2f(s.x); e.y = __builtin_amdgcn_exp2f(s.y);
    const f32x2 m = v * (q * e), r = v - m;
    f32x2 o; o.x = v.x < 0.f ? m.x : r.x; o.y = v.y < 0.f ? m.y : r.y; return o;
}

template <int ACT  > struct EpiBf16 {
    static constexpr bool PERM = true, AFTER_DRAIN = false; static_assert(ACT == 0 || ACT == 1, "EpiBf16: ACT is 0 (none) or 1 (gelu_pk)");
    bf16_t* O; int ldc; const float* bias; int split_cols; size_t split_stride; float scale0;
    __device__ __forceinline__ void operator()(const f32x4 (&acc)[2][2][4][2], const Unit& u, int wr, int wc, int fr, int fq) const {
        const int row0 = u.pm * BM + wr * 64 + fr; int colt = u.pn * BM; bf16_t* base = O;
        float sc = 1.f; if (split_cols) { const int t = colt / split_cols; base += (size_t)t * split_stride; colt -= t * split_cols; if (t == 0) sc = scale0; }
        const int col0 = colt + wc * 32 + 8 * fq, bcol0 = u.pn * BM + wc * 32 + 8 * fq;
        f32x4 bv[2][2];
#pragma unroll
        for (int bj = 0; bj < 2; ++bj)
#pragma unroll
            for (int n = 0; n < 2; ++n) bv[bj][n] = bias ? *(const f32x4*)(bias + bcol0 + bj * HALF + 4 * n) : (f32x4){0.f, 0.f, 0.f, 0.f};
#pragma unroll
        for (int ai = 0; ai < 2; ++ai)
#pragma unroll
            for (int m = 0; m < 4; ++m) { bf16_t* rowp = base + (size_t)(row0 + ai * HALF + m * 16) * ldc + col0;
#pragma unroll
                for (int bj = 0; bj < 2; ++bj) { f32x4 v0 = acc[ai][bj][m][0] + bv[bj][0], v1 = acc[ai][bj][m][1] + bv[bj][1];
                    if (ACT == 1) { f32x2 a = gelu_pk((f32x2){v0[0], v0[1]}), b = gelu_pk((f32x2){v0[2], v0[3]}), c = gelu_pk((f32x2){v1[0], v1[1]}), d = gelu_pk((f32x2){v1[2], v1[3]});
                        v0 = (f32x4){a.x, a.y, b.x, b.y}; v1 = (f32x4){c.x, c.y, d.x, d.y}; }
                    v0 = v0 * sc; v1 = v1 * sc; u32x4 w; w.x = cvt_pk_bf16(v0[0], v0[1]); w.y = cvt_pk_bf16(v0[2], v0[3]); w.z = cvt_pk_bf16(v1[0], v1[1]); w.w = cvt_pk_bf16(v1[2], v1[3]);
                    *(u32x4*)(rowp + bj * HALF) = w; } }
    }
};
constexpr int MROWS_VALID = 8224, MROWS_PROMPT = 8192;
__device__ __forceinline__ float fsigmoid(float x) { return __builtin_amdgcn_rcpf(1.f + __builtin_amdgcn_exp2f(-1.44269504f * x)); }
__device__ __forceinline__ float fsilu(float x) { return x * fsigmoid(x); }
__device__ __forceinline__ float bflo(unsigned w) { return __uint_as_float(w << 16); }
__device__ __forceinline__ float bfhi(unsigned w) { return __uint_as_float(w & 0xffff0000u); }

struct EpiSwiGLU {
    static constexpr bool PERM = true, AFTER_DRAIN = false;
    bf16_t* O; int ldc;
    __device__ __forceinline__ void operator()(const f32x4 (&acc)[2][2][4][2], const Unit& u, int wr, int wc, int fr, int fq) const {
        const int row0 = u.pm * BM + wr * 64 + fr, col0 = u.pn * HALF + wc * 32 + 8 * fq;
#pragma unroll
        for (int ai = 0; ai < 2; ++ai)
#pragma unroll
            for (int m = 0; m < 4; ++m) {
                bf16_t* p = O + (size_t)(row0 + ai * HALF + m * 16) * ldc + col0;
                const f32x4 a0 = acc[ai][0][m][0], a1 = acc[ai][0][m][1], b0 = acc[ai][1][m][0], b1 = acc[ai][1][m][1];
                u32x4 w;
                w.x = cvt_pk_bf16(fsilu(a0[0]) * b0[0], fsilu(a0[1]) * b0[1]); w.y = cvt_pk_bf16(fsilu(a0[2]) * b0[2], fsilu(a0[3]) * b0[3]);
                w.z = cvt_pk_bf16(fsilu(a1[0]) * b1[0], fsilu(a1[1]) * b1[1]); w.w = cvt_pk_bf16(fsilu(a1[2]) * b1[2], fsilu(a1[3]) * b1[3]);
                *(u32x4*)p = w;
            }
    }
};
struct EpiRes {
    static constexpr bool PERM = false, AFTER_DRAIN = false;
    const float* base_p; const float* base_s; float* out; const float* gate; float gs;
    __device__ __forceinline__ void operator()(const f32x4 (&acc)[2][2][4][2], const Unit& u, int wr, int wc, int fr, int fq) const {
        const int col0 = u.pn * BM + wc * 32 + 4 * fq;
#pragma unroll
        for (int ai = 0; ai < 2; ++ai)
#pragma unroll
            for (int m = 0; m < 4; ++m) {
                const int row = u.pm * BM + ai * HALF + wr * 64 + m * 16 + fr;
                if (row < MROWS_VALID) {
                    const int br = row < MROWS_PROMPT ? (row >> 12) : (2 + row - MROWS_PROMPT);
                    const float* bp = row < MROWS_PROMPT ? base_p + (size_t)row * 2048 : base_s + (size_t)(row - MROWS_PROMPT) * 2048;
                    const float* gp = gate + (size_t)br * 18432; float* op = out + (size_t)row * 2048;
#pragma unroll
                    for (int bj = 0; bj < 2; ++bj)
#pragma unroll
                        for (int n = 0; n < 2; ++n) { const int c = col0 + bj * HALF + n * 16;
                            const f32x4 g = *(const f32x4*)(gp + c), b = *(const f32x4*)(bp + c);
                            *(f32x4*)(op + c) = b + (g * gs) * acc[ai][bj][m][n]; }
                }
            }
    }
};
template <bool ACCUM> struct EpiGateMix {
    static constexpr bool PERM = true, AFTER_DRAIN = false;
    bf16_t* O; const bf16_t* Zg;
    __device__ __forceinline__ void operator()(const f32x4 (&acc)[2][2][4][2], const Unit& u, int wr, int wc, int fr, int fq) const {
        const int row0 = u.pm * BM + wr * 64 + fr, col0 = u.pn * BM + wc * 32 + 8 * fq;
#pragma unroll
        for (int ai = 0; ai < 2; ++ai)
#pragma unroll
            for (int m = 0; m < 4; ++m) { const int row = row0 + ai * HALF + m * 16;
#pragma unroll
                for (int bj = 0; bj < 2; ++bj) { const int c = col0 + bj * HALF;
                    const u32x4 gz = *(const u32x4*)(Zg + (size_t)row * 7680 + c);
                    bf16_t* op = O + (size_t)row * 2048 + c;
                    const f32x4 v0 = acc[ai][bj][m][0], v1 = acc[ai][bj][m][1];
                    float r0 = fsigmoid(bflo(gz.x)) * v0[0], r1 = fsigmoid(bfhi(gz.x)) * v0[1], r2 = fsigmoid(bflo(gz.y)) * v0[2], r3 = fsigmoid(bfhi(gz.y)) * v0[3];
                    float r4 = fsigmoid(bflo(gz.z)) * v1[0], r5 = fsigmoid(bfhi(gz.z)) * v1[1], r6 = fsigmoid(bflo(gz.w)) * v1[2], r7 = fsigmoid(bfhi(gz.w)) * v1[3];
                    if (ACCUM) { const u32x4 pv = *(const u32x4*)op;
                        r0 += bflo(pv.x); r1 += bfhi(pv.x); r2 += bflo(pv.y); r3 += bfhi(pv.y); r4 += bflo(pv.z); r5 += bfhi(pv.z); r6 += bflo(pv.w); r7 += bfhi(pv.w); }
                    u32x4 w; w.x = cvt_pk_bf16(r0, r1); w.y = cvt_pk_bf16(r2, r3); w.z = cvt_pk_bf16(r4, r5); w.w = cvt_pk_bf16(r6, r7);
                    *(u32x4*)op = w; }
            }
    }
};
template <class Epi, class Sched, bool ALIGN_EPI = false, bool SP2 = false>
__device__ __forceinline__ void gemm_phase(PG8_LAS unsigned char* lds, const Gemm g, const Sched& S, const Epi& E) {
    const int tid = threadIdx.x, wid = __builtin_amdgcn_readfirstlane(tid >> 6), lane = tid & 63, wr = wid >> 2, wc = wid & 3, fr = lane & 15, fq = lane >> 4;
    const int K = g.K, nt = K / BK;
    unsigned voffA[2], voffB[2];
#pragma unroll
    for (int i = 0; i < 2; ++i) { int R, C; stage_rc(tid * 16 + i * 8192, R, C); const int Rb = Epi::PERM ? ((R & ~31) + perm32(R & 31)) : R;
        voffA[i] = (unsigned)(R * K + C) * 2u; voffB[i] = (unsigned)(Rb * K + C) * 2u; }
    const size_t kstep = (size_t)(BK * 2);
    const size_t hstep = (size_t)HALF * K * 2;
    const size_t tstep = 2 * hstep;
    const unsigned ldsw = (unsigned)wid * 1024u;
    const int aoff = lds_byte(wr * 64 + fr, fq * 8), boff = lds_byte(wc * 32 + fr, fq * 8);
#define PG8_SA(b, h) (((b) * 2 + (h)) * HTB)
#define PG8_SB(b, h) ((4 + (b) * 2 + (h)) * HTB)
#define PG8_STAGE(bufoff, gbase, voff) do { _Pragma("unroll") for (int _i = 0; _i < 2; ++_i) \
        __builtin_amdgcn_global_load_lds((const unsigned*)((const char*)(gbase) + (voff)[_i]), (PG8_LAS unsigned*)(lds + (bufoff) + ldsw + _i * 8192), 16, 0, 0); } while (0)
#define PG8_LDA(dst, b, h) do { _Pragma("unroll") for (int m = 0; m < 4; ++m) _Pragma("unroll") for (int k = 0; k < 2; ++k) dst[m][k] = *(const PG8_LAS bf16x8*)(lds + PG8_SA(b, h) + aoff + m * 2048 + k * 1024); } while (0)
#define PG8_LDB(dst, b, h) do { _Pragma("unroll") for (int n = 0; n < 2; ++n) _Pragma("unroll") for (int k = 0; k < 2; ++k) dst[n][k] = *(const PG8_LAS bf16x8*)(lds + PG8_SB(b, h) + boff + n * 2048 + k * 1024); } while (0)
#define PG8_MMA(ai, bj, At, Bt) do { __builtin_amdgcn_s_setprio(1); _Pragma("unroll") for (int m = 0; m < 4; ++m) _Pragma("unroll") for (int n = 0; n < 2; ++n) _Pragma("unroll") for (int k = 0; k < 2; ++k) \
        acc[ai][bj][m][n] = __builtin_amdgcn_mfma_f32_16x16x32_bf16(Bt[n][k], At[m][k], acc[ai][bj][m][n], 0, 0, 0); __builtin_amdgcn_s_setprio(0); } while (0)
#define PG8_WAIT_V(n) asm volatile("s_waitcnt vmcnt(" #n ")" ::: "memory")
#define PG8_WAIT_L(n) asm volatile("s_waitcnt lgkmcnt(" #n ")" ::: "memory")
#define PG8_BAR __builtin_amdgcn_s_barrier()
#define PG8_SCHED __builtin_amdgcn_sched_barrier(0)
    Unit cur, nxt; int ui = 0;
    if (!S.next(0, cur)) return;
    f32x4 acc[2][2][4][2];
#pragma unroll
    for (int a = 0; a < 2; ++a)
#pragma unroll
        for (int b = 0; b < 2; ++b)
#pragma unroll
            for (int m = 0; m < 4; ++m)
#pragma unroll
                for (int n = 0; n < 2; ++n) acc[a][b][m][n] = (f32x4){0.f, 0.f, 0.f, 0.f};
    bf16x8 At[4][2], B0[2][2], B1[2][2];
    const char* cA = (const char*)g.A + (size_t)cur.pm * tstep; const char* cB = (const char*)g.Bt + (size_t)cur.pn * tstep;
    S.a_ready(cur);
    if constexpr (SP2) {
        PG8_STAGE(PG8_SB(0, 0), cB, voffB); PG8_STAGE(PG8_SB(0, 1), cB + hstep, voffB); PG8_STAGE(PG8_SA(0, 0), cA, voffA); PG8_STAGE(PG8_SA(0, 1), cA + hstep, voffA);
        if (wr == 1) PG8_BAR;
        PG8_WAIT_V(2); PG8_BAR;
        PG8_STAGE(PG8_SB(1, 0), cB + kstep, voffB); PG8_STAGE(PG8_SA(1, 0), cA + kstep, voffA); PG8_STAGE(PG8_SB(1, 1), cB + hstep + kstep, voffB);
        PG8_WAIT_V(6); PG8_BAR;
    } else {
        PG8_STAGE(PG8_SB(0, 0), cB, voffB); PG8_STAGE(PG8_SA(0, 0), cA, voffA); PG8_STAGE(PG8_SB(0, 1), cB + hstep, voffB); PG8_STAGE(PG8_SA(0, 1), cA + hstep, voffA);
        if (wr == 1) PG8_BAR;
        PG8_WAIT_V(4); PG8_BAR;
        PG8_STAGE(PG8_SB(1, 0), cB + kstep, voffB); PG8_STAGE(PG8_SA(1, 0), cA + kstep, voffA); PG8_STAGE(PG8_SB(1, 1), cB + hstep + kstep, voffB);
        PG8_WAIT_V(6); PG8_BAR;
    }
    for (;;) {
        const bool has_next = S.next(ui + 1, nxt);
        const char* nA = has_next ? (const char*)g.A + (size_t)nxt.pm * tstep : cA; const char* nB = has_next ? (const char*)g.Bt + (size_t)nxt.pn * tstep : cB;
        for (int t = 0; t < nt; t += 2) {
            const bool last = (t == nt - 2);
            const char* a1 = cA + (size_t)(t + 1) * kstep;
            const char* a2 = last ? nA : cA + (size_t)(t + 2) * kstep; const char* b2 = last ? nB : cB + (size_t)(t + 2) * kstep;
            const char* a3 = a2 + kstep; const char* b3 = b2 + kstep;
            if (last && has_next) S.a_ready(nxt);
            if constexpr (SP2) {
            PG8_LDB(B0, 0, 0); PG8_LDB(B1, 0, 1); PG8_SCHED; PG8_LDA(At, 0, 0); PG8_STAGE(PG8_SA(1, 1), a1 + hstep, voffA);
            PG8_WAIT_V(8); PG8_WAIT_L(0); PG8_BAR; PG8_MMA(0, 0, At, B0); PG8_MMA(0, 1, At, B1); PG8_BAR; PG8_SCHED;
            PG8_LDA(At, 0, 1); PG8_STAGE(PG8_SB(0, 0), b2, voffB); PG8_STAGE(PG8_SB(0, 1), b2 + hstep, voffB); PG8_STAGE(PG8_SA(0, 0), a2, voffA);
            PG8_WAIT_V(8); PG8_WAIT_L(0); PG8_BAR; PG8_MMA(1, 0, At, B0); PG8_MMA(1, 1, At, B1); PG8_BAR; PG8_SCHED;
            PG8_LDB(B0, 1, 0); PG8_LDB(B1, 1, 1); PG8_SCHED; PG8_LDA(At, 1, 0); PG8_STAGE(PG8_SA(0, 1), a2 + hstep, voffA);
            PG8_WAIT_V(8); PG8_WAIT_L(0); PG8_BAR; PG8_MMA(0, 0, At, B0); PG8_MMA(0, 1, At, B1); PG8_BAR; PG8_SCHED;
            PG8_LDA(At, 1, 1); PG8_STAGE(PG8_SB(1, 0), b3, voffB); PG8_STAGE(PG8_SB(1, 1), b3 + hstep, voffB); PG8_STAGE(PG8_SA(1, 0), a3, voffA);
            PG8_WAIT_V(8); PG8_WAIT_L(0); PG8_BAR; PG8_MMA(1, 0, At, B0); PG8_MMA(1, 1, At, B1); PG8_BAR; PG8_SCHED;
            } else {
            PG8_LDB(B0, 0, 0); PG8_SCHED; PG8_LDA(At, 0, 0); PG8_STAGE(PG8_SA(1, 1), a1 + hstep, voffA);
            PG8_WAIT_L(8); PG8_BAR; PG8_WAIT_L(0); PG8_MMA(0, 0, At, B0); PG8_BAR; PG8_SCHED;
            PG8_LDB(B1, 0, 1); PG8_STAGE(PG8_SB(0, 0), b2, voffB);
            PG8_BAR; PG8_WAIT_L(0); PG8_MMA(0, 1, At, B1); PG8_BAR;
            PG8_LDA(At, 0, 1); PG8_STAGE(PG8_SA(0, 0), a2, voffA);
            PG8_BAR; PG8_WAIT_L(0); PG8_MMA(1, 0, At, B0); PG8_BAR; PG8_SCHED;
            PG8_STAGE(PG8_SB(0, 1), b2 + hstep, voffB);
            PG8_WAIT_V(6); PG8_BAR; PG8_MMA(1, 1, At, B1); PG8_BAR;
            PG8_LDB(B0, 1, 0); PG8_SCHED; PG8_LDA(At, 1, 0); PG8_STAGE(PG8_SA(0, 1), a2 + hstep, voffA);
            PG8_WAIT_L(8); PG8_BAR; PG8_WAIT_L(0); PG8_MMA(0, 0, At, B0); PG8_BAR; PG8_SCHED;
            PG8_LDB(B1, 1, 1); PG8_STAGE(PG8_SB(1, 0), b3, voffB);
            PG8_BAR; PG8_WAIT_L(0); PG8_MMA(0, 1, At, B1); PG8_BAR;
            PG8_LDA(At, 1, 1); PG8_STAGE(PG8_SA(1, 0), a3, voffA);
            PG8_BAR; PG8_WAIT_L(0); PG8_MMA(1, 0, At, B0); PG8_BAR; PG8_SCHED;
            PG8_STAGE(PG8_SB(1, 1), b3 + hstep, voffB);
            PG8_WAIT_V(6); PG8_BAR; PG8_MMA(1, 1, At, B1); PG8_BAR;
            }
        }
        if constexpr (ALIGN_EPI) { if (wr == 0) PG8_BAR; }
        if constexpr (!Epi::AFTER_DRAIN) { E(acc, cur, wr, wc, fr, fq); S.done(cur); }
        if (!has_next) break;
#pragma unroll
        for (int a = 0; a < 2; ++a)
#pragma unroll
            for (int b = 0; b < 2; ++b)
#pragma unroll
                for (int m = 0; m < 4; ++m)
#pragma unroll
                    for (int n = 0; n < 2; ++n) acc[a][b][m][n] = (f32x4){0.f, 0.f, 0.f, 0.f};
        cur = nxt; cA = nA; cB = nB; ++ui;
        if constexpr (ALIGN_EPI) { if (wr == 1) PG8_BAR; }
    }
    PG8_WAIT_V(0);
    if constexpr (!ALIGN_EPI) { if (wr == 0) PG8_BAR; }
    PG8_BAR;
    if constexpr (Epi::AFTER_DRAIN) { E.fused(acc, cur, wr, wc, fr, fq, lds, wid, lane); S.done(cur); }
#undef PG8_SA
#undef PG8_SB
#undef PG8_STAGE
#undef PG8_LDA
#undef PG8_LDB
#undef PG8_MMA
#undef PG8_WAIT_V
#undef PG8_WAIT_L
#undef PG8_BAR
#undef PG8_SCHED
}
}
namespace cg = cooperative_groups;
#ifndef MK_ONE_LAUNCH
#define MK_ONE_LAUNCH 1
#endif
constexpr int NWAVES = 8, NTHREADS = 512;
constexpr int DM = 2048, SEQ = 4096, MPROMPT = 8192, NSAMP = 32, MROWS = 8224, MPAD = 8448;
constexpr int DFF = 5632, DIN = 7680, DATT = 1024, DRNN = 1024, MODW = 18432, NBROW = 34;
constexpr int ZQ = 0, ZK = 1024, ZV = 1280, ZRX = 1536, ZRG = 2560, ZGA = 3584, ZGR = 5632;
constexpr int NCHUNK = 64, TCHUNK = 64;
constexpr float EPSN = 1e-6f;
constexpr size_t O_Y = 0, O_KP = 16842752, O_VP = 16908288, O_KS = 16973824, O_VS = 16982016, O_HP = 16990208, O_HS = 16992256, O_CP = 17025024, O_CS = 17031168, O_END = 17129472;
constexpr size_t MiB = 1u << 20;
constexpr size_t WS_W13A = 0, WS_W2A = 44 * MiB, WS_W13B = 66 * MiB, WS_W2B = 110 * MiB, WS_WIN = 132 * MiB, WS_WPA = 162 * MiB, WS_WPR = 166 * MiB, WS_WOUT = 170 * MiB;
constexpr size_t WS_XN = 178 * MiB, WS_HZ = 211 * MiB, WS_X = 335 * MiB, WS_OATT = 401 * MiB, WS_ORNN = 418 * MiB, WS_MIX = 435 * MiB, WS_MOD = 468 * MiB, WS_ROPE = 471 * MiB;
constexpr size_t WS_CA = 473 * MiB, WS_CH = WS_CA + 512 * 1024, WS_BAR = 474 * MiB, WS_END = 475 * MiB;
constexpr int MISC_OFF = 147456 - 64;
constexpr int LDS_BYTES = 147456;

#define LAS __attribute__((address_space(3)))
typedef unsigned short bf16;
typedef unsigned v4u __attribute__((ext_vector_type(4)));
typedef unsigned v2u __attribute__((ext_vector_type(2)));
typedef float f32x4 __attribute__((ext_vector_type(4)));
typedef float f32x16 __attribute__((ext_vector_type(16)));
typedef short bf16x8 __attribute__((ext_vector_type(8)));
#define LDS_WAIT() asm volatile("s_waitcnt lgkmcnt(0)" ::: "memory")
#define MFMA32(a, b, c) __builtin_amdgcn_mfma_f32_32x32x16_bf16((a), (b), (c), 0, 0, 0)
#define MFMA16(a, b, c) __builtin_amdgcn_mfma_f32_16x16x32_bf16((a), (b), (c), 0, 0, 0)
__device__ __forceinline__ unsigned pk2(float lo, float hi) { return pg8::cvt_pk_bf16(lo, hi); }
__device__ __forceinline__ float bflo(unsigned w) { return __uint_as_float(w << 16); }
__device__ __forceinline__ float bfhi(unsigned w) { return __uint_as_float(w & 0xffff0000u); }
__device__ __forceinline__ float bf1(bf16 h) { return __uint_as_float((unsigned)h << 16); }
__device__ __forceinline__ float fsig(float x) { return __builtin_amdgcn_rcpf(1.f + __builtin_amdgcn_exp2f(-1.44269504f * x)); }
__device__ __forceinline__ float fexp(float x) { return __builtin_amdgcn_exp2f(1.44269504f * x); }
__device__ __forceinline__ float gelu_tanh(float x) { const float t = 0.7978845608f * (x + 0.044715f * x * x * x); return x * fsig(2.f * t); }
__device__ __forceinline__ bf16x8 pack8(const float (&v)[8]) { v4u p; p.x = pk2(v[0], v[1]); p.y = pk2(v[2], v[3]); p.z = pk2(v[4], v[5]); p.w = pk2(v[6], v[7]); return __builtin_bit_cast(bf16x8, p); }
__device__ __forceinline__ float wave_sum(float v) {
#pragma unroll
    for (int o = 1; o < 64; o <<= 1) v += __shfl_xor(v, o);
    return v;
}
__device__ __forceinline__ float wave_max(float v) {
#pragma unroll
    for (int o = 1; o < 64; o <<= 1) v = fmaxf(v, __shfl_xor(v, o));
    return v;
}

struct Args { const float* in[33]; float* out; unsigned char* ws; int ph_lo, ph_hi; };

__device__ __forceinline__ void transpose_item64(const float* __restrict__ W, int N, int K, bf16* __restrict__ WT, int k0, int n0, int drow0, LAS float* scr, int lane) {
    f32x4 v[16];
#pragma unroll
    for (int i = 0; i < 16; ++i) v[i] = *(const f32x4*)(W + (size_t)(k0 + (lane >> 4) + 4 * i) * N + n0 + (lane & 15) * 4);
#pragma unroll
    for (int i = 0; i < 16; ++i) { LAS float* s = scr + ((lane >> 4) + 4 * i) * 65 + (lane & 15) * 4; s[0] = v[i].x; s[1] = v[i].y; s[2] = v[i].z; s[3] = v[i].w; }
    LDS_WAIT();
    const int c = lane & 7;
#pragma unroll
    for (int j = 0; j < 8; ++j) { const int n = (lane >> 3) + 8 * j; const LAS float* s = scr + (8 * c) * 65 + n;
        v4u o; o.x = pk2(s[0], s[65]); o.y = pk2(s[2 * 65], s[3 * 65]); o.z = pk2(s[4 * 65], s[5 * 65]); o.w = pk2(s[6 * 65], s[7 * 65]);
        *(v4u*)(WT + (size_t)(drow0 + n) * K + k0 + 8 * c) = o; }
    LDS_WAIT();
}
__device__ __forceinline__ void ada_item(const Args& A, int nb, LAS float* red, float* MOD, int tid, int wave, int lane) {
    const float* cpv = A.in[2]; const float* csv = A.in[3]; const float* W = A.in[8]; const float* bias = A.in[9];
    const int n0 = nb * 64, kq = lane >> 4, l15 = lane & 15;
    f32x4 acc[3][4];
#pragma unroll
    for (int bt = 0; bt < 3; ++bt)
#pragma unroll
        for (int nt = 0; nt < 4; ++nt) acc[bt][nt] = (f32x4){0.f, 0.f, 0.f, 0.f};
    for (int ks = 0; ks < 8; ++ks) {
        const int k0 = wave * 256 + ks * 32 + 8 * kq;
        bf16x8 af[3];
#pragma unroll
        for (int bt = 0; bt < 3; ++bt) { const int b = 16 * bt + l15; float v[8];
            if (b < NBROW) { const float* cp = (b < 2 ? cpv + (size_t)b * DM : csv + (size_t)(b - 2) * DM) + k0; const f32x4 x0 = *(const f32x4*)cp, x1 = *(const f32x4*)(cp + 4);
                v[0] = x0.x * fsig(x0.x); v[1] = x0.y * fsig(x0.y); v[2] = x0.z * fsig(x0.z); v[3] = x0.w * fsig(x0.w); v[4] = x1.x * fsig(x1.x); v[5] = x1.y * fsig(x1.y); v[6] = x1.z * fsig(x1.z); v[7] = x1.w * fsig(x1.w); }
            else {
#pragma unroll
                for (int e = 0; e < 8; ++e) v[e] = 0.f; }
            af[bt] = pack8(v); }
#pragma unroll
        for (int nt = 0; nt < 4; ++nt) { const float* wp = W + (size_t)k0 * MODW + n0 + 16 * nt + l15; float v[8];
#pragma unroll
            for (int e = 0; e < 8; ++e) v[e] = wp[(size_t)e * MODW];
            const bf16x8 bfr = pack8(v);
#pragma unroll
            for (int bt = 0; bt < 3; ++bt) acc[bt][nt] = MFMA16(af[bt], bfr, acc[bt][nt]); }
    }
#pragma unroll
    for (int bt = 0; bt < 3; ++bt)
#pragma unroll
        for (int nt = 0; nt < 4; ++nt)
#pragma unroll
            for (int r = 0; r < 4; ++r) red[(wave * 48 + bt * 16 + nt * 4 + r) * 64 + lane] = acc[bt][nt][r];
    __syncthreads();
    for (int v = tid; v < 48 * 64; v += NTHREADS) { const int ln = v & 63, q = v >> 6, bt = q >> 4, nt = (q >> 2) & 3, r = q & 3; float s = 0.f;
#pragma unroll
        for (int w = 0; w < 8; ++w) s += red[(w * 48 + q) * 64 + ln];
        const int b = 16 * bt + 4 * (ln >> 4) + r, n = n0 + 16 * nt + (ln & 15);
        if (b < NBROW) MOD[(size_t)b * MODW + n] = s + bias[n]; }
    __syncthreads();
}
__device__ __forceinline__ void p0_prologue(const Args& A, LAS unsigned char* lds, int tid, int wave, int lane) {
    unsigned char* ws = A.ws;
    const int G = gridDim.x, bx = blockIdx.x;
    { float* rope = (float*)(ws + WS_ROPE);
      for (int i = bx * NTHREADS + tid; i < 4097 * 32; i += G * NTHREADS) { const int p = i >> 5, f = i & 31; const float pos = p < 4096 ? (float)p : 16384.f;
          const float inv = exp2f(-(float)f * (13.287712379549449f / 32.f)); const float ang = pos * inv; rope[p * 64 + f] = cosf(ang); rope[p * 64 + 32 + f] = sinf(ang); } }
    for (int nb = bx; nb < MODW / 64; nb += G) ada_item(A, nb, (LAS float*)lds, (float*)(ws + WS_MOD), tid, wave, lane);
    LAS float* scr = (LAS float*)(lds + wave * 16640);
    const int gw = bx * NWAVES + wave, NGW = G * NWAVES;
#define TR_MAT(Wp, WTp, Kv, Nv, kind) { constexpr int nblk = (Nv) / 64, items = ((Kv) / 64) * nblk; if (r < items) { const int kb = r / nblk, n0 = (r % nblk) * 64; \
        const int dr = (kind) == 0 ? n0 : (256 * (n0 >> 7) + (n0 & 127) + ((kind) == 2 ? 128 : 0)); transpose_item64((Wp), (Nv), (Kv), (bf16*)(WTp), kb * 64, n0, dr, scr, lane); continue; } r -= items; }
    constexpr int TOTAL = 6 * (DM / 64) * (DFF / 64) + (DM / 64) * (DIN / 64) + 2 * (DATT / 64) * (DM / 64) + (DM / 64) * (DM / 64);
    for (int it = gw; it < TOTAL; it += NGW) {
        int r = it;
        TR_MAT(A.in[13], ws + WS_W13A, DM, DFF, 1)
        TR_MAT(A.in[14], ws + WS_W13A, DM, DFF, 2)
        TR_MAT(A.in[15], ws + WS_W2A, DFF, DM, 0)
        TR_MAT(A.in[16], ws + WS_W13B, DM, DFF, 1)
        TR_MAT(A.in[17], ws + WS_W13B, DM, DFF, 2)
        TR_MAT(A.in[18], ws + WS_W2B, DFF, DM, 0)
        TR_MAT(A.in[19], ws + WS_WIN, DM, DIN, 0)
        TR_MAT(A.in[30], ws + WS_WPA, DATT, DM, 0)
        TR_MAT(A.in[31], ws + WS_WPR, DRNN, DM, 0)
        TR_MAT(A.in[32], ws + WS_WOUT, DM, DM, 0)
    }
#undef TR_MAT
}
__device__ __forceinline__ void norm_phase(const float* xp, const float* xs, const float* g, const float* MOD, int chunk_shift, bf16* XN, int wave, int lane) {
    const int gw = blockIdx.x * NWAVES + wave, NGW = gridDim.x * NWAVES;
    for (int row = gw; row < MROWS; row += NGW) {
        v2u* o8 = (v2u*)(XN + (size_t)row * DM) + lane;
        const float* xr = row < MPROMPT ? xp + (size_t)row * DM : xs + (size_t)(row - MPROMPT) * DM;
        const int br = row < MPROMPT ? (row >> 12) : (2 + row - MPROMPT);
        const float* sh = MOD + (size_t)br * MODW + chunk_shift * DM; const float* sc = sh + DM;
        f32x4 v[8]; float ss = 0.f;
#pragma unroll
        for (int j = 0; j < 8; ++j) { v[j] = *((const f32x4*)xr + lane + 64 * j); ss += (v[j].x * v[j].x + v[j].y * v[j].y) + (v[j].z * v[j].z + v[j].w * v[j].w); }
        const float rstd = rsqrtf(wave_sum(ss) * (1.f / DM) + EPSN);
#pragma unroll
        for (int j = 0; j < 8; ++j) { const int c = (lane + 64 * j) * 4; const f32x4 gg = *(const f32x4*)(g + c), s1 = *(const f32x4*)(sc + c), s0 = *(const f32x4*)(sh + c);
            const f32x4 y = (v[j] * rstd) * gg * (s1 + 1.f) + s0; o8[64 * j] = (v2u){pk2(y.x, y.y), pk2(y.z, y.w)}; }
    }
}
template <int NT> __device__ __forceinline__ void sgemm_acc(const bf16* A, int lda, const bf16* Bt, int K, const int (&nrow)[NT], f32x16 (&acc)[NT], int wave, int lane) {
    const int hh = lane >> 5, l31 = lane & 31, kw = K >> 3;
    const bf16* ap = A + (size_t)l31 * lda + wave * kw + 8 * hh;
    const bf16* bp[NT];
#pragma unroll
    for (int t = 0; t < NT; ++t) { bp[t] = Bt + (size_t)(nrow[t] + l31) * K + wave * kw + 8 * hh;
#pragma unroll
        for (int r = 0; r < 16; ++r) acc[t][r] = 0.f; }
    for (int k = 0; k < kw; k += 64) {
        bf16x8 a[4], b[NT][4];
#pragma unroll
        for (int i = 0; i < 4; ++i) { a[i] = *(const bf16x8*)(ap + k + 16 * i);
#pragma unroll
            for (int t = 0; t < NT; ++t) b[t][i] = *(const bf16x8*)(bp[t] + k + 16 * i); }
#pragma unroll
        for (int i = 0; i < 4; ++i)
#pragma unroll
            for (int t = 0; t < NT; ++t) acc[t] = MFMA32(a[i], b[t][i], acc[t]);
    }
}
template <int NT> __device__ __forceinline__ void sgemm_reduce(const f32x16 (&acc)[NT], LAS float* red, float (&out)[NT][2], int wave, int lane) {
#pragma unroll
    for (int t = 0; t < NT; ++t)
#pragma unroll
        for (int r = 0; r < 16; ++r) red[((wave * NT + t) * 16 + r) * 64 + lane] = acc[t][r];
    __syncthreads();
#pragma unroll
    for (int t = 0; t < NT; ++t)
#pragma unroll
        for (int i = 0; i < 2; ++i) { float s = 0.f;
#pragma unroll
            for (int w = 0; w < 8; ++w) s += red[((w * NT + t) * 16 + wave + 8 * i) * 64 + lane];
            out[t][i] = s; }
    __syncthreads();
}
#define SG_M(i) (8 * ((wave + 8 * (i)) >> 2) + 4 * (lane >> 5) + ((wave + 8 * (i)) & 3))
__device__ __forceinline__ void sg_ffn_up(const bf16* XN, const bf16* W13, bf16* HB, int item, LAS float* red, int wave, int lane) {
    const int c0 = 32 * item, pn = c0 >> 7, cc = c0 & 127; const int nrow[2] = {256 * pn + cc, 256 * pn + 128 + cc};
    f32x16 acc[2]; float o[2][2];
    sgemm_acc<2>(XN + (size_t)MPROMPT * DM, DM, W13, DM, nrow, acc, wave, lane); sgemm_reduce<2>(acc, red, o, wave, lane);
#pragma unroll
    for (int i = 0; i < 2; ++i) { const int m = SG_M(i); HB[(size_t)(MPROMPT + m) * DFF + c0 + (lane & 31)] = (bf16)(pk2(o[0][i] * fsig(o[0][i]) * o[1][i], 0.f) & 0xffffu); }
}
__device__ __forceinline__ void sg_res(const bf16* Arow, int K, const bf16* Bt, const float* base, float* out, const float* gate, float gs, int item, LAS float* red, int wave, int lane) {
    const int nrow[1] = {32 * item}; f32x16 acc[1]; float o[1][2];
    sgemm_acc<1>(Arow, K, Bt, K, nrow, acc, wave, lane); sgemm_reduce<1>(acc, red, o, wave, lane);
#pragma unroll
    for (int i = 0; i < 2; ++i) { const int m = SG_M(i), c = 32 * item + (lane & 31); out[(size_t)m * DM + c] = base[(size_t)m * DM + c] + gs * gate[(size_t)(2 + m) * MODW + c] * o[0][i]; }
}
__device__ __forceinline__ void sg_z(const bf16* XN, const bf16* Win, bf16* ZB, int item, LAS float* red, int wave, int lane) {
    const int nrow[1] = {32 * item}; f32x16 acc[1]; float o[1][2];
    sgemm_acc<1>(XN + (size_t)MPROMPT * DM, DM, Win, DM, nrow, acc, wave, lane); sgemm_reduce<1>(acc, red, o, wave, lane);
#pragma unroll
    for (int i = 0; i < 2; ++i) { const int m = SG_M(i); ZB[(size_t)(MPROMPT + m) * DIN + 32 * item + (lane & 31)] = (bf16)(pk2(o[0][i], 0.f) & 0xffffu); }
}
__device__ __forceinline__ void sg_mix(const bf16* OATT, const bf16* ORNN, const bf16* Wpa, const bf16* Wpr, const bf16* ZB, bf16* MIX, int item, LAS float* red, int wave, int lane) {
    const int nrow[1] = {32 * item}; f32x16 acc[1]; float oa[1][2], orr[1][2];
    sgemm_acc<1>(OATT + (size_t)MPROMPT * DATT, DATT, Wpa, DATT, nrow, acc, wave, lane); sgemm_reduce<1>(acc, red, oa, wave, lane);
    sgemm_acc<1>(ORNN + (size_t)MPROMPT * DRNN, DRNN, Wpr, DRNN, nrow, acc, wave, lane); sgemm_reduce<1>(acc, red, orr, wave, lane);
#pragma unroll
    for (int i = 0; i < 2; ++i) { const int m = SG_M(i), c = 32 * item + (lane & 31); const bf16* zr = ZB + (size_t)(MPROMPT + m) * DIN;
        MIX[(size_t)(MPROMPT + m) * DM + c] = (bf16)(pk2(fsig(bf1(zr[ZGA + c])) * oa[0][i] + fsig(bf1(zr[ZGR + c])) * orr[0][i], 0.f) & 0xffffu); }
}
template <int XORD> __device__ __forceinline__ void norm_rope_row(const bf16* rowp, int hh, const float* g, const float* rp, float scale, float (&o)[4][8]) {
    float v[4][8]; float ss = 0.f;
#pragma unroll
    for (int ks = 0; ks < 4; ++ks) { const v4u w = *(const v4u*)(rowp + 8 * hh + 16 * ks);
        v[ks][0] = bflo(w.x); v[ks][1] = bfhi(w.x); v[ks][2] = bflo(w.y); v[ks][3] = bfhi(w.y); v[ks][4] = bflo(w.z); v[ks][5] = bfhi(w.z); v[ks][6] = bflo(w.w); v[ks][7] = bfhi(w.w);
#pragma unroll
        for (int e = 0; e < 8; ++e) ss += v[ks][e] * v[ks][e]; }
    ss += __shfl_xor(ss, XORD);
    const float rstd = rsqrtf(ss * (1.f / 64.f) + EPSN);
#pragma unroll
    for (int ks = 0; ks < 2; ++ks) { const int d0 = 8 * hh + 16 * ks;
        const f32x4 g0 = *(const f32x4*)(g + d0), g1 = *(const f32x4*)(g + d0 + 4), h0 = *(const f32x4*)(g + d0 + 32), h1 = *(const f32x4*)(g + d0 + 36);
        const f32x4 c0 = *(const f32x4*)(rp + d0), c1 = *(const f32x4*)(rp + d0 + 4), s0 = *(const f32x4*)(rp + 32 + d0), s1 = *(const f32x4*)(rp + 36 + d0);
#pragma unroll
        for (int e = 0; e < 8; ++e) { const float ga = e < 4 ? g0[e & 3] : g1[e & 3], gb = e < 4 ? h0[e & 3] : h1[e & 3], cc = e < 4 ? c0[e & 3] : c1[e & 3], sn = e < 4 ? s0[e & 3] : s1[e & 3];
            const float x1 = v[ks][e] * rstd * ga, x2 = v[ks + 2][e] * rstd * gb;
            o[ks][e] = (x1 * cc - x2 * sn) * scale; o[ks + 2][e] = (x2 * cc + x1 * sn) * scale; } }
}
constexpr int KS_STRIDE = 144, VT_STRIDE = 520, KS_BYTES = 256 * KS_STRIDE, VT_BYTES = 64 * VT_STRIDE;
__device__ __forceinline__ void attn_item(const Args& A, LAS unsigned char* lds, int b, int blk, int kvh, int tid, int wave, int lane) {
    unsigned char* ws = A.ws; const bf16* Z = (const bf16*)(ws + WS_HZ); const float* rope = (const float*)(ws + WS_ROPE); bf16* OATT = (bf16*)(ws + WS_OATT);
    LAS unsigned char* Ks = lds; LAS unsigned char* Vt = lds + KS_BYTES;
    {
        const int key = tid >> 1, hh = tid & 1, t = blk * 128 - 128 + key;
        if (t >= 0) {
            const bf16* zr = Z + (size_t)(b * SEQ + t) * DIN;
            float o[4][8]; norm_rope_row<1>(zr + ZK + kvh * 64, hh, A.in[21], rope + (size_t)t * 64, 1.f, o);
#pragma unroll
            for (int ks = 0; ks < 4; ++ks) *(LAS bf16x8*)(Ks + key * KS_STRIDE + (8 * hh + 16 * ks) * 2) = pack8(o[ks]);
            v4u vv[4];
#pragma unroll
            for (int i = 0; i < 4; ++i) vv[i] = *(const v4u*)(zr + ZV + kvh * 64 + 32 * hh + 8 * i);
#pragma unroll
            for (int i = 0; i < 4; ++i) { const unsigned wv[4] = {vv[i].x, vv[i].y, vv[i].z, vv[i].w};
#pragma unroll
                for (int e = 0; e < 4; ++e) { const int d = 32 * hh + 8 * i + 2 * e;
                    *(LAS bf16*)(Vt + d * VT_STRIDE + key * 2) = (bf16)(wv[e] & 0xffffu); *(LAS bf16*)(Vt + (d + 1) * VT_STRIDE + key * 2) = (bf16)(wv[e] >> 16); } }
            if (blk == SEQ / 128 - 1 && key >= 128) {
                float* kp = A.out + O_KP + ((size_t)(b * 128 + key - 128) * 4 + kvh) * 64; float* vp = A.out + O_VP + ((size_t)(b * 128 + key - 128) * 4 + kvh) * 64;
#pragma unroll
                for (int ks = 0; ks < 4; ++ks) { *(f32x4*)(kp + 8 * hh + 16 * ks) = (f32x4){o[ks][0], o[ks][1], o[ks][2], o[ks][3]}; *(f32x4*)(kp + 8 * hh + 16 * ks + 4) = (f32x4){o[ks][4], o[ks][5], o[ks][6], o[ks][7]}; }
#pragma unroll
                for (int i = 0; i < 4; ++i) { *(f32x4*)(vp + 32 * hh + 8 * i) = (f32x4){bflo(vv[i].x), bfhi(vv[i].x), bflo(vv[i].y), bfhi(vv[i].y)}; *(f32x4*)(vp + 32 * hh + 8 * i + 4) = (f32x4){bflo(vv[i].z), bfhi(vv[i].z), bflo(vv[i].w), bfhi(vv[i].w)}; }
            }
        } else {
#pragma unroll
            for (int ks = 0; ks < 4; ++ks) *(LAS v4u*)(Ks + key * KS_STRIDE + (8 * hh + 16 * ks) * 2) = (v4u){0u, 0u, 0u, 0u};
#pragma unroll
            for (int d = 0; d < 32; ++d) *(LAS bf16*)(Vt + (32 * hh + d) * VT_STRIDE + key * 2) = (bf16)0;
        }
    }
    __syncthreads();
    const int g = wave >> 1, head = kvh * 4 + g, hh = lane >> 5, l31 = lane & 31;
    const float sink = A.in[22][head];
#pragma unroll 1
    for (int qt = 0; qt < 2; ++qt) {
        const int i0 = (wave & 1) * 64 + 32 * qt, qi = i0 + l31, t = blk * 128 + qi; const size_t row = (size_t)b * SEQ + t;
        bf16x8 qf[4];
        { float o[4][8]; norm_rope_row<32>(Z + row * DIN + ZQ + head * 64, hh, A.in[20], rope + (size_t)t * 64, 0.125f, o);
#pragma unroll
          for (int ks = 0; ks < 4; ++ks) qf[ks] = pack8(o[ks]); }
        const int kt0 = i0 >> 5;
        f32x16 s[5];
#pragma unroll
        for (int kk = 0; kk < 5; ++kk) {
#pragma unroll
            for (int r = 0; r < 16; ++r) s[kk][r] = 0.f;
#pragma unroll
            for (int ks = 0; ks < 4; ++ks) { const bf16x8 kf = *(const LAS bf16x8*)(Ks + (32 * (kt0 + kk) + l31) * KS_STRIDE + (8 * hh + 16 * ks) * 2); s[kk] = MFMA32(kf, qf[ks], s[kk]); } }
        float mx = sink;
#pragma unroll
        for (int kk = 0; kk < 5; ++kk)
#pragma unroll
            for (int r = 0; r < 16; ++r) { const int j = 32 * (kt0 + kk) + 8 * (r >> 2) + 4 * hh + (r & 3); const bool ok = (j > qi) && (j <= qi + 128) && (blk > 0 || j >= 128);
                s[kk][r] = ok ? s[kk][r] : -INFINITY; mx = fmaxf(mx, s[kk][r]); }
        mx = fmaxf(mx, __shfl_xor(mx, 32));
        float l = 0.f;
#pragma unroll
        for (int kk = 0; kk < 5; ++kk)
#pragma unroll
            for (int r = 0; r < 16; ++r) { const float p = fexp(s[kk][r] - mx); s[kk][r] = p; l += p; }
        l += __shfl_xor(l, 32);
        const float inv = 1.f / (l + fexp(sink - mx));
        f32x16 oacc[2];
#pragma unroll
        for (int dt = 0; dt < 2; ++dt)
#pragma unroll
            for (int r = 0; r < 16; ++r) oacc[dt][r] = 0.f;
#pragma unroll
        for (int kk = 0; kk < 5; ++kk)
#pragma unroll
            for (int s2 = 0; s2 < 2; ++s2) { float pv[8];
#pragma unroll
                for (int e = 0; e < 8; ++e) pv[e] = s[kk][8 * s2 + e];
                const bf16x8 pf = pack8(pv);
#pragma unroll
                for (int dt = 0; dt < 2; ++dt) { const LAS unsigned char* vp = Vt + (32 * dt + l31) * VT_STRIDE + (32 * (kt0 + kk) + 16 * s2 + 4 * hh) * 2;
                    const v2u lo = *(const LAS v2u*)vp, hi = *(const LAS v2u*)(vp + 16); const v4u a4 = (v4u){lo.x, lo.y, hi.x, hi.y};
                    oacc[dt] = MFMA32(__builtin_bit_cast(bf16x8, a4), pf, oacc[dt]); } }
        bf16* op = OATT + row * DATT + head * 64;
#pragma unroll
        for (int dt = 0; dt < 2; ++dt)
#pragma unroll
            for (int g4 = 0; g4 < 4; ++g4) *(v2u*)(op + 32 * dt + 8 * g4 + 4 * hh) = (v2u){pk2(oacc[dt][4 * g4] * inv, oacc[dt][4 * g4 + 1] * inv), pk2(oacc[dt][4 * g4 + 2] * inv, oacc[dt][4 * g4 + 3] * inv)};
    }
    __syncthreads();
}
__device__ __forceinline__ void attn_sample_item(const Args& A, LAS float* wl  , int bs, int head, int lane) {
    unsigned char* ws = A.ws; const bf16* Z = (const bf16*)(ws + WS_HZ); const float* rp = (const float*)(ws + WS_ROPE) + (size_t)4096 * 64; bf16* OATT = (bf16*)(ws + WS_OATT);
    const int kvh = head >> 2, d = lane, f = d & 31; const size_t row = MPROMPT + bs;
    const bf16* zr = Z + row * DIN;
    const float cs = rp[f], sn = rp[32 + f];
    float q = bf1(zr[ZQ + head * 64 + d]); { const float rstd = rsqrtf(wave_sum(q * q) * (1.f / 64.f) + EPSN); q = q * rstd * A.in[20][d]; const float qo = __shfl_xor(q, 32); q = (d < 32 ? q * cs - qo * sn : q * cs + qo * sn) * 0.125f; }
    float kn = bf1(zr[ZK + kvh * 64 + d]); { const float rstd = rsqrtf(wave_sum(kn * kn) * (1.f / 64.f) + EPSN); kn = kn * rstd * A.in[21][d]; const float ko = __shfl_xor(kn, 32); kn = d < 32 ? kn * cs - ko * sn : kn * cs + ko * sn; }
    const float vn = bf1(zr[ZV + kvh * 64 + d]);
    if ((head & 3) == 0) { A.out[O_KS + ((size_t)bs * 4 + kvh) * 64 + d] = kn; A.out[O_VS + ((size_t)bs * 4 + kvh) * 64 + d] = vn; }
    const float snew = wave_sum(q * kn);
    wl[d] = q; LDS_WAIT();
    const float* ck = A.in[4] + (size_t)bs * 128 * 256 + kvh * 64; const float* cv = A.in[5] + (size_t)bs * 128 * 256 + kvh * 64;
    float s0 = 0.f, s1 = 0.f;
    { const float* k0 = ck + (size_t)lane * 256; const float* k1 = ck + (size_t)(lane + 64) * 256;
#pragma unroll
      for (int i = 0; i < 16; ++i) { const f32x4 qv = *(const LAS f32x4*)(wl + 4 * i), a = *(const f32x4*)(k0 + 4 * i), c = *(const f32x4*)(k1 + 4 * i);
          s0 += (qv.x * a.x + qv.y * a.y) + (qv.z * a.z + qv.w * a.w); s1 += (qv.x * c.x + qv.y * c.y) + (qv.z * c.z + qv.w * c.w); } }
    if (lane == 0) s0 = snew;
    const float sink = A.in[22][head];
    const float mx = fmaxf(wave_max(fmaxf(s0, s1)), sink);
    const float p0 = fexp(s0 - mx), p1 = fexp(s1 - mx);
    const float inv = 1.f / (wave_sum(p0 + p1) + fexp(sink - mx));
    wl[64 + lane] = p0; wl[128 + lane] = p1; LDS_WAIT();
    float o = wl[64] * vn;
#pragma unroll 8
    for (int j = 1; j < 128; ++j) o += wl[64 + j] * cv[(size_t)j * 256 + d];
    OATT[row * DATT + head * 64 + d] = (bf16)(pk2(o * inv, 0.f) & 0xffffu);
    LDS_WAIT();
}
template <bool FINAL> __device__ __forceinline__ void rnn_item(const Args& A, LAS float* xcs  , int b, int c, int hb, int lane) {
    unsigned char* ws = A.ws; const bf16* Z = (const bf16*)(ws + WS_HZ); bf16* ORNN = (bf16*)(ws + WS_ORNN); float* CA = (float*)(ws + WS_CA); float* CH = (float*)(ws + WS_CH);
    const int hh = lane >> 5, l31 = lane & 31, t00 = c * TCHUNK, ch0 = hb * 64;
    const float* cw = A.in[23] + ch0; const float* cbp = A.in[24] + ch0;
#pragma unroll 1
    for (int tt = 0; tt < 2; ++tt) {
        const int t = t00 + 32 * tt + l31; const bf16* zr = Z + ((size_t)b * SEQ + t) * DIN + ZRX + ch0 + 8 * hh;
#pragma unroll 2
        for (int ks = 0; ks < 4; ++ks) {
            const v4u z0 = {0u, 0u, 0u, 0u};
            const v4u x0 = *(const v4u*)(zr + 16 * ks), x1 = t >= 1 ? *(const v4u*)(zr + 16 * ks - DIN) : z0, x2 = t >= 2 ? *(const v4u*)(zr + 16 * ks - 2 * DIN) : z0, x3 = t >= 3 ? *(const v4u*)(zr + 16 * ks - 3 * DIN) : z0;
            const int cg = 8 * hh + 16 * ks; float xc[8];
#pragma unroll
            for (int q = 0; q < 2; ++q) { const f32x4 w0 = *(const f32x4*)(cw + cg + 4 * q), w1 = *(const f32x4*)(cw + DRNN + cg + 4 * q), w2 = *(const f32x4*)(cw + 2 * DRNN + cg + 4 * q), w3 = *(const f32x4*)(cw + 3 * DRNN + cg + 4 * q), bb = *(const f32x4*)(cbp + cg + 4 * q);
                const unsigned a0 = q == 0 ? x0.x : x0.z, a1 = q == 0 ? x0.y : x0.w, b0 = q == 0 ? x1.x : x1.z, b1 = q == 0 ? x1.y : x1.w, c0 = q == 0 ? x2.x : x2.z, c1 = q == 0 ? x2.y : x2.w, d0 = q == 0 ? x3.x : x3.z, d1 = q == 0 ? x3.y : x3.w;
                xc[4 * q + 0] = bb.x + w3.x * bflo(a0) + w2.x * bflo(b0) + w1.x * bflo(c0) + w0.x * bflo(d0);
                xc[4 * q + 1] = bb.y + w3.y * bfhi(a0) + w2.y * bfhi(b0) + w1.y * bfhi(c0) + w0.y * bfhi(d0);
                xc[4 * q + 2] = bb.z + w3.z * bflo(a1) + w2.z * bflo(b1) + w1.z * bflo(c1) + w0.z * bflo(d1);
                xc[4 * q + 3] = bb.w + w3.w * bfhi(a1) + w2.w * bfhi(b1) + w1.w * bfhi(c1) + w0.w * bfhi(d1); }
#pragma unroll
            for (int e = 0; e < 8; ++e) xcs[(32 * tt + l31) * 65 + cg + e] = xc[e];
            if (FINAL && c == NCHUNK - 1 && tt == 1 && l31 >= 29) { float* cp = A.out + O_CP + ((size_t)b * 3 + (l31 - 29)) * DRNN + ch0 + cg;
                *(f32x4*)cp = (f32x4){bflo(x0.x), bfhi(x0.x), bflo(x0.y), bfhi(x0.y)}; *(f32x4*)(cp + 4) = (f32x4){bflo(x0.z), bfhi(x0.z), bflo(x0.w), bfhi(x0.w)}; }
        }
    }
    LDS_WAIT();
#pragma unroll 1
    for (int nt = 0; nt < 2; ++nt) {
        const int j = ch0 + 32 * nt + l31;
        bf16x8 wf[2][4];
#pragma unroll
        for (int gt = 0; gt < 2; ++gt) { const float* wg = A.in[gt == 0 ? 25 : 27] + (size_t)hb * 4096 + 32 * nt + l31;
#pragma unroll
            for (int ks = 0; ks < 4; ++ks) { float v[8];
#pragma unroll
                for (int e = 0; e < 8; ++e) v[e] = wg[(8 * hh + 16 * ks + e) * 64];
                wf[gt][ks] = pack8(v); } }
        const float brg = A.in[26][j], big = A.in[28][j], sp = log1pf(expf(-A.in[29][j]));
        float H = 0.f, Ap = 1.f;
        if (FINAL) { const float* pa = CA + (size_t)b * NCHUNK * DRNN + j; const float* ph = CH + (size_t)b * NCHUNK * DRNN + j;
            for (int c0 = 0; c0 < c; c0 += 8) { float ca[8], cv[8];
#pragma unroll
                for (int u = 0; u < 8; ++u) { ca[u] = pa[(size_t)(c0 + u) * DRNN]; cv[u] = ph[(size_t)(c0 + u) * DRNN]; }
#pragma unroll
                for (int u = 0; u < 8; ++u) H = (c0 + u < c) ? ca[u] * H + cv[u] : H; } }
#pragma unroll 1
        for (int tt = 0; tt < 2; ++tt) {
            const int t0 = t00 + 32 * tt;
            f32x16 ar, ai;
#pragma unroll
            for (int r = 0; r < 16; ++r) { ar[r] = 0.f; ai[r] = 0.f; }
#pragma unroll
            for (int ks = 0; ks < 4; ++ks) { float v[8];
#pragma unroll
                for (int e = 0; e < 8; ++e) v[e] = xcs[(32 * tt + l31) * 65 + 8 * hh + 16 * ks + e];
                const bf16x8 af = pack8(v); ar = MFMA32(af, wf[0][ks], ar); ai = MFMA32(af, wf[1][ks], ai); }
            float rgv[16];
            if (FINAL) {
#pragma unroll
                for (int r = 0; r < 16; ++r) { const int tk = 8 * (r >> 2) + 4 * hh + (r & 3); rgv[r] = bf1(Z[((size_t)b * SEQ + t0 + tk) * DIN + ZRG + j]); } }
#pragma unroll
            for (int r = 0; r < 16; ++r) { const int tk = 8 * (r >> 2) + 4 * hh + (r & 3);
                const float rg_ = fsig(ar[r] + brg), ig_ = fsig(ai[r] + big); const float la = -8.f * rg_ * sp; const float a = fexp(la);
                const float mult = sqrtf(fmaxf(-expm1f(2.f * la), 0.f)); ar[r] = a; ai[r] = mult * ig_ * xcs[(32 * tt + tk) * 65 + 32 * nt + l31]; }
            float Hs[4];
#pragma unroll
            for (int g4 = 0; g4 < 4; ++g4) { float Aa = 1.f, U = 0.f;
#pragma unroll
                for (int r4 = 0; r4 < 4; ++r4) { const float a = ar[4 * g4 + r4]; U = a * U + ai[4 * g4 + r4]; Aa *= a; }
                const float pA = __shfl_xor(Aa, 32), pU = __shfl_xor(U, 32);
                const float A0 = hh == 0 ? Aa : pA, U0 = hh == 0 ? U : pU, A1 = hh == 0 ? pA : Aa, U1 = hh == 0 ? pU : U;
                const float Hs0 = H; H = A0 * H + U0; const float Hs1 = H; H = A1 * H + U1; Hs[g4] = hh == 0 ? Hs0 : Hs1; Ap *= A0 * A1; }
            if (FINAL) {
#pragma unroll
                for (int g4 = 0; g4 < 4; ++g4) { float h = Hs[g4];
#pragma unroll
                    for (int r4 = 0; r4 < 4; ++r4) { const int r = 4 * g4 + r4, tk = 8 * g4 + 4 * hh + r4; h = ar[r] * h + ai[r];
                        ORNN[((size_t)b * SEQ + t0 + tk) * DRNN + j] = (bf16)(pk2(h * gelu_tanh(rgv[r]), 0.f) & 0xffffu); } } }
        }
        if (!FINAL) { if (hh == 0) { const size_t o = ((size_t)b * NCHUNK + c) * DRNN + j; CA[o] = Ap; CH[o] = H; } }
        else if (c == NCHUNK - 1 && hh == 0) A.out[O_HP + (size_t)b * DRNN + j] = H;
    }
    LDS_WAIT();
}
__device__ __forceinline__ void rnn_sample_item(const Args& A, int bs, int hb, int lane) {
    unsigned char* ws = A.ws; const bf16* Z = (const bf16*)(ws + WS_HZ); bf16* ORNN = (bf16*)(ws + WS_ORNN);
    const int ch = hb * 64 + lane; const size_t row = MPROMPT + bs;
    const float* sc = A.in[7] + (size_t)bs * 3 * DRNN + ch; const float b0 = sc[0], b1 = sc[DRNN], b2 = sc[2 * DRNN];
    const float rx = bf1(Z[row * DIN + ZRX + ch]), rg = bf1(Z[row * DIN + ZRG + ch]);
    const float xc = A.in[24][ch] + A.in[23][ch] * b0 + A.in[23][DRNN + ch] * b1 + A.in[23][2 * DRNN + ch] * b2 + A.in[23][3 * DRNN + ch] * rx;
    const float* wr = A.in[25] + (size_t)hb * 4096 + lane; const float* wi = A.in[27] + (size_t)hb * 4096 + lane;
    float ar = A.in[26][ch], ai = A.in[28][ch];
#pragma unroll 16
    for (int i = 0; i < 64; ++i) { const float xi = __shfl(xc, i); ar += xi * wr[i * 64]; ai += xi * wi[i * 64]; }
    const float rg_ = fsig(ar), ig_ = fsig(ai), la = -8.f * rg_ * log1pf(expf(-A.in[29][ch])), a = expf(la), mult = sqrtf(fmaxf(-expm1f(2.f * la), 0.f));
    const float h = a * A.in[6][(size_t)bs * DRNN + ch] + mult * ig_ * xc;
    A.out[O_HS + (size_t)bs * DRNN + ch] = h;
    ORNN[row * DRNN + ch] = (bf16)(pk2(h * gelu_tanh(rg), 0.f) & 0xffffu);
    float* co = A.out + O_CS + (size_t)bs * 3 * DRNN + ch; co[0] = b1; co[DRNN] = b2; co[2 * DRNN] = rx;
}

#define XB_TMO      128
#define XB_XCNT(j)  (256  + 64 * (j))
#define XB_XSUB(j)  (1280 + 64 * (j))
#define XB_XGEN(j)  (2304 + 64 * (j))
#define XB_TOP      3328
#define XB_TOPGEN   3392
#define XCD_BAR_WORDS 3456
#define XB_SPIN_CAP (1u << 18)

__device__ __forceinline__ unsigned xb_ld(unsigned* p)              { return __hip_atomic_load(p, __ATOMIC_RELAXED, __HIP_MEMORY_SCOPE_AGENT); }
__device__ __forceinline__ unsigned xb_add(unsigned* p, unsigned v) { return __hip_atomic_fetch_add(p, v, __ATOMIC_RELAXED, __HIP_MEMORY_SCOPE_AGENT); }
__device__ __forceinline__ unsigned xb_xcc_id() { return (unsigned)__builtin_amdgcn_s_getreg((3 << 11) | 20) & 0xFu; }
#define XB_SPIN(cond, bar) do { unsigned _sp = 0; while (cond) { __builtin_amdgcn_s_sleep(1); \
    if ((++_sp & 255u) == 0u) { if (xb_ld(&(bar)[XB_TMO])) break; if (_sp > XB_SPIN_CAP) { atomicAdd(&(bar)[XB_TMO], 1u); break; } } } } while (0)

struct XcdBarrier {
    unsigned* bar; unsigned x;
    volatile LAS unsigned* st;
};

__device__ __forceinline__ XcdBarrier xcd_barrier_post(unsigned* bar, volatile LAS unsigned* st) {
    XcdBarrier b; b.bar = bar; b.x = xb_xcc_id(); b.st = st;
    if (threadIdx.x == 0) (void)xb_add(&bar[XB_XCNT(b.x)], 1u);
    return b;
}
__device__ __forceinline__ void xcd_barrier_complete(unsigned* bar, unsigned x, unsigned& nloc, unsigned& nx) {
    const unsigned G = gridDim.x * gridDim.y * gridDim.z;
    unsigned sum, cnt, mine, sp = 0u;
    for (;;) {
        sum = 0u; cnt = 0u; mine = 0u;
#pragma unroll
        for (unsigned j = 0; j < 16; ++j) { const unsigned c = xb_ld(&bar[XB_XCNT(j)]); sum += c; cnt += (c > 0u) ? 1u : 0u; mine = (j == x) ? c : mine; }
        if (sum == G) break;
        __builtin_amdgcn_s_sleep(1);
        if ((++sp & 255u) == 0u) { if (xb_ld(&bar[XB_TMO])) break; if (sp > XB_SPIN_CAP) { atomicAdd(&bar[XB_TMO], 1u); break; } }
    }
    nloc = mine > 0u ? mine : 1u; nx = cnt > 0u ? cnt : 1u;
}

__device__ __forceinline__ void xcd_barrier(const XcdBarrier& b) {
    asm volatile("s_waitcnt vmcnt(0)" ::: "memory");
    __syncthreads();
    if (threadIdx.x == 0) {
        unsigned* bar = b.bar;
        __builtin_amdgcn_s_waitcnt(0);
        unsigned nloc = b.st[0], nx = b.st[1];
        if (nloc == 0u) { xcd_barrier_complete(bar, b.x, nloc, nx); b.st[0] = nloc; b.st[1] = nx; }
        const unsigned old = xb_add(&bar[XB_XSUB(b.x)], 1u);
        const unsigned gen = old / nloc;
        if (old + 1u == (gen + 1u) * nloc) {
            __builtin_amdgcn_fence(__ATOMIC_RELEASE, "agent");
            asm volatile("s_waitcnt vmcnt(0)" ::: "memory");
            const unsigned og = xb_add(&bar[XB_TOP], 1u);
            const unsigned tg = og / nx;
            if (og + 1u == (tg + 1u) * nx) xb_add(&bar[XB_TOPGEN], 1u);
            else XB_SPIN(xb_ld(&bar[XB_TOPGEN]) == tg, bar);
            __builtin_amdgcn_fence(__ATOMIC_ACQUIRE, "agent");
            xb_add(&bar[XB_XGEN(b.x)], 1u);
            asm volatile("s_waitcnt vmcnt(0)" ::: "memory");
        } else {
            XB_SPIN(xb_ld(&bar[XB_XGEN(b.x)]) == gen, bar);
            __builtin_amdgcn_fence(__ATOMIC_ACQUIRE, "agent");
            asm volatile("s_waitcnt vmcnt(0)" ::: "memory");
        }
    }
    __syncthreads();
}

__global__ void __launch_bounds__(NTHREADS, 2) mk_fwd(Args args) {
    extern __shared__ __attribute__((aligned(16))) unsigned char lds_raw[];
    LAS unsigned char* lds = (LAS unsigned char*)lds_raw;
    const int tid = threadIdx.x, lane = tid & 63, wave = __builtin_amdgcn_readfirstlane(tid >> 6);
    const int G = gridDim.x, bx = blockIdx.x;
    unsigned char* ws = args.ws;
    const int lo = args.ph_lo, hi = args.ph_hi;
    if (tid < 16) ((LAS unsigned*)(lds + MISC_OFF))[tid] = 0u;
    __syncthreads();
    if (hi > 1000) cg::this_grid().sync();
    XcdBarrier bar; bar.bar = (unsigned*)(ws + WS_BAR); bar.x = 0; bar.st = nullptr;
    if (hi - lo > 1) bar = xcd_barrier_post((unsigned*)(ws + WS_BAR), (volatile LAS unsigned*)(lds + MISC_OFF));
    bf16* XN = (bf16*)(ws + WS_XN); bf16* HB = (bf16*)(ws + WS_HZ); bf16* ZB = (bf16*)(ws + WS_HZ); float* XB = (float*)(ws + WS_X); float* MOD = (float*)(ws + WS_MOD);
    bf16* OATT = (bf16*)(ws + WS_OATT); bf16* ORNN = (bf16*)(ws + WS_ORNN); bf16* MIX = (bf16*)(ws + WS_MIX);
#ifndef PH_MASK
#define PH_MASK 0x1fff
#endif
#define IN(k) (((PH_MASK >> (k)) & 1) && lo <= (k) && (k) < hi)
#define SEAM(k) do { if (IN(k) && IN((k) + 1)) { xcd_barrier(bar); } } while (0)

    if (IN(0)) { p0_prologue(args, lds, tid, wave, lane); } SEAM(0);
    if (IN(1)) { norm_phase(args.in[0], args.in[1], args.in[10], MOD, 0, XN, wave, lane); } SEAM(1);
    LAS float* red = (LAS float*)lds;
    const float* MODS = MOD;
    if (IN(2)) { for (int it = bx - 128; it >= 0 && it < DFF / 32; it += 128) sg_ffn_up(XN, (const bf16*)(ws + WS_W13A), HB, it, red, wave, lane);
        pg8::Gemm g{XN, (const bf16*)(ws + WS_W13A), MPROMPT, 2 * DFF, DM}; pg8::StaticOrder S; S.init(MPROMPT, 2 * DFF, G, bx); pg8::EpiSwiGLU E{HB, DFF};
        pg8::gemm_phase<pg8::EpiSwiGLU, pg8::StaticOrder, true, true>(lds, g, S, E); } SEAM(2);
    if (IN(3)) { for (int it = bx; it < DM / 32; it += G) sg_res(HB + (size_t)MPROMPT * DFF, DFF, (const bf16*)(ws + WS_W2A), args.in[1], XB + (size_t)MPROMPT * DM, MODS + 2 * DM, 0.5f, it, red, wave, lane);
        pg8::Gemm g{HB, (const bf16*)(ws + WS_W2A), MPROMPT, DM, DFF}; pg8::StaticOrder S; S.init(MPROMPT, DM, G, bx); pg8::EpiRes E{args.in[0], args.in[1], XB, MOD + 2 * DM, 0.5f};
        pg8::gemm_phase<pg8::EpiRes, pg8::StaticOrder, true, true>(lds, g, S, E); } SEAM(3);
    if (IN(4)) { norm_phase(XB, XB + (size_t)MPROMPT * DM, args.in[11], MOD, 3, XN, wave, lane); } SEAM(4);
    if (IN(5)) { for (int it = bx - 192; it >= 0 && it < DIN / 32; it += 64) sg_z(XN, (const bf16*)(ws + WS_WIN), ZB, it, red, wave, lane);
        pg8::Gemm g{XN, (const bf16*)(ws + WS_WIN), MPROMPT, DIN, DM}; pg8::StaticOrder S; S.init(MPROMPT, DIN, G, bx); pg8::EpiBf16<0> E{ZB, DIN, nullptr, 0, 0, 1.f};
        pg8::gemm_phase<pg8::EpiBf16<0>, pg8::StaticOrder, true, true>(lds, g, S, E); } SEAM(5);
    if (IN(6)) {
#ifndef NO_ATTN
        for (int it = bx; it < 256; it += G) attn_item(args, lds, it >> 7, (it >> 2) & 31, it & 3, tid, wave, lane);
#endif
#ifndef NO_RNN
        for (int it = bx; it < 4 * NCHUNK; it += G) rnn_item<false>(args, (LAS float*)(lds + wave * 16640), it >> 7, (it >> 1) & 63, (it & 1) * 8 + wave, lane);
#endif
        __syncthreads();
#ifndef NO_SATTN
        for (int it = (G - 1 - bx) * NWAVES + wave; it < NSAMP * 16; it += G * NWAVES) attn_sample_item(args, (LAS float*)(lds + wave * 768), it >> 4, it & 15, lane);
#endif
    } SEAM(6);
    if (IN(7)) {
        for (int it = bx; it < 4 * NCHUNK; it += G) rnn_item<true>(args, (LAS float*)(lds + wave * 16640), it >> 7, (it >> 1) & 63, (it & 1) * 8 + wave, lane);
        for (int it = (G - 1 - bx) * NWAVES + wave; it < NSAMP * 16; it += G * NWAVES) rnn_sample_item(args, it >> 4, it & 15, lane);
        __syncthreads();
        pg8::Gemm g{OATT, (const bf16*)(ws + WS_WPA), MPROMPT, DM, DATT}; pg8::StaticOrder S; S.init(MPROMPT, DM, G, bx); pg8::EpiGateMix<false> E{MIX, ZB + ZGA};
        pg8::gemm_phase<pg8::EpiGateMix<false>, pg8::StaticOrder, true, true>(lds, g, S, E); } SEAM(7);
    if (IN(8)) { for (int it = bx; it < DM / 32; it += G) sg_mix(OATT, ORNN, (const bf16*)(ws + WS_WPA), (const bf16*)(ws + WS_WPR), ZB, MIX, it, red, wave, lane);
        pg8::Gemm g{ORNN, (const bf16*)(ws + WS_WPR), MPROMPT, DM, DRNN}; pg8::StaticOrder S; S.init(MPROMPT, DM, G, bx); pg8::EpiGateMix<true> E{MIX, ZB + ZGR};
        pg8::gemm_phase<pg8::EpiGateMix<true>, pg8::StaticOrder, true, true>(lds, g, S, E); } SEAM(8);
    if (IN(9)) { for (int it = bx; it < DM / 32; it += G) sg_res(MIX + (size_t)MPROMPT * DM, DM, (const bf16*)(ws + WS_WOUT), XB + (size_t)MPROMPT * DM, XB + (size_t)MPROMPT * DM, MODS + 5 * DM, 1.f, it, red, wave, lane);
        pg8::Gemm g{MIX, (const bf16*)(ws + WS_WOUT), MPROMPT, DM, DM}; pg8::StaticOrder S; S.init(MPROMPT, DM, G, bx); pg8::EpiRes E{XB, XB + (size_t)MPROMPT * DM, XB, MOD + 5 * DM, 1.f};
        pg8::gemm_phase<pg8::EpiRes, pg8::StaticOrder, true, true>(lds, g, S, E); } SEAM(9);
    if (IN(10)) { norm_phase(XB, XB + (size_t)MPROMPT * DM, args.in[12], MOD, 6, XN, wave, lane); } SEAM(10);
    if (IN(11)) { for (int it = bx - 128; it >= 0 && it < DFF / 32; it += 128) sg_ffn_up(XN, (const bf16*)(ws + WS_W13B), HB, it, red, wave, lane);
        pg8::Gemm g{XN, (const bf16*)(ws + WS_W13B), MPROMPT, 2 * DFF, DM}; pg8::StaticOrder S; S.init(MPROMPT, 2 * DFF, G, bx); pg8::EpiSwiGLU E{HB, DFF};
        pg8::gemm_phase<pg8::EpiSwiGLU, pg8::StaticOrder, true, true>(lds, g, S, E); } SEAM(11);
    if (IN(12)) { for (int it = bx; it < DM / 32; it += G) sg_res(HB + (size_t)MPROMPT * DFF, DFF, (const bf16*)(ws + WS_W2B), XB + (size_t)MPROMPT * DM, args.out + O_Y + (size_t)MPROMPT * DM, MODS + 8 * DM, 0.5f, it, red, wave, lane);
        pg8::Gemm g{HB, (const bf16*)(ws + WS_W2B), MPROMPT, DM, DFF}; pg8::StaticOrder S; S.init(MPROMPT, DM, G, bx); pg8::EpiRes E{XB, XB + (size_t)MPROMPT * DM, args.out + O_Y, MOD + 8 * DM, 0.5f};
        pg8::gemm_phase<pg8::EpiRes, pg8::StaticOrder, true, true>(lds, g, S, E); }
#undef IN
#undef SEAM
}

extern "C" void kernel_launch(void* const* d_in, const int* in_sizes, int n_in, void* d_out, int out_size, void* d_ws, size_t ws_size, hipStream_t stream) {
    static int grid = 0;
    if (grid == 0) {
        if (n_in != 33 || out_size != (int)O_END || ws_size < WS_END) { fprintf(stderr, "kernel_launch: unexpected shapes: n_in %d out %d ws %zu\n", n_in, out_size, ws_size); grid = -1; return; }
        int dev = 0, cus = 0, per_cu = 0;
        hipGetDevice(&dev); hipDeviceGetAttribute(&cus, hipDeviceAttributeMultiprocessorCount, dev);
        hipFuncSetAttribute((const void*)mk_fwd, hipFuncAttributeMaxDynamicSharedMemorySize, LDS_BYTES);
        hipOccupancyMaxActiveBlocksPerMultiprocessor(&per_cu, (const void*)mk_fwd, NTHREADS, LDS_BYTES);
        if (per_cu < 1) { fprintf(stderr, "kernel_launch: occupancy query says %d blocks per CU\n", per_cu); grid = -1; return; }
        grid = cus;
    }
    if (grid < 0) return;
    Args a{};
    for (int i = 0; i < 33; ++i) a.in[i] = (const float*)d_in[i];
    a.out = (float*)d_out; a.ws = (unsigned char*)d_ws;
#if MK_ONE_LAUNCH
    if (hipMemsetAsync((char*)d_ws + WS_BAR, 0, 65536, stream) != hipSuccess) { fprintf(stderr, "memset failed\n"); return; }
    a.ph_lo = 0; a.ph_hi = 13;
    void* kargs[] = {&a};
    hipError_t e = hipLaunchCooperativeKernel((const void*)mk_fwd, dim3(grid), dim3(NTHREADS), kargs, LDS_BYTES, stream);
    if (e != hipSuccess) fprintf(stderr, "cooperative launch failed: %s (grid %d)\n", hipGetErrorString(e), grid);
#else
    for (int p = 0; p < 13; ++p) { a.ph_lo = p; a.ph_hi = p + 1; hipLaunchKernelGGL(mk_fwd, dim3(grid), dim3(NTHREADS), LDS_BYTES, stream, a); }
#endif
}
```

```cpp
#include <hip/hip_runtime.h>
#include <hip/hip_cooperative_groups.h>
#include <cstdio>
#include <cstdint>
#include <cmath>
namespace pg8 {
#define PG8_LAS __attribute__((address_space(3)))
typedef unsigned short bf16_t;
typedef short bf16x8 __attribute__((ext_vector_type(8)));
typedef float f32x4 __attribute__((ext_vector_type(4)));
typedef unsigned u32x4 __attribute__((ext_vector_type(4)));
constexpr int BM = 256, BK = 64, HALF = 128, HTB = HALF * BK * 2  , STAGE_BYTES = 8 * HTB, NXCD = 8, WGM = 8;

__host__ __device__ __forceinline__ int lds_byte(int r, int c) { const int st = (r >> 4) * 2 + (c >> 5), rr = r & 15, cc = c & 31, ob = rr * 64 + cc * 2; return st * 1024 + (ob ^ (((ob >> 9) & 1) << 5)); }
__host__ __device__ __forceinline__ void stage_rc(int b, int& R, int& C) { const int st = b / 1024, sb = b % 1024, swz = sb ^ (((sb >> 9) & 1) << 5); R = (st >> 1) * 16 + swz / 64; C = (st & 1) * 32 + (swz % 64) / 2; }
__host__ __device__ __forceinline__ int perm32(int rho) { const int n = rho >> 4, i = rho & 15; return 8 * (i >> 2) + 4 * n + (i & 3); }

struct Unit { int pm, pn; };
struct Gemm { const bf16_t* A; const bf16_t* Bt; int M, N, K; };

struct StaticOrder {
    int nM, nN, nwg, G, c;
    __host__ __device__ void init(int M, int N, int G_, int c_) { nM = M / BM; nN = N / BM; nwg = nM * nN; G = G_; c = c_; }
    __host__ __device__ bool next(int i, Unit& u) const {
        const long L = (long)i * G + c; if (L >= nwg) return false;
        int wgid = (int)L; { const int q = nwg / NXCD, r = nwg % NXCD, xcd = wgid % NXCD, off = wgid / NXCD; wgid = (xcd < r ? xcd * (q + 1) : r * (q + 1) + (xcd - r) * q) + off; }
        const int nig = WGM * nN, gid = wgid / nig, fm = gid * WGM, gsz = (nM - fm) < WGM ? (nM - fm) : WGM;
        u.pm = fm + ((wgid % nig) % gsz); u.pn = (wgid % nig) / gsz; return true;
    }
    __device__ __forceinline__ void a_ready(const Unit&) const {}
    __device__ __forceinline__ void done(const Unit&) const {}
};

__device__ __forceinline__ unsigned cvt_pk_bf16(float lo, float hi) { unsigned r; asm volatile("v_cvt_pk_bf16_f32 %0, %1, %2" : "=v"(r) : "v"(lo), "v"(hi)); return r; }
typedef float f32x2 __attribute__((ext_vector_type(2)));
__device__ __forceinline__ f32x2 gelu_pk(f32x2 v) {
    const f32x2 av = __builtin_elementwise_abs(v), d = av * 0.2316418882f + 1.0f;
    f32x2 t; t.x = __builtin_amdgcn_rcpf(d.x); t.y = __builtin_amdgcn_rcpf(d.y);
    f32x2 q = t * 0.5307027145f + (-0.7265760135f); q = q * t + 0.7107068705f; q = q * t + (-0.142248368f); q = q * t + 0.127414796f; q = q * t;
    const f32x2 s = (v * v) * (-0.72134752044f);
    f32x2 e; e.x = __builtin_amdgcn_exp2f(s.x); e.y = __builtin_amdgcn_exp2f(s.y);
    const f32x2 m = v * (q * e), r = v - m;
    f32x2 o; o.x = v.x < 0.f ? m.x : r.x; o.y = v.y < 0.f ? m.y : r.y; return o;
}

template <int ACT  > struct EpiBf16 {
    static constexpr bool PERM = true, AFTER_DRAIN = false; static_assert(ACT == 0 || ACT == 1, "EpiBf16: ACT is 0 (none) or 1 (gelu_pk)");
    bf16_t* O; int ldc; const float* bias; int split_cols; size_t split_stride; float scale0;
    __device__ __forceinline__ void operator()(const f32x4 (&acc)[2][2][4][2], const Unit& u, int wr, int wc, int fr, int fq) const {
        const int row0 = u.pm * BM + wr * 64 + fr; int colt = u.pn * BM; bf16_t* base = O;
        float sc = 1.f; if (split_cols) { const int t = colt / split_cols; base += (size_t)t * split_stride; colt -= t * split_cols; if (t == 0) sc = scale0; }
        const int col0 = colt + wc * 32 + 8 * fq, bcol0 = u.pn * BM + wc * 32 + 8 * fq;
        f32x4 bv[2][2];
#pragma unroll
        for (int bj = 0; bj < 2; ++bj)
#pragma unroll
            for (int n = 0; n < 2; ++n) bv[bj][n] = bias ? *(const f32x4*)(bias + bcol0 + bj * HALF + 4 * n) : (f32x4){0.f, 0.f, 0.f, 0.f};
#pragma unroll
        for (int ai = 0; ai < 2; ++ai)
#pragma unroll
            for (int m = 0; m < 4; ++m) { bf16_t* rowp = base + (size_t)(row0 + ai * HALF + m * 16) * ldc + col0;
#pragma unroll
                for (int bj = 0; bj < 2; ++bj) { f32x4 v0 = acc[ai][bj][m][0] + bv[bj][0], v1 = acc[ai][bj][m][1] + bv[bj][1];
                    if (ACT == 1) { f32x2 a = gelu_pk((f32x2){v0[0], v0[1]}), b = gelu_pk((f32x2){v0[2], v0[3]}), c = gelu_pk((f32x2){v1[0], v1[1]}), d = gelu_pk((f32x2){v1[2], v1[3]});
                        v0 = (f32x4){a.x, a.y, b.x, b.y}; v1 = (f32x4){c.x, c.y, d.x, d.y}; }
                    v0 = v0 * sc; v1 = v1 * sc; u32x4 w; w.x = cvt_pk_bf16(v0[0], v0[1]); w.y = cvt_pk_bf16(v0[2], v0[3]); w.z = cvt_pk_bf16(v1[0], v1[1]); w.w = cvt_pk_bf16(v1[2], v1[3]);
                    *(u32x4*)(rowp + bj * HALF) = w; } }
    }
};
constexpr int MROWS_VALID = 8224, MROWS_PROMPT = 8192;
__device__ __forceinline__ float fsigmoid(float x) { return __builtin_amdgcn_rcpf(1.f + __builtin_amdgcn_exp2f(-1.44269504f * x)); }
__device__ __forceinline__ float fsilu(float x) { return x * fsigmoid(x); }
__device__ __forceinline__ float bflo(unsigned w) { return __uint_as_float(w << 16); }
__device__ __forceinline__ float bfhi(unsigned w) { return __uint_as_float(w & 0xffff0000u); }

struct EpiSwiGLU {
    static constexpr bool PERM = true, AFTER_DRAIN = false;
    bf16_t* O; int ldc;
    __device__ __forceinline__ void operator()(const f32x4 (&acc)[2][2][4][2], const Unit& u, int wr, int wc, int fr, int fq) const {
        const int row0 = u.pm * BM + wr * 64 + fr, col0 = u.pn * HALF + wc * 32 + 8 * fq;
#pragma unroll
        for (int ai = 0; ai < 2; ++ai)
#pragma unroll
            for (int m = 0; m < 4; ++m) {
                bf16_t* p = O + (size_t)(row0 + ai * HALF + m * 16) * ldc + col0;
                const f32x4 a0 = acc[ai][0][m][0], a1 = acc[ai][0][m][1], b0 = acc[ai][1][m][0], b1 = acc[ai][1][m][1];
                u32x4 w;
                w.x = cvt_pk_bf16(fsilu(a0[0]) * b0[0], fsilu(a0[1]) * b0[1]); w.y = cvt_pk_bf16(fsilu(a0[2]) * b0[2], fsilu(a0[3]) * b0[3]);
                w.z = cvt_pk_bf16(fsilu(a1[0]) * b1[0], fsilu(a1[1]) * b1[1]); w.w = cvt_pk_bf16(fsilu(a1[2]) * b1[2], fsilu(a1[3]) * b1[3]);
                *(u32x4*)p = w;
            }
    }
};
struct EpiRes {
    static constexpr bool PERM = false, AFTER_DRAIN = false;
    const float* base_p; const float* base_s; float* out; const float* gate; float gs;
    __device__ __forceinline__ void operator()(const f32x4 (&acc)[2][2][4][2], const Unit& u, int wr, int wc, int fr, int fq) const {
        const int col0 = u.pn * BM + wc * 32 + 4 * fq;
#pragma unroll
        for (int ai = 0; ai < 2; ++ai)
#pragma unroll
            for (int m = 0; m < 4; ++m) {
                const int row = u.pm * BM + ai * HALF + wr * 64 + m * 16 + fr;
                if (row < MROWS_VALID) {
                    const int br = row < MROWS_PROMPT ? (row >> 12) : (2 + row - MROWS_PROMPT);
                    const float* bp = row < MROWS_PROMPT ? base_p + (size_t)row * 2048 : base_s + (size_t)(row - MROWS_PROMPT) * 2048;
                    const float* gp = gate + (size_t)br * 18432; float* op = out + (size_t)row * 2048;
#pragma unroll
                    for (int bj = 0; bj < 2; ++bj)
#pragma unroll
                        for (int n = 0; n < 2; ++n) { const int c = col0 + bj * HALF + n * 16;
                            const f32x4 g = *(const f32x4*)(gp + c), b = *(const f32x4*)(bp + c);
                            *(f32x4*)(op + c) = b + (g * gs) * acc[ai][bj][m][n]; }
                }
            }
    }
};
template <bool ACCUM> struct EpiGateMix {
    static constexpr bool PERM = true, AFTER_DRAIN = false;
    bf16_t* O; const bf16_t* Zg;
    __device__ __forceinline__ void operator()(const f32x4 (&acc)[2][2][4][2], const Unit& u, int wr, int wc, int fr, int fq) const {
        const int row0 = u.pm * BM + wr * 64 + fr, col0 = u.pn * BM + wc * 32 + 8 * fq;
#pragma unroll
        for (int ai = 0; ai < 2; ++ai)
#pragma unroll
            for (int m = 0; m < 4; ++m) { const int row = row0 + ai * HALF + m * 16;
#pragma unroll
                for (int bj = 0; bj < 2; ++bj) { const int c = col0 + bj * HALF;
                    const u32x4 gz = *(const u32x4*)(Zg + (size_t)row * 7680 + c);
                    bf16_t* op = O + (size_t)row * 2048 + c;
                    const f32x4 v0 = acc[ai][bj][m][0], v1 = acc[ai][bj][m][1];
                    float r0 = fsigmoid(bflo(gz.x)) * v0[0], r1 = fsigmoid(bfhi(gz.x)) * v0[1], r2 = fsigmoid(bflo(gz.y)) * v0[2], r3 = fsigmoid(bfhi(gz.y)) * v0[3];
                    float r4 = fsigmoid(bflo(gz.z)) * v1[0], r5 = fsigmoid(bfhi(gz.z)) * v1[1], r6 = fsigmoid(bflo(gz.w)) * v1[2], r7 = fsigmoid(bfhi(gz.w)) * v1[3];
                    if (ACCUM) { const u32x4 pv = *(const u32x4*)op;
                        r0 += bflo(pv.x); r1 += bfhi(pv.x); r2 += bflo(pv.y); r3 += bfhi(pv.y); r4 += bflo(pv.z); r5 += bfhi(pv.z); r6 += bflo(pv.w); r7 += bfhi(pv.w); }
                    u32x4 w; w.x = cvt_pk_bf16(r0, r1); w.y = cvt_pk_bf16(r2, r3); w.z = cvt_pk_bf16(r4, r5); w.w = cvt_pk_bf16(r6, r7);
                    *(u32x4*)op = w; }
            }
    }
};
template <class Epi, class Sched, bool ALIGN_EPI = false, bool SP2 = false>
__device__ __forceinline__ void gemm_phase(PG8_LAS unsigned char* lds, const Gemm g, const Sched& S, const Epi& E) {
    const int tid = threadIdx.x, wid = __builtin_amdgcn_readfirstlane(tid >> 6), lane = tid & 63, wr = wid >> 2, wc = wid & 3, fr = lane & 15, fq = lane >> 4;
    const int K = g.K, nt = K / BK;
    unsigned voffA[2], voffB[2];
#pragma unroll
    for (int i = 0; i < 2; ++i) { int R, C; stage_rc(tid * 16 + i * 8192, R, C); const int Rb = Epi::PERM ? ((R & ~31) + perm32(R & 31)) : R;
        voffA[i] = (unsigned)(R * K + C) * 2u; voffB[i] = (unsigned)(Rb * K + C) * 2u; }
    const size_t kstep = (size_t)(BK * 2);
    const size_t hstep = (size_t)HALF * K * 2;
    const size_t tstep = 2 * hstep;
    const unsigned ldsw = (unsigned)wid * 1024u;
    const int aoff = lds_byte(wr * 64 + fr, fq * 8), boff = lds_byte(wc * 32 + fr, fq * 8);
#define PG8_SA(b, h) (((b) * 2 + (h)) * HTB)
#define PG8_SB(b, h) ((4 + (b) * 2 + (h)) * HTB)
#define PG8_STAGE(bufoff, gbase, voff) do { _Pragma("unroll") for (int _i = 0; _i < 2; ++_i) \
        __builtin_amdgcn_global_load_lds((const unsigned*)((const char*)(gbase) + (voff)[_i]), (PG8_LAS unsigned*)(lds + (bufoff) + ldsw + _i * 8192), 16, 0, 0); } while (0)
#define PG8_LDA(dst, b, h) do { _Pragma("unroll") for (int m = 0; m < 4; ++m) _Pragma("unroll") for (int k = 0; k < 2; ++k) dst[m][k] = *(const PG8_LAS bf16x8*)(lds + PG8_SA(b, h) + aoff + m * 2048 + k * 1024); } while (0)
#define PG8_LDB(dst, b, h) do { _Pragma("unroll") for (int n = 0; n < 2; ++n) _Pragma("unroll") for (int k = 0; k < 2; ++k) dst[n][k] = *(const PG8_LAS bf16x8*)(lds + PG8_SB(b, h) + boff + n * 2048 + k * 1024); } while (0)
#define PG8_MMA(ai, bj, At, Bt) do { __builtin_amdgcn_s_setprio(1); _Pragma("unroll") for (int m = 0; m < 4; ++m) _Pragma("unroll") for (int n = 0; n < 2; ++n) _Pragma("unroll") for (int k = 0; k < 2; ++k) \
        acc[ai][bj][m][n] = __builtin_amdgcn_mfma_f32_16x16x32_bf16(Bt[n][k], At[m][k], acc[ai][bj][m][n], 0, 0, 0); __builtin_amdgcn_s_setprio(0); } while (0)
#define PG8_WAIT_V(n) asm volatile("s_waitcnt vmcnt(" #n ")" ::: "memory")
#define PG8_WAIT_L(n) asm volatile("s_waitcnt lgkmcnt(" #n ")" ::: "memory")
#define PG8_BAR __builtin_amdgcn_s_barrier()
#define PG8_SCHED __builtin_amdgcn_sched_barrier(0)
    Unit cur, nxt; int ui = 0;
    if (!S.next(0, cur)) return;
    f32x4 acc[2][2][4][2];
#pragma unroll
    for (int a = 0; a < 2; ++a)
#pragma unroll
        for (int b = 0; b < 2; ++b)
#pragma unroll
            for (int m = 0; m < 4; ++m)
#pragma unroll
                for (int n = 0; n < 2; ++n) acc[a][b][m][n] = (f32x4){0.f, 0.f, 0.f, 0.f};
    bf16x8 At[4][2], B0[2][2], B1[2][2];
    const char* cA = (const char*)g.A + (size_t)cur.pm * tstep; const char* cB = (const char*)g.Bt + (size_t)cur.pn * tstep;
    S.a_ready(cur);
    if constexpr (SP2) {
        PG8_STAGE(PG8_SB(0, 0), cB, voffB); PG8_STAGE(PG8_SB(0, 1), cB + hstep, voffB); PG8_STAGE(PG8_SA(0, 0), cA, voffA); PG8_STAGE(PG8_SA(0, 1), cA + hstep, voffA);
        if (wr == 1) PG8_BAR;
        PG8_WAIT_V(2); PG8_BAR;
        PG8_STAGE(PG8_SB(1, 0), cB + kstep, voffB); PG8_STAGE(PG8_SA(1, 0), cA + kstep, voffA); PG8_STAGE(PG8_SB(1, 1), cB + hstep + kstep, voffB);
        PG8_WAIT_V(6); PG8_BAR;
    } else {
        PG8_STAGE(PG8_SB(0, 0), cB, voffB); PG8_STAGE(PG8_SA(0, 0), cA, voffA); PG8_STAGE(PG8_SB(0, 1), cB + hstep, voffB); PG8_STAGE(PG8_SA(0, 1), cA + hstep, voffA);
        if (wr == 1) PG8_BAR;
        PG8_WAIT_V(4); PG8_BAR;
        PG8_STAGE(PG8_SB(1, 0), cB + kstep, voffB); PG8_STAGE(PG8_SA(1, 0), cA + kstep, voffA); PG8_STAGE(PG8_SB(1, 1), cB + hstep + kstep, voffB);
        PG8_WAIT_V(6); PG8_BAR;
    }
    for (;;) {
        const bool has_next = S.next(ui + 1, nxt);
        const char* nA = has_next ? (const char*)g.A + (size_t)nxt.pm * tstep : cA; const char* nB = has_next ? (const char*)g.Bt + (size_t)nxt.pn * tstep : cB;
        for (int t = 0; t < nt; t += 2) {
            const bool last = (t == nt - 2);
            const char* a1 = cA + (size_t)(t + 1) * kstep;
            const char* a2 = last ? nA : cA + (size_t)(t + 2) * kstep; const char* b2 = last ? nB : cB + (size_t)(t + 2) * kstep;
            const char* a3 = a2 + kstep; const char* b3 = b2 + kstep;
            if (last && has_next) S.a_ready(nxt);
            if constexpr (SP2) {
            PG8_LDB(B0, 0, 0); PG8_LDB(B1, 0, 1); PG8_SCHED; PG8_LDA(At, 0, 0); PG8_STAGE(PG8_SA(1, 1), a1 + hstep, voffA);
            PG8_WAIT_V(8); PG8_WAIT_L(0); PG8_BAR; PG8_MMA(0, 0, At, B0); PG8_MMA(0, 1, At, B1); PG8_BAR; PG8_SCHED;
            PG8_LDA(At, 0, 1); PG8_STAGE(PG8_SB(0, 0), b2, voffB); PG8_STAGE(PG8_SB(0, 1), b2 + hstep, voffB); PG8_STAGE(PG8_SA(0, 0), a2, voffA);
            PG8_WAIT_V(8); PG8_WAIT_L(0); PG8_BAR; PG8_MMA(1, 0, At, B0); PG8_MMA(1, 1, At, B1); PG8_BAR; PG8_SCHED;
            PG8_LDB(B0, 1, 0); PG8_LDB(B1, 1, 1); PG8_SCHED; PG8_LDA(At, 1, 0); PG8_STAGE(PG8_SA(0, 1), a2 + hstep, voffA);
            PG8_WAIT_V(8); PG8_WAIT_L(0); PG8_BAR; PG8_MMA(0, 0, At, B0); PG8_MMA(0, 1, At, B1); PG8_BAR; PG8_SCHED;
            PG8_LDA(At, 1, 1); PG8_STAGE(PG8_SB(1, 0), b3, voffB); PG8_STAGE(PG8_SB(1, 1), b3 + hstep, voffB); PG8_STAGE(PG8_SA(1, 0), a3, voffA);
            PG8_WAIT_V(8); PG8_WAIT_L(0); PG8_BAR; PG8_MMA(1, 0, At, B0); PG8_MMA(1, 1, At, B1); PG8_BAR; PG8_SCHED;
            } else {
            PG8_LDB(B0, 0, 0); PG8_SCHED; PG8_LDA(At, 0, 0); PG8_STAGE(PG8_SA(1, 1), a1 + hstep, voffA);
            PG8_WAIT_L(8); PG8_BAR; PG8_WAIT_L(0); PG8_MMA(0, 0, At, B0); PG8_BAR; PG8_SCHED;
            PG8_LDB(B1, 0, 1); PG8_STAGE(PG8_SB(0, 0), b2, voffB);
            PG8_BAR; PG8_WAIT_L(0); PG8_MMA(0, 1, At, B1); PG8_BAR;
            PG8_LDA(At, 0, 1); PG8_STAGE(PG8_SA(0, 0), a2, voffA);
            PG8_BAR; PG8_WAIT_L(0); PG8_MMA(1, 0, At, B0); PG8_BAR; PG8_SCHED;
            PG8_STAGE(PG8_SB(0, 1), b2 + hstep, voffB);
            PG8_WAIT_V(6); PG8_BAR; PG8_MMA(1, 1, At, B1); PG8_BAR;
            PG8_LDB(B0, 1, 0); PG8_SCHED; PG8_LDA(At, 1, 0); PG8_STAGE(PG8_SA(0, 1), a2 + hstep, voffA);
            PG8_WAIT_L(8); PG8_BAR; PG8_WAIT_L(0); PG8_MMA(0, 0, At, B0); PG8_BAR; PG8_SCHED;
            PG8_LDB(B1, 1, 1); PG8_STAGE(PG8_SB(1, 0), b3, voffB);
            PG8_BAR; PG8_WAIT_L(0); PG8_MMA(0, 1, At, B1); PG8_BAR;
            PG8_LDA(At, 1, 1); PG8_STAGE(PG8_SA(1, 0), a3, voffA);
            PG8_BAR; PG8_WAIT_L(0); PG8_MMA(1, 0, At, B0); PG8_BAR; PG8_SCHED;
            PG8_STAGE(PG8_SB(1, 1), b3 + hstep, voffB);
            PG8_WAIT_V(6); PG8_BAR; PG8_MMA(1, 1, At, B1); PG8_BAR;
            }
        }
        if constexpr (ALIGN_EPI) { if (wr == 0) PG8_BAR; }
        if constexpr (!Epi::AFTER_DRAIN) { E(acc, cur, wr, wc, fr, fq); S.done(cur); }
        if (!has_next) break;
#pragma unroll
        for (int a = 0; a < 2; ++a)
#pragma unroll
            for (int b = 0; b < 2; ++b)
#pragma unroll
                for (int m = 0; m < 4; ++m)
#pragma unroll
                    for (int n = 0; n < 2; ++n) acc[a][b][m][n] = (f32x4){0.f, 0.f, 0.f, 0.f};
        cur = nxt; cA = nA; cB = nB; ++ui;
        if constexpr (ALIGN_EPI) { if (wr == 1) PG8_BAR; }
    }
    PG8_WAIT_V(0);
    if constexpr (!ALIGN_EPI) { if (wr == 0) PG8_BAR; }
    PG8_BAR;
    if constexpr (Epi::AFTER_DRAIN) { E.fused(acc, cur, wr, wc, fr, fq, lds, wid, lane); S.done(cur); }
#undef PG8_SA
#undef PG8_SB
#undef PG8_STAGE
#undef PG8_LDA
#undef PG8_LDB
#undef PG8_MMA
#undef PG8_WAIT_V
#undef PG8_WAIT_L
#undef PG8_BAR
#undef PG8_SCHED
}
}
namespace cg = cooperative_groups;
#ifndef MK_ONE_LAUNCH
#define MK_ONE_LAUNCH 1
#endif
constexpr int NWAVES = 8, NTHREADS = 512;
constexpr int DM = 2048, SEQ = 4096, MPROMPT = 8192, NSAMP = 32, MROWS = 8224, MPAD = 8448;
constexpr int DFF = 5632, DIN = 7680, DATT = 1024, DRNN = 1024, MODW = 18432, NBROW = 34;
constexpr int ZQ = 0, ZK = 1024, ZV = 1280, ZRX = 1536, ZRG = 2560, ZGA = 3584, ZGR = 5632;
constexpr int NCHUNK = 64, TCHUNK = 64;
constexpr float EPSN = 1e-6f;
constexpr size_t O_Y = 0, O_KP = 16842752, O_VP = 16908288, O_KS = 16973824, O_VS = 16982016, O_HP = 16990208, O_HS = 16992256, O_CP = 17025024, O_CS = 17031168, O_END = 17129472;
constexpr size_t MiB = 1u << 20;
constexpr size_t WS_W13A = 0, WS_W2A = 44 * MiB, WS_W13B = 66 * MiB, WS_W2B = 110 * MiB, WS_WIN = 132 * MiB, WS_WPA = 162 * MiB, WS_WPR = 166 * MiB, WS_WOUT = 170 * MiB;
constexpr size_t WS_XN = 178 * MiB, WS_HZ = 211 * MiB, WS_X = 335 * MiB, WS_OATT = 401 * MiB, WS_ORNN = 418 * MiB, WS_MIX = 435 * MiB, WS_MOD = 468 * MiB, WS_ROPE = 471 * MiB;
constexpr size_t WS_CA = 473 * MiB, WS_CH = WS_CA + 512 * 1024, WS_BAR = 474 * MiB, WS_END = 475 * MiB;
constexpr int MISC_OFF = 147456 - 64;
constexpr int LDS_BYTES = 147456;

#define LAS __attribute__((address_space(3)))
typedef unsigned short bf16;
typedef unsigned v4u __attribute__((ext_vector_type(4)));
typedef unsigned v2u __attribute__((ext_vector_type(2)));
typedef float f32x4 __attribute__((ext_vector_type(4)));
typedef float f32x16 __attribute__((ext_vector_type(16)));
typedef short bf16x8 __attribute__((ext_vector_type(8)));
#define LDS_WAIT() asm volatile("s_waitcnt lgkmcnt(0)" ::: "memory")
#define MFMA32(a, b, c) __builtin_amdgcn_mfma_f32_32x32x16_bf16((a), (b), (c), 0, 0, 0)
#define MFMA16(a, b, c) __builtin_amdgcn_mfma_f32_16x16x32_bf16((a), (b), (c), 0, 0, 0)
__device__ __forceinline__ unsigned pk2(float lo, float hi) { return pg8::cvt_pk_bf16(lo, hi); }
__device__ __forceinline__ float bflo(unsigned w) { return __uint_as_float(w << 16); }
__device__ __forceinline__ float bfhi(unsigned w) { return __uint_as_float(w & 0xffff0000u); }
__device__ __forceinline__ float bf1(bf16 h) { return __uint_as_float((unsigned)h << 16); }
__device__ __forceinline__ float fsig(float x) { return __builtin_amdgcn_rcpf(1.f + __builtin_amdgcn_exp2f(-1.44269504f * x)); }
__device__ __forceinline__ float fexp(float x) { return __builtin_amdgcn_exp2f(1.44269504f * x); }
__device__ __forceinline__ float gelu_tanh(float x) { const float t = 0.7978845608f * (x + 0.044715f * x * x * x); return x * fsig(2.f * t); }
__device__ __forceinline__ bf16x8 pack8(const float (&v)[8]) { v4u p; p.x = pk2(v[0], v[1]); p.y = pk2(v[2], v[3]); p.z = pk2(v[4], v[5]); p.w = pk2(v[6], v[7]); return __builtin_bit_cast(bf16x8, p); }
__device__ __forceinline__ float wave_sum(float v) {
#pragma unroll
    for (int o = 1; o < 64; o <<= 1) v += __shfl_xor(v, o);
    return v;
}
__device__ __forceinline__ float wave_max(float v) {
#pragma unroll
    for (int o = 1; o < 64; o <<= 1) v = fmaxf(v, __shfl_xor(v, o));
    return v;
}

struct Args { const float* in[33]; float* out; unsigned char* ws; int ph_lo, ph_hi; };

__device__ __forceinline__ void transpose_item64(const float* __restrict__ W, int N, int K, bf16* __restrict__ WT, int k0, int n0, int drow0, LAS float* scr, int lane) {
    f32x4 v[16];
#pragma unroll
    for (int i = 0; i < 16; ++i) v[i] = *(const f32x4*)(W + (size_t)(k0 + (lane >> 4) + 4 * i) * N + n0 + (lane & 15) * 4);
#pragma unroll
    for (int i = 0; i < 16; ++i) { LAS float* s = scr + ((lane >> 4) + 4 * i) * 65 + (lane & 15) * 4; s[0] = v[i].x; s[1] = v[i].y; s[2] = v[i].z; s[3] = v[i].w; }
    LDS_WAIT();
    const int c = lane & 7;
#pragma unroll
    for (int j = 0; j < 8; ++j) { const int n = (lane >> 3) + 8 * j; const LAS float* s = scr + (8 * c) * 65 + n;
        v4u o; o.x = pk2(s[0], s[65]); o.y = pk2(s[2 * 65], s[3 * 65]); o.z = pk2(s[4 * 65], s[5 * 65]); o.w = pk2(s[6 * 65], s[7 * 65]);
        *(v4u*)(WT + (size_t)(drow0 + n) * K + k0 + 8 * c) = o; }
    LDS_WAIT();
}
template <int KIND> __device__ __forceinline__ void tr_matrix(const float* W, bf16* WT, int K, int N, int w, int NW, LAS float* scr, int lane) {
    const int nblk = N >> 6, items = (K >> 6) * nblk;
    for (int r = w; r < items; r += NW) { const int kb = r / nblk, n0 = (r - kb * nblk) * 64;
        const int dr = KIND == 0 ? n0 : (256 * (n0 >> 7) + (n0 & 127) + (KIND == 2 ? 128 : 0));
        transpose_item64(W, N, K, WT, kb * 64, n0, dr, scr, lane); }
}
__device__ __forceinline__ void ada_item(const Args& A, int nb, LAS float* red, float* MOD, int tid, int wave, int lane) {
    const float* cpv = A.in[2]; const float* csv = A.in[3]; const float* W = A.in[8]; const float* bias = A.in[9];
    const int n0 = nb * 64, kq = lane >> 4, l15 = lane & 15;
    f32x4 acc[3][4];
#pragma unroll
    for (int bt = 0; bt < 3; ++bt)
#pragma unroll
        for (int nt = 0; nt < 4; ++nt) acc[bt][nt] = (f32x4){0.f, 0.f, 0.f, 0.f};
    for (int ks = 0; ks < 8; ++ks) {
        const int k0 = wave * 256 + ks * 32 + 8 * kq;
        bf16x8 af[3];
#pragma unroll
        for (int bt = 0; bt < 3; ++bt) { const int b = 16 * bt + l15; float v[8];
            if (b < NBROW) { const float* cp = (b < 2 ? cpv + (size_t)b * DM : csv + (size_t)(b - 2) * DM) + k0; const f32x4 x0 = *(const f32x4*)cp, x1 = *(const f32x4*)(cp + 4);
                v[0] = x0.x * fsig(x0.x); v[1] = x0.y * fsig(x0.y); v[2] = x0.z * fsig(x0.z); v[3] = x0.w * fsig(x0.w); v[4] = x1.x * fsig(x1.x); v[5] = x1.y * fsig(x1.y); v[6] = x1.z * fsig(x1.z); v[7] = x1.w * fsig(x1.w); }
            else {
#pragma unroll
                for (int e = 0; e < 8; ++e) v[e] = 0.f; }
            af[bt] = pack8(v); }
#pragma unroll
        for (int nt = 0; nt < 4; ++nt) { const float* wp = W + (size_t)k0 * MODW + n0 + 16 * nt + l15; float v[8];
#pragma unroll
            for (int e = 0; e < 8; ++e) v[e] = wp[(size_t)e * MODW];
            const bf16x8 bfr = pack8(v);
#pragma unroll
            for (int bt = 0; bt < 3; ++bt) acc[bt][nt] = MFMA16(af[bt], bfr, acc[bt][nt]); }
    }
#pragma unroll
    for (int bt = 0; bt < 3; ++bt)
#pragma unroll
        for (int nt = 0; nt < 4; ++nt)
#pragma unroll
            for (int r = 0; r < 4; ++r) red[(wave * 48 + bt * 16 + nt * 4 + r) * 64 + lane] = acc[bt][nt][r];
    __syncthreads();
    for (int v = tid; v < 48 * 64; v += NTHREADS) { const int ln = v & 63, q = v >> 6, bt = q >> 4, nt = (q >> 2) & 3, r = q & 3; float s = 0.f;
#pragma unroll
        for (int w = 0; w < 8; ++w) s += red[(w * 48 + q) * 64 + ln];
        const int b = 16 * bt + 4 * (ln >> 4) + r, n = n0 + 16 * nt + (ln & 15);
        if (b < NBROW) MOD[(size_t)b * MODW + n] = s + bias[n]; }
    __syncthreads();
}
__device__ __forceinline__ void p0_prologue(const Args& A, LAS unsigned char* lds, int tid, int wave, int lane) {
    unsigned char* ws = A.ws;
    const int G = gridDim.x, bx = blockIdx.x;
    { float* rope = (float*)(ws + WS_ROPE);
      for (int i = bx * NTHREADS + tid; i < 4097 * 32; i += G * NTHREADS) { const int p = i >> 5, f = i & 31; const float pos = p < 4096 ? (float)p : 16384.f;
          const float inv = exp2f(-(float)f * (13.287712379549449f / 32.f)); const float ang = pos * inv; rope[p * 64 + f] = cosf(ang); rope[p * 64 + 32 + f] = sinf(ang); } }
    for (int nb = bx; nb < MODW / 64; nb += G) ada_item(A, nb, (LAS float*)lds, (float*)(ws + WS_MOD), tid, wave, lane);
    tr_matrix<1>(A.in[13], (bf16*)(ws + WS_W13A), DM, DFF, bx * NWAVES + wave, G * NWAVES, (LAS float*)(lds + wave * 16640), lane);
    tr_matrix<2>(A.in[14], (bf16*)(ws + WS_W13A), DM, DFF, bx * NWAVES + wave, G * NWAVES, (LAS float*)(lds + wave * 16640), lane);
}
__device__ __forceinline__ void norm_phase(const float* xp, const float* xs, const float* g, const float* MOD, int chunk_shift, bf16* XN, int wave, int lane) {
    const int gw = blockIdx.x * NWAVES + wave, NGW = gridDim.x * NWAVES;
    for (int row = gw; row < MROWS; row += NGW) {
        v2u* o8 = (v2u*)(XN + (size_t)row * DM) + lane;
        const float* xr = row < MPROMPT ? xp + (size_t)row * DM : xs + (size_t)(row - MPROMPT) * DM;
        const int br = row < MPROMPT ? (row >> 12) : (2 + row - MPROMPT);
        const float* sh = MOD + (size_t)br * MODW + chunk_shift * DM; const float* sc = sh + DM;
        f32x4 v[8]; float ss = 0.f;
#pragma unroll
        for (int j = 0; j < 8; ++j) { v[j] = *((const f32x4*)xr + lane + 64 * j); ss += (v[j].x * v[j].x + v[j].y * v[j].y) + (v[j].z * v[j].z + v[j].w * v[j].w); }
        const float rstd = rsqrtf(wave_sum(ss) * (1.f / DM) + EPSN);
#pragma unroll
        for (int j = 0; j < 8; ++j) { const int c = (lane + 64 * j) * 4; const f32x4 gg = *(const f32x4*)(g + c), s1 = *(const f32x4*)(sc + c), s0 = *(const f32x4*)(sh + c);
            const f32x4 y = (v[j] * rstd) * gg * (s1 + 1.f) + s0; o8[64 * j] = (v2u){pk2(y.x, y.y), pk2(y.z, y.w)}; }
    }
}
template <int NT> __device__ __forceinline__ void sgemm_acc(const bf16* A, int lda, const bf16* Bt, int K, const int (&nrow)[NT], f32x16 (&acc)[NT], int wave, int lane) {
    const int hh = lane >> 5, l31 = lane & 31, kw = K >> 3;
    const bf16* ap = A + (size_t)l31 * lda + wave * kw + 8 * hh;
    const bf16* bp[NT];
#pragma unroll
    for (int t = 0; t < NT; ++t) { bp[t] = Bt + (size_t)(nrow[t] + l31) * K + wave * kw + 8 * hh;
#pragma unroll
        for (int r = 0; r < 16; ++r) acc[t][r] = 0.f; }
    for (int k = 0; k < kw; k += 64) {
        bf16x8 a[4], b[NT][4];
#pragma unroll
        for (int i = 0; i < 4; ++i) { a[i] = *(const bf16x8*)(ap + k + 16 * i);
#pragma unroll
            for (int t = 0; t < NT; ++t) b[t][i] = *(const bf16x8*)(bp[t] + k + 16 * i); }
#pragma unroll
        for (int i = 0; i < 4; ++i)
#pragma unroll
            for (int t = 0; t < NT; ++t) acc[t] = MFMA32(a[i], b[t][i], acc[t]);
    }
}
template <int NT> __device__ __forceinline__ void sgemm_reduce(const f32x16 (&acc)[NT], LAS float* red, float (&out)[NT][2], int wave, int lane) {
#pragma unroll
    for (int t = 0; t < NT; ++t)
#pragma unroll
        for (int r = 0; r < 16; ++r) red[((wave * NT + t) * 16 + r) * 64 + lane] = acc[t][r];
    __syncthreads();
#pragma unroll
    for (int t = 0; t < NT; ++t)
#pragma unroll
        for (int i = 0; i < 2; ++i) { float s = 0.f;
#pragma unroll
            for (int w = 0; w < 8; ++w) s += red[((w * NT + t) * 16 + wave + 8 * i) * 64 + lane];
            out[t][i] = s; }
    __syncthreads();
}
#define SG_M(i) (8 * ((wave + 8 * (i)) >> 2) + 4 * (lane >> 5) + ((wave + 8 * (i)) & 3))
__device__ __forceinline__ void sg_ffn_up(const bf16* XN, const bf16* W13, bf16* HB, int item, LAS float* red, int wave, int lane) {
    const int c0 = 32 * item, pn = c0 >> 7, cc = c0 & 127; const int nrow[2] = {256 * pn + cc, 256 * pn + 128 + cc};
    f32x16 acc[2]; float o[2][2];
    sgemm_acc<2>(XN + (size_t)MPROMPT * DM, DM, W13, DM, nrow, acc, wave, lane); sgemm_reduce<2>(acc, red, o, wave, lane);
#pragma unroll
    for (int i = 0; i < 2; ++i) { const int m = SG_M(i); HB[(size_t)(MPROMPT + m) * DFF + c0 + (lane & 31)] = (bf16)(pk2(o[0][i] * fsig(o[0][i]) * o[1][i], 0.f) & 0xffffu); }
}
__device__ __forceinline__ void sg_res(const bf16* Arow, int K, const bf16* Bt, const float* base, float* out, const float* gate, float gs, int item, LAS float* red, int wave, int lane) {
    const int nrow[1] = {32 * item}; f32x16 acc[1]; float o[1][2];
    sgemm_acc<1>(Arow, K, Bt, K, nrow, acc, wave, lane); sgemm_reduce<1>(acc, red, o, wave, lane);
#pragma unroll
    for (int i = 0; i < 2; ++i) { const int m = SG_M(i), c = 32 * item + (lane & 31); out[(size_t)m * DM + c] = base[(size_t)m * DM + c] + gs * gate[(size_t)(2 + m) * MODW + c] * o[0][i]; }
}
__device__ __forceinline__ void sg_z(const bf16* XN, const bf16* Win, bf16* ZB, int item, LAS float* red, int wave, int lane) {
    const int nrow[1] = {32 * item}; f32x16 acc[1]; float o[1][2];
    sgemm_acc<1>(XN + (size_t)MPROMPT * DM, DM, Win, DM, nrow, acc, wave, lane); sgemm_reduce<1>(acc, red, o, wave, lane);
#pragma unroll
    for (int i = 0; i < 2; ++i) { const int m = SG_M(i); ZB[(size_t)(MPROMPT + m) * DIN + 32 * item + (lane & 31)] = (bf16)(pk2(o[0][i], 0.f) & 0xffffu); }
}
__device__ __forceinline__ void sg_mix(const bf16* OATT, const bf16* ORNN, const bf16* Wpa, const bf16* Wpr, const bf16* ZB, bf16* MIX, int item, LAS float* red, int wave, int lane) {
    const int nrow[1] = {32 * item}; f32x16 acc[1]; float oa[1][2], orr[1][2];
    sgemm_acc<1>(OATT + (size_t)MPROMPT * DATT, DATT, Wpa, DATT, nrow, acc, wave, lane); sgemm_reduce<1>(acc, red, oa, wave, lane);
    sgemm_acc<1>(ORNN + (size_t)MPROMPT * DRNN, DRNN, Wpr, DRNN, nrow, acc, wave, lane); sgemm_reduce<1>(acc, red, orr, wave, lane);
#pragma unroll
    for (int i = 0; i < 2; ++i) { const int m = SG_M(i), c = 32 * item + (lane & 31); const bf16* zr = ZB + (size_t)(MPROMPT + m) * DIN;
        MIX[(size_t)(MPROMPT + m) * DM + c] = (bf16)(pk2(fsig(bf1(zr[ZGA + c])) * oa[0][i] + fsig(bf1(zr[ZGR + c])) * orr[0][i], 0.f) & 0xffffu); }
}
template <int XORD> __device__ __forceinline__ void norm_rope_row(const bf16* rowp, int hh, const float* g, const float* rp, float scale, float (&o)[4][8]) {
    float v[4][8]; float ss = 0.f;
#pragma unroll
    for (int ks = 0; ks < 4; ++ks) { const v4u w = *(const v4u*)(rowp + 8 * hh + 16 * ks);
        v[ks][0] = bflo(w.x); v[ks][1] = bfhi(w.x); v[ks][2] = bflo(w.y); v[ks][3] = bfhi(w.y); v[ks][4] = bflo(w.z); v[ks][5] = bfhi(w.z); v[ks][6] = bflo(w.w); v[ks][7] = bfhi(w.w);
#pragma unroll
        for (int e = 0; e < 8; ++e) ss += v[ks][e] * v[ks][e]; }
    ss += __shfl_xor(ss, XORD);
    const float rstd = rsqrtf(ss * (1.f / 64.f) + EPSN);
#pragma unroll
    for (int ks = 0; ks < 2; ++ks) { const int d0 = 8 * hh + 16 * ks;
        const f32x4 g0 = *(const f32x4*)(g + d0), g1 = *(const f32x4*)(g + d0 + 4), h0 = *(const f32x4*)(g + d0 + 32), h1 = *(const f32x4*)(g + d0 + 36);
        const f32x4 c0 = *(const f32x4*)(rp + d0), c1 = *(const f32x4*)(rp + d0 + 4), s0 = *(const f32x4*)(rp + 32 + d0), s1 = *(const f32x4*)(rp + 36 + d0);
#pragma unroll
        for (int e = 0; e < 8; ++e) { const float ga = e < 4 ? g0[e & 3] : g1[e & 3], gb = e < 4 ? h0[e & 3] : h1[e & 3], cc = e < 4 ? c0[e & 3] : c1[e & 3], sn = e < 4 ? s0[e & 3] : s1[e & 3];
            const float x1 = v[ks][e] * rstd * ga, x2 = v[ks + 2][e] * rstd * gb;
            o[ks][e] = (x1 * cc - x2 * sn) * scale; o[ks + 2][e] = (x2 * cc + x1 * sn) * scale; } }
}
constexpr int KS_STRIDE = 144, VT_STRIDE = 520, KS_BYTES = 256 * KS_STRIDE, VT_BYTES = 64 * VT_STRIDE;
__device__ __forceinline__ void attn_item(const Args& A, LAS unsigned char* lds, int b, int blk, int kvh, int tid, int wave, int lane) {
    unsigned char* ws = A.ws; const bf16* Z = (const bf16*)(ws + WS_HZ); const float* rope = (const float*)(ws + WS_ROPE); bf16* OATT = (bf16*)(ws + WS_OATT);
    LAS unsigned char* Ks = lds; LAS unsigned char* Vt = lds + KS_BYTES;
    {
        const int key = tid >> 1, hh = tid & 1, t = blk * 128 - 128 + key;
        if (t >= 0) {
            const bf16* zr = Z + (size_t)(b * SEQ + t) * DIN;
            float o[4][8]; norm_rope_row<1>(zr + ZK + kvh * 64, hh, A.in[21], rope + (size_t)t * 64, 1.f, o);
#pragma unroll
            for (int ks = 0; ks < 4; ++ks) *(LAS bf16x8*)(Ks + key * KS_STRIDE + (8 * hh + 16 * ks) * 2) = pack8(o[ks]);
            v4u vv[4];
#pragma unroll
            for (int i = 0; i < 4; ++i) vv[i] = *(const v4u*)(zr + ZV + kvh * 64 + 32 * hh + 8 * i);
#pragma unroll
            for (int i = 0; i < 4; ++i) { const unsigned wv[4] = {vv[i].x, vv[i].y, vv[i].z, vv[i].w};
#pragma unroll
                for (int e = 0; e < 4; ++e) { const int d = 32 * hh + 8 * i + 2 * e;
                    *(LAS bf16*)(Vt + d * VT_STRIDE + key * 2) = (bf16)(wv[e] & 0xffffu); *(LAS bf16*)(Vt + (d + 1) * VT_STRIDE + key * 2) = (bf16)(wv[e] >> 16); } }
            if (blk == SEQ / 128 - 1 && key >= 128) {
                float* kp = A.out + O_KP + ((size_t)(b * 128 + key - 128) * 4 + kvh) * 64; float* vp = A.out + O_VP + ((size_t)(b * 128 + key - 128) * 4 + kvh) * 64;
#pragma unroll
                for (int ks = 0; ks < 4; ++ks) { *(f32x4*)(kp + 8 * hh + 16 * ks) = (f32x4){o[ks][0], o[ks][1], o[ks][2], o[ks][3]}; *(f32x4*)(kp + 8 * hh + 16 * ks + 4) = (f32x4){o[ks][4], o[ks][5], o[ks][6], o[ks][7]}; }
#pragma unroll
                for (int i = 0; i < 4; ++i) { *(f32x4*)(vp + 32 * hh + 8 * i) = (f32x4){bflo(vv[i].x), bfhi(vv[i].x), bflo(vv[i].y), bfhi(vv[i].y)}; *(f32x4*)(vp + 32 * hh + 8 * i + 4) = (f32x4){bflo(vv[i].z), bfhi(vv[i].z), bflo(vv[i].w), bfhi(vv[i].w)}; }
            }
        } else {
#pragma unroll
            for (int ks = 0; ks < 4; ++ks) *(LAS v4u*)(Ks + key * KS_STRIDE + (8 * hh + 16 * ks) * 2) = (v4u){0u, 0u, 0u, 0u};
#pragma unroll
            for (int d = 0; d < 32; ++d) *(LAS bf16*)(Vt + (32 * hh + d) * VT_STRIDE + key * 2) = (bf16)0;
        }
    }
    __syncthreads();
    const int g = wave >> 1, head = kvh * 4 + g, hh = lane >> 5, l31 = lane & 31;
    const float sink = A.in[22][head];
#pragma unroll 1
    for (int qt = 0; qt < 2; ++qt) {
        const int i0 = (wave & 1) * 64 + 32 * qt, qi = i0 + l31, t = blk * 128 + qi; const size_t row = (size_t)b * SEQ + t;
        bf16x8 qf[4];
        { float o[4][8]; norm_rope_row<32>(Z + row * DIN + ZQ + head * 64, hh, A.in[20], rope + (size_t)t * 64, 0.125f, o);
#pragma unroll
          for (int ks = 0; ks < 4; ++ks) qf[ks] = pack8(o[ks]); }
        const int kt0 = i0 >> 5;
        f32x16 s[5];
#pragma unroll
        for (int kk = 0; kk < 5; ++kk) {
#pragma unroll
            for (int r = 0; r < 16; ++r) s[kk][r] = 0.f;
#pragma unroll
            for (int ks = 0; ks < 4; ++ks) { const bf16x8 kf = *(const LAS bf16x8*)(Ks + (32 * (kt0 + kk) + l31) * KS_STRIDE + (8 * hh + 16 * ks) * 2); s[kk] = MFMA32(kf, qf[ks], s[kk]); } }
        float mx = sink;
#pragma unroll
        for (int kk = 0; kk < 5; ++kk)
#pragma unroll
            for (int r = 0; r < 16; ++r) { const int j = 32 * (kt0 + kk) + 8 * (r >> 2) + 4 * hh + (r & 3); const bool ok = (j > qi) && (j <= qi + 128) && (blk > 0 || j >= 128);
                s[kk][r] = ok ? s[kk][r] : -INFINITY; mx = fmaxf(mx, s[kk][r]); }
        mx = fmaxf(mx, __shfl_xor(mx, 32));
        float l = 0.f;
#pragma unroll
        for (int kk = 0; kk < 5; ++kk)
#pragma unroll
            for (int r = 0; r < 16; ++r) { const float p = fexp(s[kk][r] - mx); s[kk][r] = p; l += p; }
        l += __shfl_xor(l, 32);
        const float inv = 1.f / (l + fexp(sink - mx));
        f32x16 oacc[2];
#pragma unroll
        for (int dt = 0; dt < 2; ++dt)
#pragma unroll
            for (int r = 0; r < 16; ++r) oacc[dt][r] = 0.f;
#pragma unroll
        for (int kk = 0; kk < 5; ++kk)
#pragma unroll
            for (int s2 = 0; s2 < 2; ++s2) { float pv[8];
#pragma unroll
                for (int e = 0; e < 8; ++e) pv[e] = s[kk][8 * s2 + e];
                const bf16x8 pf = pack8(pv);
#pragma unroll
                for (int dt = 0; dt < 2; ++dt) { const LAS unsigned char* vp = Vt + (32 * dt + l31) * VT_STRIDE + (32 * (kt0 + kk) + 16 * s2 + 4 * hh) * 2;
                    const v2u lo = *(const LAS v2u*)vp, hi = *(const LAS v2u*)(vp + 16); const v4u a4 = (v4u){lo.x, lo.y, hi.x, hi.y};
                    oacc[dt] = MFMA32(__builtin_bit_cast(bf16x8, a4), pf, oacc[dt]); } }
        bf16* op = OATT + row * DATT + head * 64;
#pragma unroll
        for (int dt = 0; dt < 2; ++dt)
#pragma unroll
            for (int g4 = 0; g4 < 4; ++g4) *(v2u*)(op + 32 * dt + 8 * g4 + 4 * hh) = (v2u){pk2(oacc[dt][4 * g4] * inv, oacc[dt][4 * g4 + 1] * inv), pk2(oacc[dt][4 * g4 + 2] * inv, oacc[dt][4 * g4 + 3] * inv)};
    }
    __syncthreads();
}
__device__ __forceinline__ void attn_sample_item(const Args& A, LAS float* wl  , int bs, int head, int lane) {
    unsigned char* ws = A.ws; const bf16* Z = (const bf16*)(ws + WS_HZ); const float* rp = (const float*)(ws + WS_ROPE) + (size_t)4096 * 64; bf16* OATT = (bf16*)(ws + WS_OATT);
    const int kvh = head >> 2, d = lane, f = d & 31; const size_t row = MPROMPT + bs;
    const bf16* zr = Z + row * DIN;
    const float cs = rp[f], sn = rp[32 + f];
    float q = bf1(zr[ZQ + head * 64 + d]); { const float rstd = rsqrtf(wave_sum(q * q) * (1.f / 64.f) + EPSN); q = q * rstd * A.in[20][d]; const float qo = __shfl_xor(q, 32); q = (d < 32 ? q * cs - qo * sn : q * cs + qo * sn) * 0.125f; }
    float kn = bf1(zr[ZK + kvh * 64 + d]); { const float rstd = rsqrtf(wave_sum(kn * kn) * (1.f / 64.f) + EPSN); kn = kn * rstd * A.in[21][d]; const float ko = __shfl_xor(kn, 32); kn = d < 32 ? kn * cs - ko * sn : kn * cs + ko * sn; }
    const float vn = bf1(zr[ZV + kvh * 64 + d]);
    if ((head & 3) == 0) { A.out[O_KS + ((size_t)bs * 4 + kvh) * 64 + d] = kn; A.out[O_VS + ((size_t)bs * 4 + kvh) * 64 + d] = vn; }
    const float snew = wave_sum(q * kn);
    wl[d] = q; LDS_WAIT();
    const float* ck = A.in[4] + (size_t)bs * 128 * 256 + kvh * 64; const float* cv = A.in[5] + (size_t)bs * 128 * 256 + kvh * 64;
    float s0 = 0.f, s1 = 0.f;
    { const float* k0 = ck + (size_t)lane * 256; const float* k1 = ck + (size_t)(lane + 64) * 256;
#pragma unroll
      for (int i = 0; i < 16; ++i) { const f32x4 qv = *(const LAS f32x4*)(wl + 4 * i), a = *(const f32x4*)(k0 + 4 * i), c = *(const f32x4*)(k1 + 4 * i);
          s0 += (qv.x * a.x + qv.y * a.y) + (qv.z * a.z + qv.w * a.w); s1 += (qv.x * c.x + qv.y * c.y) + (qv.z * c.z + qv.w * c.w); } }
    if (lane == 0) s0 = snew;
    const float sink = A.in[22][head];
    const float mx = fmaxf(wave_max(fmaxf(s0, s1)), sink);
    const float p0 = fexp(s0 - mx), p1 = fexp(s1 - mx);
    const float inv = 1.f / (wave_sum(p0 + p1) + fexp(sink - mx));
    wl[64 + lane] = p0; wl[128 + lane] = p1; LDS_WAIT();
    float o = wl[64] * vn;
#pragma unroll 8
    for (int j = 1; j < 128; ++j) o += wl[64 + j] * cv[(size_t)j * 256 + d];
    OATT[row * DATT + head * 64 + d] = (bf16)(pk2(o * inv, 0.f) & 0xffffu);
    LDS_WAIT();
}
template <bool FINAL> __device__ __forceinline__ void rnn_item(const Args& A, LAS float* xcs  , int b, int c, int hb, int lane) {
    unsigned char* ws = A.ws; const bf16* Z = (const bf16*)(ws + WS_HZ); bf16* ORNN = (bf16*)(ws + WS_ORNN); float* CA = (float*)(ws + WS_CA); float* CH = (float*)(ws + WS_CH);
    const int hh = lane >> 5, l31 = lane & 31, t00 = c * TCHUNK, ch0 = hb * 64;
    const float* cw = A.in[23] + ch0; const float* cbp = A.in[24] + ch0;
#pragma unroll 1
    for (int tt = 0; tt < 2; ++tt) {
        const int t = t00 + 32 * tt + l31; const bf16* zr = Z + ((size_t)b * SEQ + t) * DIN + ZRX + ch0 + 8 * hh;
#pragma unroll 2
        for (int ks = 0; ks < 4; ++ks) {
            const v4u z0 = {0u, 0u, 0u, 0u};
            const v4u x0 = *(const v4u*)(zr + 16 * ks), x1 = t >= 1 ? *(const v4u*)(zr + 16 * ks - DIN) : z0, x2 = t >= 2 ? *(const v4u*)(zr + 16 * ks - 2 * DIN) : z0, x3 = t >= 3 ? *(const v4u*)(zr + 16 * ks - 3 * DIN) : z0;
            const int cg = 8 * hh + 16 * ks; float xc[8];
#pragma unroll
            for (int q = 0; q < 2; ++q) { const f32x4 w0 = *(const f32x4*)(cw + cg + 4 * q), w1 = *(const f32x4*)(cw + DRNN + cg + 4 * q), w2 = *(const f32x4*)(cw + 2 * DRNN + cg + 4 * q), w3 = *(const f32x4*)(cw + 3 * DRNN + cg + 4 * q), bb = *(const f32x4*)(cbp + cg + 4 * q);
                const unsigned a0 = q == 0 ? x0.x : x0.z, a1 = q == 0 ? x0.y : x0.w, b0 = q == 0 ? x1.x : x1.z, b1 = q == 0 ? x1.y : x1.w, c0 = q == 0 ? x2.x : x2.z, c1 = q == 0 ? x2.y : x2.w, d0 = q == 0 ? x3.x : x3.z, d1 = q == 0 ? x3.y : x3.w;
                xc[4 * q + 0] = bb.x + w3.x * bflo(a0) + w2.x * bflo(b0) + w1.x * bflo(c0) + w0.x * bflo(d0);
                xc[4 * q + 1] = bb.y + w3.y * bfhi(a0) + w2.y * bfhi(b0) + w1.y * bfhi(c0) + w0.y * bfhi(d0);
                xc[4 * q + 2] = bb.z + w3.z * bflo(a1) + w2.z * bflo(b1) + w1.z * bflo(c1) + w0.z * bflo(d1);
                xc[4 * q + 3] = bb.w + w3.w * bfhi(a1) + w2.w * bfhi(b1) + w1.w * bfhi(c1) + w0.w * bfhi(d1); }
#pragma unroll
            for (int e = 0; e < 8; ++e) xcs[(32 * tt + l31) * 65 + cg + e] = xc[e];
            if (FINAL && c == NCHUNK - 1 && tt == 1 && l31 >= 29) { float* cp = A.out + O_CP + ((size_t)b * 3 + (l31 - 29)) * DRNN + ch0 + cg;
                *(f32x4*)cp = (f32x4){bflo(x0.x), bfhi(x0.x), bflo(x0.y), bfhi(x0.y)}; *(f32x4*)(cp + 4) = (f32x4){bflo(x0.z), bfhi(x0.z), bflo(x0.w), bfhi(x0.w)}; }
        }
    }
    LDS_WAIT();
#pragma unroll 1
    for (int nt = 0; nt < 2; ++nt) {
        const int j = ch0 + 32 * nt + l31;
        bf16x8 wf[2][4];
#pragma unroll
        for (int gt = 0; gt < 2; ++gt) { const float* wg = A.in[gt == 0 ? 25 : 27] + (size_t)hb * 4096 + 32 * nt + l31;
#pragma unroll
            for (int ks = 0; ks < 4; ++ks) { float v[8];
#pragma unroll
                for (int e = 0; e < 8; ++e) v[e] = wg[(8 * hh + 16 * ks + e) * 64];
                wf[gt][ks] = pack8(v); } }
        const float brg = A.in[26][j], big = A.in[28][j], sp = log1pf(expf(-A.in[29][j]));
        float H = 0.f, Ap = 1.f;
        if (FINAL) { const float* pa = CA + (size_t)b * NCHUNK * DRNN + j; const float* ph = CH + (size_t)b * NCHUNK * DRNN + j;
            for (int c0 = 0; c0 < c; c0 += 8) { float ca[8], cv[8];
#pragma unroll
                for (int u = 0; u < 8; ++u) { ca[u] = pa[(size_t)(c0 + u) * DRNN]; cv[u] = ph[(size_t)(c0 + u) * DRNN]; }
#pragma unroll
                for (int u = 0; u < 8; ++u) H = (c0 + u < c) ? ca[u] * H + cv[u] : H; } }
#pragma unroll 1
        for (int tt = 0; tt < 2; ++tt) {
            const int t0 = t00 + 32 * tt;
            f32x16 ar, ai;
#pragma unroll
            for (int r = 0; r < 16; ++r) { ar[r] = 0.f; ai[r] = 0.f; }
#pragma unroll
            for (int ks = 0; ks < 4; ++ks) { float v[8];
#pragma unroll
                for (int e = 0; e < 8; ++e) v[e] = xcs[(32 * tt + l31) * 65 + 8 * hh + 16 * ks + e];
                const bf16x8 af = pack8(v); ar = MFMA32(af, wf[0][ks], ar); ai = MFMA32(af, wf[1][ks], ai); }
            float rgv[16];
            if (FINAL) {
#pragma unroll
                for (int r = 0; r < 16; ++r) { const int tk = 8 * (r >> 2) + 4 * hh + (r & 3); rgv[r] = bf1(Z[((size_t)b * SEQ + t0 + tk) * DIN + ZRG + j]); } }
#pragma unroll
            for (int r = 0; r < 16; ++r) { const int tk = 8 * (r >> 2) + 4 * hh + (r & 3);
                const float rg_ = fsig(ar[r] + brg), ig_ = fsig(ai[r] + big); const float la = -8.f * rg_ * sp; const float a = fexp(la);
                const float mult = __builtin_amdgcn_sqrtf(fmaxf(1.f - a * a, 0.f)); ar[r] = a; ai[r] = mult * ig_ * xcs[(32 * tt + tk) * 65 + 32 * nt + l31]; }
            float Hs[4];
#pragma unroll
            for (int g4 = 0; g4 < 4; ++g4) { float Aa = 1.f, U = 0.f;
#pragma unroll
                for (int r4 = 0; r4 < 4; ++r4) { const float a = ar[4 * g4 + r4]; U = a * U + ai[4 * g4 + r4]; Aa *= a; }
                const float pA = __shfl_xor(Aa, 32), pU = __shfl_xor(U, 32);
                const float A0 = hh == 0 ? Aa : pA, U0 = hh == 0 ? U : pU, A1 = hh == 0 ? pA : Aa, U1 = hh == 0 ? pU : U;
                const float Hs0 = H; H = A0 * H + U0; const float Hs1 = H; H = A1 * H + U1; Hs[g4] = hh == 0 ? Hs0 : Hs1; Ap *= A0 * A1; }
            if (FINAL) {
#pragma unroll
                for (int g4 = 0; g4 < 4; ++g4) { float h = Hs[g4];
#pragma unroll
                    for (int r4 = 0; r4 < 4; ++r4) { const int r = 4 * g4 + r4, tk = 8 * g4 + 4 * hh + r4; h = ar[r] * h + ai[r];
                        ORNN[((size_t)b * SEQ + t0 + tk) * DRNN + j] = (bf16)(pk2(h * gelu_tanh(rgv[r]), 0.f) & 0xffffu); } } }
        }
        if (!FINAL) { if (hh == 0) { const size_t o = ((size_t)b * NCHUNK + c) * DRNN + j; CA[o] = Ap; CH[o] = H; } }
        else if (c == NCHUNK - 1 && hh == 0) A.out[O_HP + (size_t)b * DRNN + j] = H;
    }
    LDS_WAIT();
}
__device__ __forceinline__ void rnn_sample_item(const Args& A, int bs, int hb, int lane) {
    unsigned char* ws = A.ws; const bf16* Z = (const bf16*)(ws + WS_HZ); bf16* ORNN = (bf16*)(ws + WS_ORNN);
    const int ch = hb * 64 + lane; const size_t row = MPROMPT + bs;
    const float* sc = A.in[7] + (size_t)bs * 3 * DRNN + ch; const float b0 = sc[0], b1 = sc[DRNN], b2 = sc[2 * DRNN];
    const float rx = bf1(Z[row * DIN + ZRX + ch]), rg = bf1(Z[row * DIN + ZRG + ch]);
    const float xc = A.in[24][ch] + A.in[23][ch] * b0 + A.in[23][DRNN + ch] * b1 + A.in[23][2 * DRNN + ch] * b2 + A.in[23][3 * DRNN + ch] * rx;
    const float* wr = A.in[25] + (size_t)hb * 4096 + lane; const float* wi = A.in[27] + (size_t)hb * 4096 + lane;
    float ar = A.in[26][ch], ai = A.in[28][ch];
#pragma unroll 16
    for (int i = 0; i < 64; ++i) { const float xi = __shfl(xc, i); ar += xi * wr[i * 64]; ai += xi * wi[i * 64]; }
    const float rg_ = fsig(ar), ig_ = fsig(ai), la = -8.f * rg_ * log1pf(expf(-A.in[29][ch])), a = expf(la), mult = sqrtf(fmaxf(-expm1f(2.f * la), 0.f));
    const float h = a * A.in[6][(size_t)bs * DRNN + ch] + mult * ig_ * xc;
    A.out[O_HS + (size_t)bs * DRNN + ch] = h;
    ORNN[row * DRNN + ch] = (bf16)(pk2(h * gelu_tanh(rg), 0.f) & 0xffffu);
    float* co = A.out + O_CS + (size_t)bs * 3 * DRNN + ch; co[0] = b1; co[DRNN] = b2; co[2 * DRNN] = rx;
}

#define XB_TMO      128
#define XB_XCNT(j)  (256  + 64 * (j))
#define XB_XSUB(j)  (1280 + 64 * (j))
#define XB_XGEN(j)  (2304 + 64 * (j))
#define XB_TOP      3328
#define XB_TOPGEN   3392
#define XCD_BAR_WORDS 3456
#define XB_SPIN_CAP (1u << 18)

__device__ __forceinline__ unsigned xb_ld(unsigned* p)              { return __hip_atomic_load(p, __ATOMIC_RELAXED, __HIP_MEMORY_SCOPE_AGENT); }
__device__ __forceinline__ unsigned xb_add(unsigned* p, unsigned v) { return __hip_atomic_fetch_add(p, v, __ATOMIC_RELAXED, __HIP_MEMORY_SCOPE_AGENT); }
__device__ __forceinline__ unsigned xb_xcc_id() { return (unsigned)__builtin_amdgcn_s_getreg((3 << 11) | 20) & 0xFu; }
#define XB_SPIN(cond, bar) do { unsigned _sp = 0; while (cond) { __builtin_amdgcn_s_sleep(1); \
    if ((++_sp & 255u) == 0u) { if (xb_ld(&(bar)[XB_TMO])) break; if (_sp > XB_SPIN_CAP) { atomicAdd(&(bar)[XB_TMO], 1u); break; } } } } while (0)

struct XcdBarrier {
    unsigned* bar; unsigned x;
    volatile LAS unsigned* st;
};

__device__ __forceinline__ XcdBarrier xcd_barrier_post(unsigned* bar, volatile LAS unsigned* st) {
    XcdBarrier b; b.bar = bar; b.x = xb_xcc_id(); b.st = st;
    if (threadIdx.x == 0) (void)xb_add(&bar[XB_XCNT(b.x)], 1u);
    return b;
}
__device__ __forceinline__ void xcd_barrier_complete(unsigned* bar, unsigned x, unsigned& nloc, unsigned& nx) {
    const unsigned G = gridDim.x * gridDim.y * gridDim.z;
    unsigned sum, cnt, mine, sp = 0u;
    for (;;) {
        sum = 0u; cnt = 0u; mine = 0u;
#pragma unroll
        for (unsigned j = 0; j < 16; ++j) { const unsigned c = xb_ld(&bar[XB_XCNT(j)]); sum += c; cnt += (c > 0u) ? 1u : 0u; mine = (j == x) ? c : mine; }
        if (sum == G) break;
        __builtin_amdgcn_s_sleep(1);
        if ((++sp & 255u) == 0u) { if (xb_ld(&bar[XB_TMO])) break; if (sp > XB_SPIN_CAP) { atomicAdd(&bar[XB_TMO], 1u); break; } }
    }
    nloc = mine > 0u ? mine : 1u; nx = cnt > 0u ? cnt : 1u;
}

__device__ __forceinline__ void xcd_barrier(const XcdBarrier& b) {
    asm volatile("s_waitcnt vmcnt(0)" ::: "memory");
    __syncthreads();
    if (threadIdx.x == 0) {
        unsigned* bar = b.bar;
        __builtin_amdgcn_s_waitcnt(0);
        unsigned nloc = b.st[0], nx = b.st[1];
        if (nloc == 0u) { xcd_barrier_complete(bar, b.x, nloc, nx); b.st[0] = nloc; b.st[1] = nx; }
        const unsigned old = xb_add(&bar[XB_XSUB(b.x)], 1u);
        const unsigned gen = old / nloc;
        if (old + 1u == (gen + 1u) * nloc) {
            __builtin_amdgcn_fence(__ATOMIC_RELEASE, "agent");
            asm volatile("s_waitcnt vmcnt(0)" ::: "memory");
            const unsigned og = xb_add(&bar[XB_TOP], 1u);
            const unsigned tg = og / nx;
            if (og + 1u == (tg + 1u) * nx) xb_add(&bar[XB_TOPGEN], 1u);
            else XB_SPIN(xb_ld(&bar[XB_TOPGEN]) == tg, bar);
            __builtin_amdgcn_fence(__ATOMIC_ACQUIRE, "agent");
            xb_add(&bar[XB_XGEN(b.x)], 1u);
            asm volatile("s_waitcnt vmcnt(0)" ::: "memory");
        } else {
            XB_SPIN(xb_ld(&bar[XB_XGEN(b.x)]) == gen, bar);
            __builtin_amdgcn_fence(__ATOMIC_ACQUIRE, "agent");
            asm volatile("s_waitcnt vmcnt(0)" ::: "memory");
        }
    }
    __syncthreads();
}

__global__ void __launch_bounds__(NTHREADS, 2) mk_fwd(Args args) {
    extern __shared__ __attribute__((aligned(16))) unsigned char lds_raw[];
    LAS unsigned char* lds = (LAS unsigned char*)lds_raw;
    const int tid = threadIdx.x, lane = tid & 63, wave = __builtin_amdgcn_readfirstlane(tid >> 6);
    const int G = gridDim.x, bx = blockIdx.x;
    unsigned char* ws = args.ws;
    const int lo = args.ph_lo, hi = args.ph_hi;
    if (tid < 16) ((LAS unsigned*)(lds + MISC_OFF))[tid] = 0u;
    __syncthreads();
    if (hi > 1000) cg::this_grid().sync();
    XcdBarrier bar; bar.bar = (unsigned*)(ws + WS_BAR); bar.x = 0; bar.st = nullptr;
    if (hi - lo > 1) bar = xcd_barrier_post((unsigned*)(ws + WS_BAR), (volatile LAS unsigned*)(lds + MISC_OFF));
    bf16* XN = (bf16*)(ws + WS_XN); bf16* HB = (bf16*)(ws + WS_HZ); bf16* ZB = (bf16*)(ws + WS_HZ); float* XB = (float*)(ws + WS_X); float* MOD = (float*)(ws + WS_MOD);
    bf16* OATT = (bf16*)(ws + WS_OATT); bf16* ORNN = (bf16*)(ws + WS_ORNN); bf16* MIX = (bf16*)(ws + WS_MIX);
#ifndef PH_MASK
#define PH_MASK 0x1fff
#endif
#define IN(k) (((PH_MASK >> (k)) & 1) && lo <= (k) && (k) < hi)
#ifndef REP_MASK
#define REP_MASK 0
#endif
#define REPS(k) for (int rep_ = 0; rep_ < 1 + ((REP_MASK >> (k)) & 1); ++rep_)
#define SEAM(k) do { if (IN(k) && IN((k) + 1)) { xcd_barrier(bar); } } while (0)

    if (IN(0)) REPS(0) { p0_prologue(args, lds, tid, wave, lane); } SEAM(0);
    if (IN(1)) REPS(1) { norm_phase(args.in[0], args.in[1], args.in[10], MOD, 0, XN, wave, lane); } SEAM(1);
    LAS float* red = (LAS float*)lds;
    const float* MODS = MOD;
    if (IN(2)) { for (int it = bx - 128; it >= 0 && it < DFF / 32; it += 128) sg_ffn_up(XN, (const bf16*)(ws + WS_W13A), HB, it, red, wave, lane);
        if (bx >= 128) { const int w = (bx - 128) * NWAVES + wave; LAS float* scr = (LAS float*)(lds + wave * 16640);
            tr_matrix<0>(args.in[15], (bf16*)(ws + WS_W2A), DFF, DM, w, 128 * NWAVES, scr, lane); tr_matrix<0>(args.in[19], (bf16*)(ws + WS_WIN), DM, DIN, w, 128 * NWAVES, scr, lane); __syncthreads(); }
        pg8::Gemm g{XN, (const bf16*)(ws + WS_W13A), MPROMPT, 2 * DFF, DM}; pg8::StaticOrder S; S.init(MPROMPT, 2 * DFF, G, bx); pg8::EpiSwiGLU E{HB, DFF};
        pg8::gemm_phase<pg8::EpiSwiGLU, pg8::StaticOrder, true, true>(lds, g, S, E); } SEAM(2);
    if (IN(3)) { for (int it = bx; it < DM / 32; it += G) sg_res(HB + (size_t)MPROMPT * DFF, DFF, (const bf16*)(ws + WS_W2A), args.in[1], XB + (size_t)MPROMPT * DM, MODS + 2 * DM, 0.5f, it, red, wave, lane);
        pg8::Gemm g{HB, (const bf16*)(ws + WS_W2A), MPROMPT, DM, DFF}; pg8::StaticOrder S; S.init(MPROMPT, DM, G, bx); pg8::EpiRes E{args.in[0], args.in[1], XB, MOD + 2 * DM, 0.5f};
        pg8::gemm_phase<pg8::EpiRes, pg8::StaticOrder, true, true>(lds, g, S, E); } SEAM(3);
    if (IN(4)) { norm_phase(XB, XB + (size_t)MPROMPT * DM, args.in[11], MOD, 3, XN, wave, lane); } SEAM(4);
    if (IN(5)) { for (int it = bx - 192; it >= 0 && it < DIN / 32; it += 64) sg_z(XN, (const bf16*)(ws + WS_WIN), ZB, it, red, wave, lane);
        if (bx >= 192) { const int w = (bx - 192) * NWAVES + wave; LAS float* scr = (LAS float*)(lds + wave * 16640);
            tr_matrix<0>(args.in[30], (bf16*)(ws + WS_WPA), DATT, DM, w, 64 * NWAVES, scr, lane); tr_matrix<0>(args.in[31], (bf16*)(ws + WS_WPR), DRNN, DM, w, 64 * NWAVES, scr, lane);
            tr_matrix<0>(args.in[32], (bf16*)(ws + WS_WOUT), DM, DM, w, 64 * NWAVES, scr, lane); __syncthreads(); }
        pg8::Gemm g{XN, (const bf16*)(ws + WS_WIN), MPROMPT, DIN, DM}; pg8::StaticOrder S; S.init(MPROMPT, DIN, G, bx); pg8::EpiBf16<0> E{ZB, DIN, nullptr, 0, 0, 1.f};
        pg8::gemm_phase<pg8::EpiBf16<0>, pg8::StaticOrder, true, true>(lds, g, S, E); } SEAM(5);
    if (IN(6)) REPS(6) {
#ifndef NO_ATTN
        for (int it = bx; it < 256; it += G) attn_item(args, lds, it >> 7, (it >> 2) & 31, it & 3, tid, wave, lane);
#endif
#ifndef NO_RNN
        for (int it = bx; it < 4 * NCHUNK; it += G) rnn_item<false>(args, (LAS float*)(lds + wave * 16640), it >> 7, (it >> 1) & 63, (it & 1) * 8 + wave, lane);
#endif
        __syncthreads();
#ifndef NO_SATTN
        for (int it = (G - 1 - bx) * NWAVES + wave; it < NSAMP * 16; it += G * NWAVES) attn_sample_item(args, (LAS float*)(lds + wave * 768), it >> 4, it & 15, lane);
#endif
        __syncthreads();
        { const int w = bx * NWAVES + wave; LAS float* scr = (LAS float*)(lds + wave * 16640);
          tr_matrix<1>(args.in[16], (bf16*)(ws + WS_W13B), DM, DFF, w, G * NWAVES, scr, lane); tr_matrix<2>(args.in[17], (bf16*)(ws + WS_W13B), DM, DFF, w, G * NWAVES, scr, lane);
          tr_matrix<0>(args.in[18], (bf16*)(ws + WS_W2B), DFF, DM, w, G * NWAVES, scr, lane); }
    } SEAM(6);
    if (IN(7)) {
        REPS(7) for (int it = bx; it < 4 * NCHUNK; it += G) rnn_item<true>(args, (LAS float*)(lds + wave * 16640), it >> 7, (it >> 1) & 63, (it & 1) * 8 + wave, lane);
        for (int it = (G - 1 - bx) * NWAVES + wave; it < NSAMP * 16; it += G * NWAVES) rnn_sample_item(args, it >> 4, it & 15, lane);
        __syncthreads();
        pg8::Gemm g{OATT, (const bf16*)(ws + WS_WPA), MPROMPT, DM, DATT}; pg8::StaticOrder S; S.init(MPROMPT, DM, G, bx); pg8::EpiGateMix<false> E{MIX, ZB + ZGA};
        pg8::gemm_phase<pg8::EpiGateMix<false>, pg8::StaticOrder, true, true>(lds, g, S, E); } SEAM(7);
    if (IN(8)) { for (int it = bx; it < DM / 32; it += G) sg_mix(OATT, ORNN, (const bf16*)(ws + WS_WPA), (const bf16*)(ws + WS_WPR), ZB, MIX, it, red, wave, lane);
        pg8::Gemm g{ORNN, (const bf16*)(ws + WS_WPR), MPROMPT, DM, DRNN}; pg8::StaticOrder S; S.init(MPROMPT, DM, G, bx); pg8::EpiGateMix<true> E{MIX, ZB + ZGR};
        pg8::gemm_phase<pg8::EpiGateMix<true>, pg8::StaticOrder, true, true>(lds, g, S, E); } SEAM(8);
    if (IN(9)) { for (int it = bx; it < DM / 32; it += G) sg_res(MIX + (size_t)MPROMPT * DM, DM, (const bf16*)(ws + WS_WOUT), XB + (size_t)MPROMPT * DM, XB + (size_t)MPROMPT * DM, MODS + 5 * DM, 1.f, it, red, wave, lane);
        pg8::Gemm g{MIX, (const bf16*)(ws + WS_WOUT), MPROMPT, DM, DM}; pg8::StaticOrder S; S.init(MPROMPT, DM, G, bx); pg8::EpiRes E{XB, XB + (size_t)MPROMPT * DM, XB, MOD + 5 * DM, 1.f};
        pg8::gemm_phase<pg8::EpiRes, pg8::StaticOrder, true, true>(lds, g, S, E); } SEAM(9);
    if (IN(10)) { norm_phase(XB, XB + (size_t)MPROMPT * DM, args.in[12], MOD, 6, XN, wave, lane); } SEAM(10);
    if (IN(11)) { for (int it = bx - 128; it >= 0 && it < DFF / 32; it += 128) sg_ffn_up(XN, (const bf16*)(ws + WS_W13B), HB, it, red, wave, lane);
        pg8::Gemm g{XN, (const bf16*)(ws + WS_W13B), MPROMPT, 2 * DFF, DM}; pg8::StaticOrder S; S.init(MPROMPT, 2 * DFF, G, bx); pg8::EpiSwiGLU E{HB, DFF};
        pg8::gemm_phase<pg8::EpiSwiGLU, pg8::StaticOrder, true, true>(lds, g, S, E); } SEAM(11);
    if (IN(12)) { for (int it = bx; it < DM / 32; it += G) sg_res(HB + (size_t)MPROMPT * DFF, DFF, (const bf16*)(ws + WS_W2B), XB + (size_t)MPROMPT * DM, args.out + O_Y + (size_t)MPROMPT * DM, MODS + 8 * DM, 0.5f, it, red, wave, lane);
        pg8::Gemm g{HB, (const bf16*)(ws + WS_W2B), MPROMPT, DM, DFF}; pg8::StaticOrder S; S.init(MPROMPT, DM, G, bx); pg8::EpiRes E{XB, XB + (size_t)MPROMPT * DM, args.out + O_Y, MOD + 8 * DM, 0.5f};
        pg8::gemm_phase<pg8::EpiRes, pg8::StaticOrder, true, true>(lds, g, S, E); }
#undef IN
#undef SEAM
}

extern "C" void kernel_launch(void* const* d_in, const int* in_sizes, int n_in, void* d_out, int out_size, void* d_ws, size_t ws_size, hipStream_t stream) {
    static int grid = 0;
    if (grid == 0) {
        if (n_in != 33 || out_size != (int)O_END || ws_size < WS_END) { fprintf(stderr, "kernel_launch: unexpected shapes: n_in %d out %d ws %zu\n", n_in, out_size, ws_size); grid = -1; return; }
        int dev = 0, cus = 0, per_cu = 0;
        hipGetDevice(&dev); hipDeviceGetAttribute(&cus, hipDeviceAttributeMultiprocessorCount, dev);
        hipFuncSetAttribute((const void*)mk_fwd, hipFuncAttributeMaxDynamicSharedMemorySize, LDS_BYTES);
        hipOccupancyMaxActiveBlocksPerMultiprocessor(&per_cu, (const void*)mk_fwd, NTHREADS, LDS_BYTES);
        if (per_cu < 1) { fprintf(stderr, "kernel_launch: occupancy query says %d blocks per CU\n", per_cu); grid = -1; return; }
        grid = cus;
    }
    if (grid < 0) return;
    Args a{};
    for (int i = 0; i < 33; ++i) a.in[i] = (const float*)d_in[i];
    a.out = (float*)d_out; a.ws = (unsigned char*)d_ws;
#if MK_ONE_LAUNCH
    if (hipMemsetAsync((char*)d_ws + WS_BAR, 0, 65536, stream) != hipSuccess) { fprintf(stderr, "memset failed\n"); return; }
    a.ph_lo = 0; a.ph_hi = 13;
    void* kargs[] = {&a};
    hipError_t e = hipLaunchCooperativeKernel((const void*)mk_fwd, dim3(grid), dim3(NTHREADS), kargs, LDS_BYTES, stream);
    if (e != hipSuccess) fprintf(stderr, "cooperative launch failed: %s (grid %d)\n", hipGetErrorString(e), grid);
#else
    for (int p = 0; p < 13; ++p) { a.ph_lo = p; a.ph_hi = p + 1; hipLaunchKernelGGL(mk_fwd, dim3(grid), dim3(NTHREADS), LDS_BYTES, stream, a); }
#endif
}
```

```cpp
#include <hip/hip_runtime.h>
#include <hip/hip_cooperative_groups.h>
#include <cstdio>
#include <cstdint>
#include <cmath>
namespace pg8 {
#define PG8_LAS __attribute__((address_space(3)))
typedef unsigned short bf16_t;
typedef short bf16x8 __attribute__((ext_vector_type(8)));
typedef float f32x4 __attribute__((ext_vector_type(4)));
typedef unsigned u32x4 __attribute__((ext_vector_type(4)));
constexpr int BM = 256, BK = 64, HALF = 128, HTB = HALF * BK * 2  , STAGE_BYTES = 8 * HTB, NXCD = 8, WGM = 8;

__host__ __device__ __forceinline__ int lds_byte(int r, int c) { const int st = (r >> 4) * 2 + (c >> 5), rr = r & 15, cc = c & 31, ob = rr * 64 + cc * 2; return st * 1024 + (ob ^ (((ob >> 9) & 1) << 5)); }
__host__ __device__ __forceinline__ void stage_rc(int b, int& R, int& C) { const int st = b / 1024, sb = b % 1024, swz = sb ^ (((sb >> 9) & 1) << 5); R = (st >> 1) * 16 + swz / 64; C = (st & 1) * 32 + (swz % 64) / 2; }
__host__ __device__ __forceinline__ int perm32(int rho) { const int n = rho >> 4, i = rho & 15; return 8 * (i >> 2) + 4 * n + (i & 3); }

struct Unit { int pm, pn; };
struct Gemm { const bf16_t* A; const bf16_t* Bt; int M, N, K; };

struct StaticOrder {
    int nM, nN, nwg, G, c;
    __host__ __device__ void init(int M, int N, int G_, int c_) { nM = M / BM; nN = N / BM; nwg = nM * nN; G = G_; c = c_; }
    __host__ __device__ bool next(int i, Unit& u) const {
        const long L = (long)i * G + c; if (L >= nwg) return false;
        int wgid = (int)L; { const int q = nwg / NXCD, r = nwg % NXCD, xcd = wgid % NXCD, off = wgid / NXCD; wgid = (xcd < r ? xcd * (q + 1) : r * (q + 1) + (xcd - r) * q) + off; }
        const int nig = WGM * nN, gid = wgid / nig, fm = gid * WGM, gsz = (nM - fm) < WGM ? (nM - fm) : WGM;
        u.pm = fm + ((wgid % nig) % gsz); u.pn = (wgid % nig) / gsz; return true;
    }
    __device__ __forceinline__ void a_ready(const Unit&) const {}
    __device__ __forceinline__ void done(const Unit&) const {}
};

__device__ __forceinline__ unsigned cvt_pk_bf16(float lo, float hi) { unsigned r; asm volatile("v_cvt_pk_bf16_f32 %0, %1, %2" : "=v"(r) : "v"(lo), "v"(hi)); return r; }
typedef float f32x2 __attribute__((ext_vector_type(2)));
__device__ __forceinline__ f32x2 gelu_pk(f32x2 v) {
    const f32x2 av = __builtin_elementwise_abs(v), d = av * 0.2316418882f + 1.0f;
    f32x2 t; t.x = __builtin_amdgcn_rcpf(d.x); t.y = __builtin_amdgcn_rcpf(d.y);
    f32x2 q = t * 0.5307027145f + (-0.7265760135f); q = q * t + 0.7107068705f; q = q * t + (-0.142248368f); q = q * t + 0.127414796f; q = q * t;
    const f32x2 s = (v * v) * (-0.72134752044f);
    f32x2 e; e.x = __builtin_amdgcn_exp2f(s.x); e.y = __builtin_amdgcn_exp2f(s.y);
    const f32x2 m = v * (q * e), r = v - m;
    f32x2 o; o.x = v.x < 0.f ? m.x : r.x; o.y = v.y < 0.f ? m.y : r.y; return o;
}

template <int ACT  > struct EpiBf16 {
    static constexpr bool PERM = true, AFTER_DRAIN = false; static_assert(ACT == 0 || ACT == 1, "EpiBf16: ACT is 0 (none) or 1 (gelu_pk)");
    bf16_t* O; int ldc; const float* bias; int split_cols; size_t split_stride; float scale0;
    __device__ __forceinline__ void operator()(const f32x4 (&acc)[2][2][4][2], const Unit& u, int wr, int wc, int fr, int fq) const {
        const int row0 = u.pm * BM + wr * 64 + fr; int colt = u.pn * BM; bf16_t* base = O;
        float sc = 1.f; if (split_cols) { const int t = colt / split_cols; base += (size_t)t * split_stride; colt -= t * split_cols; if (t == 0) sc = scale0; }
        const int col0 = colt + wc * 32 + 8 * fq, bcol0 = u.pn * BM + wc * 32 + 8 * fq;
        f32x4 bv[2][2];
#pragma unroll
        for (int bj = 0; bj < 2; ++bj)
#pragma unroll
            for (int n = 0; n < 2; ++n) bv[bj][n] = bias ? *(const f32x4*)(bias + bcol0 + bj * HALF + 4 * n) : (f32x4){0.f, 0.f, 0.f, 0.f};
#pragma unroll
        for (int ai = 0; ai < 2; ++ai)
#pragma unroll
            for (int m = 0; m < 4; ++m) { bf16_t* rowp = base + (size_t)(row0 + ai * HALF + m * 16) * ldc + col0;
#pragma unroll
                for (int bj = 0; bj < 2; ++bj) { f32x4 v0 = acc[ai][bj][m][0] + bv[bj][0], v1 = acc[ai][bj][m][1] + bv[bj][1];
                    if (ACT == 1) { f32x2 a = gelu_pk((f32x2){v0[0], v0[1]}), b = gelu_pk((f32x2){v0[2], v0[3]}), c = gelu_pk((f32x2){v1[0], v1[1]}), d = gelu_pk((f32x2){v1[2], v1[3]});
                        v0 = (f32x4){a.x, a.y, b.x, b.y}; v1 = (f32x4){c.x, c.y, d.x, d.y}; }
                    v0 = v0 * sc; v1 = v1 * sc; u32x4 w; w.x = cvt_pk_bf16(v0[0], v0[1]); w.y = cvt_pk_bf16(v0[2], v0[3]); w.z = cvt_pk_bf16(v1[0], v1[1]); w.w = cvt_pk_bf16(v1[2], v1[3]);
                    *(u32x4*)(rowp + bj * HALF) = w; } }
    }
};
constexpr int MROWS_VALID = 8224, MROWS_PROMPT = 8192;
__device__ __forceinline__ float fsigmoid(float x) { return __builtin_amdgcn_rcpf(1.f + __builtin_amdgcn_exp2f(-1.44269504f * x)); }
__device__ __forceinline__ float fsilu(float x) { return x * fsigmoid(x); }
__device__ __forceinline__ float bflo(unsigned w) { return __uint_as_float(w << 16); }
__device__ __forceinline__ float bfhi(unsigned w) { return __uint_as_float(w & 0xffff0000u); }

struct EpiSwiGLU {
    static constexpr bool PERM = true, AFTER_DRAIN = false;
    bf16_t* O; int ldc;
    __device__ __forceinline__ void operator()(const f32x4 (&acc)[2][2][4][2], const Unit& u, int wr, int wc, int fr, int fq) const {
        const int row0 = u.pm * BM + wr * 64 + fr, col0 = u.pn * HALF + wc * 32 + 8 * fq;
#pragma unroll
        for (int ai = 0; ai < 2; ++ai)
#pragma unroll
            for (int m = 0; m < 4; ++m) {
                bf16_t* p = O + (size_t)(row0 + ai * HALF + m * 16) * ldc + col0;
                const f32x4 a0 = acc[ai][0][m][0], a1 = acc[ai][0][m][1], b0 = acc[ai][1][m][0], b1 = acc[ai][1][m][1];
                u32x4 w;
                w.x = cvt_pk_bf16(fsilu(a0[0]) * b0[0], fsilu(a0[1]) * b0[1]); w.y = cvt_pk_bf16(fsilu(a0[2]) * b0[2], fsilu(a0[3]) * b0[3]);
                w.z = cvt_pk_bf16(fsilu(a1[0]) * b1[0], fsilu(a1[1]) * b1[1]); w.w = cvt_pk_bf16(fsilu(a1[2]) * b1[2], fsilu(a1[3]) * b1[3]);
                *(u32x4*)p = w;
            }
    }
};
struct EpiRes {
    static constexpr bool PERM = false, AFTER_DRAIN = false;
    const float* base_p; const float* base_s; float* out; const float* gate; float gs;
    __device__ __forceinline__ void operator()(const f32x4 (&acc)[2][2][4][2], const Unit& u, int wr, int wc, int fr, int fq) const {
        const int col0 = u.pn * BM + wc * 32 + 4 * fq;
#pragma unroll
        for (int ai = 0; ai < 2; ++ai)
#pragma unroll
            for (int m = 0; m < 4; ++m) {
                const int row = u.pm * BM + ai * HALF + wr * 64 + m * 16 + fr;
                if (row < MROWS_VALID) {
                    const int br = row < MROWS_PROMPT ? (row >> 12) : (2 + row - MROWS_PROMPT);
                    const float* bp = row < MROWS_PROMPT ? base_p + (size_t)row * 2048 : base_s + (size_t)(row - MROWS_PROMPT) * 2048;
                    const float* gp = gate + (size_t)br * 18432; float* op = out + (size_t)row * 2048;
#pragma unroll
                    for (int bj = 0; bj < 2; ++bj)
#pragma unroll
                        for (int n = 0; n < 2; ++n) { const int c = col0 + bj * HALF + n * 16;
                            const f32x4 g = *(const f32x4*)(gp + c), b = *(const f32x4*)(bp + c);
                            *(f32x4*)(op + c) = b + (g * gs) * acc[ai][bj][m][n]; }
                }
            }
    }
};
template <bool ACCUM> struct EpiGateMix {
    static constexpr bool PERM = true, AFTER_DRAIN = false;
    bf16_t* O; const bf16_t* Zg;
    __device__ __forceinline__ void operator()(const f32x4 (&acc)[2][2][4][2], const Unit& u, int wr, int wc, int fr, int fq) const {
        const int row0 = u.pm * BM + wr * 64 + fr, col0 = u.pn * BM + wc * 32 + 8 * fq;
#pragma unroll
        for (int ai = 0; ai < 2; ++ai)
#pragma unroll
            for (int m = 0; m < 4; ++m) { const int row = row0 + ai * HALF + m * 16;
#pragma unroll
                for (int bj = 0; bj < 2; ++bj) { const int c = col0 + bj * HALF;
                    const u32x4 gz = *(const u32x4*)(Zg + (size_t)row * 7680 + c);
                    bf16_t* op = O + (size_t)row * 2048 + c;
                    const f32x4 v0 = acc[ai][bj][m][0], v1 = acc[ai][bj][m][1];
                    float r0 = fsigmoid(bflo(gz.x)) * v0[0], r1 = fsigmoid(bfhi(gz.x)) * v0[1], r2 = fsigmoid(bflo(gz.y)) * v0[2], r3 = fsigmoid(bfhi(gz.y)) * v0[3];
                    float r4 = fsigmoid(bflo(gz.z)) * v1[0], r5 = fsigmoid(bfhi(gz.z)) * v1[1], r6 = fsigmoid(bflo(gz.w)) * v1[2], r7 = fsigmoid(bfhi(gz.w)) * v1[3];
                    if (ACCUM) { const u32x4 pv = *(const u32x4*)op;
                        r0 += bflo(pv.x); r1 += bfhi(pv.x); r2 += bflo(pv.y); r3 += bfhi(pv.y); r4 += bflo(pv.z); r5 += bfhi(pv.z); r6 += bflo(pv.w); r7 += bfhi(pv.w); }
                    u32x4 w; w.x = cvt_pk_bf16(r0, r1); w.y = cvt_pk_bf16(r2, r3); w.z = cvt_pk_bf16(r4, r5); w.w = cvt_pk_bf16(r6, r7);
                    *(u32x4*)op = w; }
            }
    }
};
template <class Epi, class Sched, bool ALIGN_EPI = false, bool SP2 = false>
__device__ __forceinline__ void gemm_phase(PG8_LAS unsigned char* lds, const Gemm g, const Sched& S, const Epi& E) {
    const int tid = threadIdx.x, wid = __builtin_amdgcn_readfirstlane(tid >> 6), lane = tid & 63, wr = wid >> 2, wc = wid & 3, fr = lane & 15, fq = lane >> 4;
    const int K = g.K, nt = K / BK;
    unsigned voffA[2], voffB[2];
#pragma unroll
    for (int i = 0; i < 2; ++i) { int R, C; stage_rc(tid * 16 + i * 8192, R, C); const int Rb = Epi::PERM ? ((R & ~31) + perm32(R & 31)) : R;
        voffA[i] = (unsigned)(R * K + C) * 2u; voffB[i] = (unsigned)(Rb * K + C) * 2u; }
    const size_t kstep = (size_t)(BK * 2);
    const size_t hstep = (size_t)HALF * K * 2;
    const size_t tstep = 2 * hstep;
    const unsigned ldsw = (unsigned)wid * 1024u;
    const int aoff = lds_byte(wr * 64 + fr, fq * 8), boff = lds_byte(wc * 32 + fr, fq * 8);
#define PG8_SA(b, h) (((b) * 2 + (h)) * HTB)
#define PG8_SB(b, h) ((4 + (b) * 2 + (h)) * HTB)
#define PG8_STAGE(bufoff, gbase, voff) do { _Pragma("unroll") for (int _i = 0; _i < 2; ++_i) \
        __builtin_amdgcn_global_load_lds((const unsigned*)((const char*)(gbase) + (voff)[_i]), (PG8_LAS unsigned*)(lds + (bufoff) + ldsw + _i * 8192), 16, 0, 0); } while (0)
#define PG8_LDA(dst, b, h) do { _Pragma("unroll") for (int m = 0; m < 4; ++m) _Pragma("unroll") for (int k = 0; k < 2; ++k) dst[m][k] = *(const PG8_LAS bf16x8*)(lds + PG8_SA(b, h) + aoff + m * 2048 + k * 1024); } while (0)
#define PG8_LDB(dst, b, h) do { _Pragma("unroll") for (int n = 0; n < 2; ++n) _Pragma("unroll") for (int k = 0; k < 2; ++k) dst[n][k] = *(const PG8_LAS bf16x8*)(lds + PG8_SB(b, h) + boff + n * 2048 + k * 1024); } while (0)
#define PG8_MMA(ai, bj, At, Bt) do { __builtin_amdgcn_s_setprio(1); _Pragma("unroll") for (int m = 0; m < 4; ++m) _Pragma("unroll") for (int n = 0; n < 2; ++n) _Pragma("unroll") for (int k = 0; k < 2; ++k) \
        acc[ai][bj][m][n] = __builtin_amdgcn_mfma_f32_16x16x32_bf16(Bt[n][k], At[m][k], acc[ai][bj][m][n], 0, 0, 0); __builtin_amdgcn_s_setprio(0); } while (0)
#define PG8_WAIT_V(n) asm volatile("s_waitcnt vmcnt(" #n ")" ::: "memory")
#define PG8_WAIT_L(n) asm volatile("s_waitcnt lgkmcnt(" #n ")" ::: "memory")
#define PG8_BAR __builtin_amdgcn_s_barrier()
#define PG8_SCHED __builtin_amdgcn_sched_barrier(0)
    Unit cur, nxt; int ui = 0;
    if (!S.next(0, cur)) return;
    f32x4 acc[2][2][4][2];
#pragma unroll
    for (int a = 0; a < 2; ++a)
#pragma unroll
        for (int b = 0; b < 2; ++b)
#pragma unroll
            for (int m = 0; m < 4; ++m)
#pragma unroll
                for (int n = 0; n < 2; ++n) acc[a][b][m][n] = (f32x4){0.f, 0.f, 0.f, 0.f};
    bf16x8 At[4][2], B0[2][2], B1[2][2];
    const char* cA = (const char*)g.A + (size_t)cur.pm * tstep; const char* cB = (const char*)g.Bt + (size_t)cur.pn * tstep;
    S.a_ready(cur);
    if constexpr (SP2) {
        PG8_STAGE(PG8_SB(0, 0), cB, voffB); PG8_STAGE(PG8_SB(0, 1), cB + hstep, voffB); PG8_STAGE(PG8_SA(0, 0), cA, voffA); PG8_STAGE(PG8_SA(0, 1), cA + hstep, voffA);
        if (wr == 1) PG8_BAR;
        PG8_WAIT_V(2); PG8_BAR;
        PG8_STAGE(PG8_SB(1, 0), cB + kstep, voffB); PG8_STAGE(PG8_SA(1, 0), cA + kstep, voffA); PG8_STAGE(PG8_SB(1, 1), cB + hstep + kstep, voffB);
        PG8_WAIT_V(6); PG8_BAR;
    } else {
        PG8_STAGE(PG8_SB(0, 0), cB, voffB); PG8_STAGE(PG8_SA(0, 0), cA, voffA); PG8_STAGE(PG8_SB(0, 1), cB + hstep, voffB); PG8_STAGE(PG8_SA(0, 1), cA + hstep, voffA);
        if (wr == 1) PG8_BAR;
        PG8_WAIT_V(4); PG8_BAR;
        PG8_STAGE(PG8_SB(1, 0), cB + kstep, voffB); PG8_STAGE(PG8_SA(1, 0), cA + kstep, voffA); PG8_STAGE(PG8_SB(1, 1), cB + hstep + kstep, voffB);
        PG8_WAIT_V(6); PG8_BAR;
    }
    for (;;) {
        const bool has_next = S.next(ui + 1, nxt);
        const char* nA = has_next ? (const char*)g.A + (size_t)nxt.pm * tstep : cA; const char* nB = has_next ? (const char*)g.Bt + (size_t)nxt.pn * tstep : cB;
        for (int t = 0; t < nt; t += 2) {
            const bool last = (t == nt - 2);
            const char* a1 = cA + (size_t)(t + 1) * kstep;
            const char* a2 = last ? nA : cA + (size_t)(t + 2) * kstep; const char* b2 = last ? nB : cB + (size_t)(t + 2) * kstep;
            const char* a3 = a2 + kstep; const char* b3 = b2 + kstep;
            if (last && has_next) S.a_ready(nxt);
            if constexpr (SP2) {
            PG8_LDB(B0, 0, 0); PG8_LDB(B1, 0, 1); PG8_SCHED; PG8_LDA(At, 0, 0); PG8_STAGE(PG8_SA(1, 1), a1 + hstep, voffA);
            PG8_WAIT_V(8); PG8_WAIT_L(0); PG8_BAR; PG8_MMA(0, 0, At, B0); PG8_MMA(0, 1, At, B1); PG8_BAR; PG8_SCHED;
            PG8_LDA(At, 0, 1); PG8_STAGE(PG8_SB(0, 0), b2, voffB); PG8_STAGE(PG8_SB(0, 1), b2 + hstep, voffB); PG8_STAGE(PG8_SA(0, 0), a2, voffA);
            PG8_WAIT_V(8); PG8_WAIT_L(0); PG8_BAR; PG8_MMA(1, 0, At, B0); PG8_MMA(1, 1, At, B1); PG8_BAR; PG8_SCHED;
            PG8_LDB(B0, 1, 0); PG8_LDB(B1, 1, 1); PG8_SCHED; PG8_LDA(At, 1, 0); PG8_STAGE(PG8_SA(0, 1), a2 + hstep, voffA);
            PG8_WAIT_V(8); PG8_WAIT_L(0); PG8_BAR; PG8_MMA(0, 0, At, B0); PG8_MMA(0, 1, At, B1); PG8_BAR; PG8_SCHED;
            PG8_LDA(At, 1, 1); PG8_STAGE(PG8_SB(1, 0), b3, voffB); PG8_STAGE(PG8_SB(1, 1), b3 + hstep, voffB); PG8_STAGE(PG8_SA(1, 0), a3, voffA);
            PG8_WAIT_V(8); PG8_WAIT_L(0); PG8_BAR; PG8_MMA(1, 0, At, B0); PG8_MMA(1, 1, At, B1); PG8_BAR; PG8_SCHED;
            } else {
            PG8_LDB(B0, 0, 0); PG8_SCHED; PG8_LDA(At, 0, 0); PG8_STAGE(PG8_SA(1, 1), a1 + hstep, voffA);
            PG8_WAIT_L(8); PG8_BAR; PG8_WAIT_L(0); PG8_MMA(0, 0, At, B0); PG8_BAR; PG8_SCHED;
            PG8_LDB(B1, 0, 1); PG8_STAGE(PG8_SB(0, 0), b2, voffB);
            PG8_BAR; PG8_WAIT_L(0); PG8_MMA(0, 1, At, B1); PG8_BAR;
            PG8_LDA(At, 0, 1); PG8_STAGE(PG8_SA(0, 0), a2, voffA);
            PG8_BAR; PG8_WAIT_L(0); PG8_MMA(1, 0, At, B0); PG8_BAR; PG8_SCHED;
            PG8_STAGE(PG8_SB(0, 1), b2 + hstep, voffB);
            PG8_WAIT_V(6); PG8_BAR; PG8_MMA(1, 1, At, B1); PG8_BAR;
            PG8_LDB(B0, 1, 0); PG8_SCHED; PG8_LDA(At, 1, 0); PG8_STAGE(PG8_SA(0, 1), a2 + hstep, voffA);
            PG8_WAIT_L(8); PG8_BAR; PG8_WAIT_L(0); PG8_MMA(0, 0, At, B0); PG8_BAR; PG8_SCHED;
            PG8_LDB(B1, 1, 1); PG8_STAGE(PG8_SB(1, 0), b3, voffB);
            PG8_BAR; PG8_WAIT_L(0); PG8_MMA(0, 1, At, B1); PG8_BAR;
            PG8_LDA(At, 1, 1); PG8_STAGE(PG8_SA(1, 0), a3, voffA);
            PG8_BAR; PG8_WAIT_L(0); PG8_MMA(1, 0, At, B0); PG8_BAR; PG8_SCHED;
            PG8_STAGE(PG8_SB(1, 1), b3 + hstep, voffB);
            PG8_WAIT_V(6); PG8_BAR; PG8_MMA(1, 1, At, B1); PG8_BAR;
            }
        }
        if constexpr (ALIGN_EPI) { if (wr == 0) PG8_BAR; }
        if constexpr (!Epi::AFTER_DRAIN) { E(acc, cur, wr, wc, fr, fq); S.done(cur); }
        if (!has_next) break;
#pragma unroll
        for (int a = 0; a < 2; ++a)
#pragma unroll
            for (int b = 0; b < 2; ++b)
#pragma unroll
                for (int m = 0; m < 4; ++m)
#pragma unroll
                    for (int n = 0; n < 2; ++n) acc[a][b][m][n] = (f32x4){0.f, 0.f, 0.f, 0.f};
        cur = nxt; cA = nA; cB = nB; ++ui;
        if constexpr (ALIGN_EPI) { if (wr == 1) PG8_BAR; }
    }
    PG8_WAIT_V(0);
    if constexpr (!ALIGN_EPI) { if (wr == 0) PG8_BAR; }
    PG8_BAR;
    if constexpr (Epi::AFTER_DRAIN) { E.fused(acc, cur, wr, wc, fr, fq, lds, wid, lane); S.done(cur); }
#undef PG8_SA
#undef PG8_SB
#undef PG8_STAGE
#undef PG8_LDA
#undef PG8_LDB
#undef PG8_MMA
#undef PG8_WAIT_V
#undef PG8_WAIT_L
#undef PG8_BAR
#undef PG8_SCHED
}
}
namespace cg = cooperative_groups;
#ifndef MK_ONE_LAUNCH
#define MK_ONE_LAUNCH 1
#endif
constexpr int NWAVES = 8, NTHREADS = 512;
constexpr int DM = 2048, SEQ = 4096, MPROMPT = 8192, NSAMP = 32, MROWS = 8224, MPAD = 8448;
constexpr int DFF = 5632, DIN = 7680, DATT = 1024, DRNN = 1024, MODW = 18432, NBROW = 34;
constexpr int ZQ = 0, ZK = 1024, ZV = 1280, ZRX = 1536, ZRG = 2560, ZGA = 3584, ZGR = 5632;
constexpr int NCHUNK = 64, TCHUNK = 64;
constexpr float EPSN = 1e-6f;
constexpr size_t O_Y = 0, O_KP = 16842752, O_VP = 16908288, O_KS = 16973824, O_VS = 16982016, O_HP = 16990208, O_HS = 16992256, O_CP = 17025024, O_CS = 17031168, O_END = 17129472;
constexpr size_t MiB = 1u << 20;
constexpr size_t WS_W13A = 0, WS_W2A = 44 * MiB, WS_W13B = 66 * MiB, WS_W2B = 110 * MiB, WS_WIN = 132 * MiB, WS_WPA = 162 * MiB, WS_WPR = 166 * MiB, WS_WOUT = 170 * MiB;
constexpr size_t WS_XN = 178 * MiB, WS_HZ = 211 * MiB, WS_X = 335 * MiB, WS_OATT = 401 * MiB, WS_ORNN = 418 * MiB, WS_MIX = 435 * MiB, WS_MOD = 468 * MiB, WS_ROPE = 471 * MiB;
constexpr size_t WS_CA = 473 * MiB, WS_CH = WS_CA + 512 * 1024, WS_BAR = 474 * MiB, WS_END = 475 * MiB;
constexpr int MISC_OFF = 147456 - 64;
constexpr int LDS_BYTES = 147456;

#define LAS __attribute__((address_space(3)))
typedef unsigned short bf16;
typedef unsigned v4u __attribute__((ext_vector_type(4)));
typedef unsigned v2u __attribute__((ext_vector_type(2)));
typedef float f32x4 __attribute__((ext_vector_type(4)));
typedef float f32x16 __attribute__((ext_vector_type(16)));
typedef short bf16x8 __attribute__((ext_vector_type(8)));
#define LDS_WAIT() asm volatile("s_waitcnt lgkmcnt(0)" ::: "memory")
#define MFMA32(a, b, c) __builtin_amdgcn_mfma_f32_32x32x16_bf16((a), (b), (c), 0, 0, 0)
#define MFMA16(a, b, c) __builtin_amdgcn_mfma_f32_16x16x32_bf16((a), (b), (c), 0, 0, 0)
__device__ __forceinline__ unsigned pk2(float lo, float hi) { return pg8::cvt_pk_bf16(lo, hi); }
__device__ __forceinline__ float bflo(unsigned w) { return __uint_as_float(w << 16); }
__device__ __forceinline__ float bfhi(unsigned w) { return __uint_as_float(w & 0xffff0000u); }
__device__ __forceinline__ float bf1(bf16 h) { return __uint_as_float((unsigned)h << 16); }
__device__ __forceinline__ float fsig(float x) { return __builtin_amdgcn_rcpf(1.f + __builtin_amdgcn_exp2f(-1.44269504f * x)); }
__device__ __forceinline__ float fexp(float x) { return __builtin_amdgcn_exp2f(1.44269504f * x); }
__device__ __forceinline__ float gelu_tanh(float x) { const float t = 0.7978845608f * (x + 0.044715f * x * x * x); return x * fsig(2.f * t); }
__device__ __forceinline__ bf16x8 pack8(const float (&v)[8]) { v4u p; p.x = pk2(v[0], v[1]); p.y = pk2(v[2], v[3]); p.z = pk2(v[4], v[5]); p.w = pk2(v[6], v[7]); return __builtin_bit_cast(bf16x8, p); }
__device__ __forceinline__ float wave_sum(float v) {
#pragma unroll
    for (int o = 1; o < 64; o <<= 1) v += __shfl_xor(v, o);
    return v;
}
__device__ __forceinline__ float wave_max(float v) {
#pragma unroll
    for (int o = 1; o < 64; o <<= 1) v = fmaxf(v, __shfl_xor(v, o));
    return v;
}

struct Args { const float* in[33]; float* out; unsigned char* ws; int ph_lo, ph_hi; };

__device__ __forceinline__ void transpose_item64(const float* __restrict__ W, int N, int K, bf16* __restrict__ WT, int k0, int n0, int drow0, LAS float* scr, int lane) {
    f32x4 v[16];
#pragma unroll
    for (int i = 0; i < 16; ++i) v[i] = *(const f32x4*)(W + (size_t)(k0 + (lane >> 4) + 4 * i) * N + n0 + (lane & 15) * 4);
#pragma unroll
    for (int i = 0; i < 16; ++i) { LAS float* s = scr + ((lane >> 4) + 4 * i) * 65 + (lane & 15) * 4; s[0] = v[i].x; s[1] = v[i].y; s[2] = v[i].z; s[3] = v[i].w; }
    LDS_WAIT();
    const int c = lane & 7;
#pragma unroll
    for (int j = 0; j < 8; ++j) { const int n = (lane >> 3) + 8 * j; const LAS float* s = scr + (8 * c) * 65 + n;
        v4u o; o.x = pk2(s[0], s[65]); o.y = pk2(s[2 * 65], s[3 * 65]); o.z = pk2(s[4 * 65], s[5 * 65]); o.w = pk2(s[6 * 65], s[7 * 65]);
        *(v4u*)(WT + (size_t)(drow0 + n) * K + k0 + 8 * c) = o; }
    LDS_WAIT();
}
template <int KIND> __device__ __forceinline__ void tr_matrix(const float* W, bf16* WT, int K, int N, int w, int NW, LAS float* scr, int lane) {
    const int nblk = N >> 6, items = (K >> 6) * nblk;
    for (int r = w; r < items; r += NW) { const int kb = r / nblk, n0 = (r - kb * nblk) * 64;
        const int dr = KIND == 0 ? n0 : (256 * (n0 >> 7) + (n0 & 127) + (KIND == 2 ? 128 : 0));
        transpose_item64(W, N, K, WT, kb * 64, n0, dr, scr, lane); }
}
__device__ __forceinline__ void ada_item(const Args& A, int nb, LAS float* red, float* MOD, int tid, int wave, int lane) {
    const float* cpv = A.in[2]; const float* csv = A.in[3]; const float* W = A.in[8]; const float* bias = A.in[9];
    const int n0 = nb * 64, kq = lane >> 4, l15 = lane & 15;
    f32x4 acc[3][4];
#pragma unroll
    for (int bt = 0; bt < 3; ++bt)
#pragma unroll
        for (int nt = 0; nt < 4; ++nt) acc[bt][nt] = (f32x4){0.f, 0.f, 0.f, 0.f};
    const float* wbase = W + (size_t)(wave * 256 + 8 * kq) * MODW + n0 + 4 * l15;
#pragma unroll 1
    for (int ks2 = 0; ks2 < 4; ++ks2) {
        f32x4 wv[2][8];
#pragma unroll
        for (int h = 0; h < 2; ++h)
#pragma unroll
            for (int e = 0; e < 8; ++e) wv[h][e] = *(const f32x4*)(wbase + (size_t)((2 * ks2 + h) * 32 + e) * MODW);
#pragma unroll
        for (int h = 0; h < 2; ++h) {
            const int k0 = wave * 256 + (2 * ks2 + h) * 32 + 8 * kq;
            bf16x8 af[3];
#pragma unroll
            for (int bt = 0; bt < 3; ++bt) { const int b = 16 * bt + l15; float v[8];
                if (b < NBROW) { const float* cp = (b < 2 ? cpv + (size_t)b * DM : csv + (size_t)(b - 2) * DM) + k0; const f32x4 x0 = *(const f32x4*)cp, x1 = *(const f32x4*)(cp + 4);
                    v[0] = x0.x * fsig(x0.x); v[1] = x0.y * fsig(x0.y); v[2] = x0.z * fsig(x0.z); v[3] = x0.w * fsig(x0.w); v[4] = x1.x * fsig(x1.x); v[5] = x1.y * fsig(x1.y); v[6] = x1.z * fsig(x1.z); v[7] = x1.w * fsig(x1.w); }
                else {
#pragma unroll
                    for (int e = 0; e < 8; ++e) v[e] = 0.f; }
                af[bt] = pack8(v); }
#pragma unroll
            for (int nt = 0; nt < 4; ++nt) { float v[8];
#pragma unroll
                for (int e = 0; e < 8; ++e) v[e] = wv[h][e][nt];
                const bf16x8 bfr = pack8(v);
#pragma unroll
                for (int bt = 0; bt < 3; ++bt) acc[bt][nt] = MFMA16(af[bt], bfr, acc[bt][nt]); }
        }
    }
#pragma unroll
    for (int bt = 0; bt < 3; ++bt)
#pragma unroll
        for (int nt = 0; nt < 4; ++nt)
#pragma unroll
            for (int r = 0; r < 4; ++r) red[(wave * 48 + bt * 16 + nt * 4 + r) * 64 + lane] = acc[bt][nt][r];
    __syncthreads();
    for (int v = tid; v < 48 * 64; v += NTHREADS) { const int ln = v & 63, q = v >> 6, bt = q >> 4, nt = (q >> 2) & 3, r = q & 3; float s = 0.f;
#pragma unroll
        for (int w = 0; w < 8; ++w) s += red[(w * 48 + q) * 64 + ln];
        const int b = 16 * bt + 4 * (ln >> 4) + r, n = n0 + 4 * (ln & 15) + nt;
        if (b < NBROW) MOD[(size_t)b * MODW + n] = s + bias[n]; }
    __syncthreads();
}
__device__ __forceinline__ void p0_prologue(const Args& A, LAS unsigned char* lds, int tid, int wave, int lane) {
    unsigned char* ws = A.ws;
    const int G = gridDim.x, bx = blockIdx.x;
    { float* rope = (float*)(ws + WS_ROPE);
      for (int i = bx * NTHREADS + tid; i < 4097 * 32; i += G * NTHREADS) { const int p = i >> 5, f = i & 31; const float pos = p < 4096 ? (float)p : 16384.f;
          const float inv = exp2f(-(float)f * (13.287712379549449f / 32.f)); const float ang = pos * inv; rope[p * 64 + f] = cosf(ang); rope[p * 64 + 32 + f] = sinf(ang); } }
    for (int nb = bx; nb < MODW / 64; nb += G) ada_item(A, nb, (LAS float*)lds, (float*)(ws + WS_MOD), tid, wave, lane);
    { const int skip = G == 256 ? 32 : 0; if (bx >= skip) { const int w = (bx - skip) * NWAVES + wave, NW = (G - skip) * NWAVES; LAS float* scr = (LAS float*)(lds + wave * 16640);
        tr_matrix<1>(A.in[13], (bf16*)(ws + WS_W13A), DM, DFF, w, NW, scr, lane); tr_matrix<2>(A.in[14], (bf16*)(ws + WS_W13A), DM, DFF, w, NW, scr, lane); } }
}
__device__ __forceinline__ void norm_phase(const float* xp, const float* xs, const float* g, const float* MOD, int chunk_shift, bf16* XN, int wave, int lane) {
    const int gw = blockIdx.x * NWAVES + wave, NGW = gridDim.x * NWAVES;
    for (int row = gw; row < MROWS; row += NGW) {
        v2u* o8 = (v2u*)(XN + (size_t)row * DM) + lane;
        const float* xr = row < MPROMPT ? xp + (size_t)row * DM : xs + (size_t)(row - MPROMPT) * DM;
        const int br = row < MPROMPT ? (row >> 12) : (2 + row - MPROMPT);
        const float* sh = MOD + (size_t)br * MODW + chunk_shift * DM; const float* sc = sh + DM;
        f32x4 v[8]; float ss = 0.f;
#pragma unroll
        for (int j = 0; j < 8; ++j) { v[j] = *((const f32x4*)xr + lane + 64 * j); ss += (v[j].x * v[j].x + v[j].y * v[j].y) + (v[j].z * v[j].z + v[j].w * v[j].w); }
        const float rstd = rsqrtf(wave_sum(ss) * (1.f / DM) + EPSN);
#pragma unroll
        for (int j = 0; j < 8; ++j) { const int c = (lane + 64 * j) * 4; const f32x4 gg = *(const f32x4*)(g + c), s1 = *(const f32x4*)(sc + c), s0 = *(const f32x4*)(sh + c);
            const f32x4 y = (v[j] * rstd) * gg * (s1 + 1.f) + s0; o8[64 * j] = (v2u){pk2(y.x, y.y), pk2(y.z, y.w)}; }
    }
}
template <int NT> __device__ __forceinline__ void sgemm_acc(const bf16* A, int lda, const bf16* Bt, int K, const int (&nrow)[NT], f32x16 (&acc)[NT], int wave, int lane) {
    const int hh = lane >> 5, l31 = lane & 31, kw = K >> 3;
    const bf16* ap = A + (size_t)l31 * lda + wave * kw + 8 * hh;
    const bf16* bp[NT];
#pragma unroll
    for (int t = 0; t < NT; ++t) { bp[t] = Bt + (size_t)(nrow[t] + l31) * K + wave * kw + 8 * hh;
#pragma unroll
        for (int r = 0; r < 16; ++r) acc[t][r] = 0.f; }
    for (int k = 0; k < kw; k += 64) {
        bf16x8 a[4], b[NT][4];
#pragma unroll
        for (int i = 0; i < 4; ++i) { a[i] = *(const bf16x8*)(ap + k + 16 * i);
#pragma unroll
            for (int t = 0; t < NT; ++t) b[t][i] = *(const bf16x8*)(bp[t] + k + 16 * i); }
#pragma unroll
        for (int i = 0; i < 4; ++i)
#pragma unroll
            for (int t = 0; t < NT; ++t) acc[t] = MFMA32(a[i], b[t][i], acc[t]);
    }
}
template <int NT> __device__ __forceinline__ void sgemm_reduce(const f32x16 (&acc)[NT], LAS float* red, float (&out)[NT][2], int wave, int lane) {
#pragma unroll
    for (int t = 0; t < NT; ++t)
#pragma unroll
        for (int r = 0; r < 16; ++r) red[((wave * NT + t) * 16 + r) * 64 + lane] = acc[t][r];
    __syncthreads();
#pragma unroll
    for (int t = 0; t < NT; ++t)
#pragma unroll
        for (int i = 0; i < 2; ++i) { float s = 0.f;
#pragma unroll
            for (int w = 0; w < 8; ++w) s += red[((w * NT + t) * 16 + wave + 8 * i) * 64 + lane];
            out[t][i] = s; }
    __syncthreads();
}
#define SG_M(i) (8 * ((wave + 8 * (i)) >> 2) + 4 * (lane >> 5) + ((wave + 8 * (i)) & 3))
__device__ __forceinline__ void sg_ffn_up(const bf16* XN, const bf16* W13, bf16* HB, int item, LAS float* red, int wave, int lane) {
    const int c0 = 32 * item, pn = c0 >> 7, cc = c0 & 127; const int nrow[2] = {256 * pn + cc, 256 * pn + 128 + cc};
    f32x16 acc[2]; float o[2][2];
    sgemm_acc<2>(XN + (size_t)MPROMPT * DM, DM, W13, DM, nrow, acc, wave, lane); sgemm_reduce<2>(acc, red, o, wave, lane);
#pragma unroll
    for (int i = 0; i < 2; ++i) { const int m = SG_M(i); HB[(size_t)(MPROMPT + m) * DFF + c0 + (lane & 31)] = (bf16)(pk2(o[0][i] * fsig(o[0][i]) * o[1][i], 0.f) & 0xffffu); }
}
__device__ __forceinline__ void sg_res(const bf16* Arow, int K, const bf16* Bt, const float* base, float* out, const float* gate, float gs, int item, LAS float* red, int wave, int lane) {
    const int nrow[1] = {32 * item}; f32x16 acc[1]; float o[1][2];
    sgemm_acc<1>(Arow, K, Bt, K, nrow, acc, wave, lane); sgemm_reduce<1>(acc, red, o, wave, lane);
#pragma unroll
    for (int i = 0; i < 2; ++i) { const int m = SG_M(i), c = 32 * item + (lane & 31); out[(size_t)m * DM + c] = base[(size_t)m * DM + c] + gs * gate[(size_t)(2 + m) * MODW + c] * o[0][i]; }
}
__device__ __forceinline__ void sg_z(const bf16* XN, const bf16* Win, bf16* ZB, int item, LAS float* red, int wave, int lane) {
    const int nrow[1] = {32 * item}; f32x16 acc[1]; float o[1][2];
    sgemm_acc<1>(XN + (size_t)MPROMPT * DM, DM, Win, DM, nrow, acc, wave, lane); sgemm_reduce<1>(acc, red, o, wave, lane);
#pragma unroll
    for (int i = 0; i < 2; ++i) { const int m = SG_M(i); ZB[(size_t)(MPROMPT + m) * DIN + 32 * item + (lane & 31)] = (bf16)(pk2(o[0][i], 0.f) & 0xffffu); }
}
__device__ __forceinline__ void sg_mix(const bf16* OATT, const bf16* ORNN, const bf16* Wpa, const bf16* Wpr, const bf16* ZB, bf16* MIX, int item, LAS float* red, int wave, int lane) {
    const int nrow[1] = {32 * item}; f32x16 acc[1]; float oa[1][2], orr[1][2];
    sgemm_acc<1>(OATT + (size_t)MPROMPT * DATT, DATT, Wpa, DATT, nrow, acc, wave, lane); sgemm_reduce<1>(acc, red, oa, wave, lane);
    sgemm_acc<1>(ORNN + (size_t)MPROMPT * DRNN, DRNN, Wpr, DRNN, nrow, acc, wave, lane); sgemm_reduce<1>(acc, red, orr, wave, lane);
#pragma unroll
    for (int i = 0; i < 2; ++i) { const int m = SG_M(i), c = 32 * item + (lane & 31); const bf16* zr = ZB + (size_t)(MPROMPT + m) * DIN;
        MIX[(size_t)(MPROMPT + m) * DM + c] = (bf16)(pk2(fsig(bf1(zr[ZGA + c])) * oa[0][i] + fsig(bf1(zr[ZGR + c])) * orr[0][i], 0.f) & 0xffffu); }
}
template <int XORD> __device__ __forceinline__ void norm_rope_row(const bf16* rowp, int hh, const float* g, const float* rp, float scale, float (&o)[4][8]) {
    float v[4][8]; float ss = 0.f;
#pragma unroll
    for (int ks = 0; ks < 4; ++ks) { const v4u w = *(const v4u*)(rowp + 8 * hh + 16 * ks);
        v[ks][0] = bflo(w.x); v[ks][1] = bfhi(w.x); v[ks][2] = bflo(w.y); v[ks][3] = bfhi(w.y); v[ks][4] = bflo(w.z); v[ks][5] = bfhi(w.z); v[ks][6] = bflo(w.w); v[ks][7] = bfhi(w.w);
#pragma unroll
        for (int e = 0; e < 8; ++e) ss += v[ks][e] * v[ks][e]; }
    ss += __shfl_xor(ss, XORD);
    const float rstd = rsqrtf(ss * (1.f / 64.f) + EPSN);
#pragma unroll
    for (int ks = 0; ks < 2; ++ks) { const int d0 = 8 * hh + 16 * ks;
        const f32x4 g0 = *(const f32x4*)(g + d0), g1 = *(const f32x4*)(g + d0 + 4), h0 = *(const f32x4*)(g + d0 + 32), h1 = *(const f32x4*)(g + d0 + 36);
        const f32x4 c0 = *(const f32x4*)(rp + d0), c1 = *(const f32x4*)(rp + d0 + 4), s0 = *(const f32x4*)(rp + 32 + d0), s1 = *(const f32x4*)(rp + 36 + d0);
#pragma unroll
        for (int e = 0; e < 8; ++e) { const float ga = e < 4 ? g0[e & 3] : g1[e & 3], gb = e < 4 ? h0[e & 3] : h1[e & 3], cc = e < 4 ? c0[e & 3] : c1[e & 3], sn = e < 4 ? s0[e & 3] : s1[e & 3];
            const float x1 = v[ks][e] * rstd * ga, x2 = v[ks + 2][e] * rstd * gb;
            o[ks][e] = (x1 * cc - x2 * sn) * scale; o[ks + 2][e] = (x2 * cc + x1 * sn) * scale; } }
}
constexpr int KS_STRIDE = 144, VT_STRIDE = 520, KS_BYTES = 256 * KS_STRIDE, VT_BYTES = 64 * VT_STRIDE;
__device__ __forceinline__ void attn_item(const Args& A, LAS unsigned char* lds, int b, int blk, int kvh, int tid, int wave, int lane) {
    unsigned char* ws = A.ws; const bf16* Z = (const bf16*)(ws + WS_HZ); const float* rope = (const float*)(ws + WS_ROPE); bf16* OATT = (bf16*)(ws + WS_OATT);
    LAS unsigned char* Ks = lds; LAS unsigned char* Vt = lds + KS_BYTES;
    {
        const int key = tid >> 1, hh = tid & 1, t = blk * 128 - 128 + key;
        if (t >= 0) {
            const bf16* zr = Z + (size_t)(b * SEQ + t) * DIN;
            float o[4][8]; norm_rope_row<1>(zr + ZK + kvh * 64, hh, A.in[21], rope + (size_t)t * 64, 1.f, o);
#pragma unroll
            for (int ks = 0; ks < 4; ++ks) *(LAS bf16x8*)(Ks + key * KS_STRIDE + (8 * hh + 16 * ks) * 2) = pack8(o[ks]);
            v4u vv[4];
#pragma unroll
            for (int i = 0; i < 4; ++i) vv[i] = *(const v4u*)(zr + ZV + kvh * 64 + 32 * hh + 8 * i);
#pragma unroll
            for (int i = 0; i < 4; ++i) { const unsigned wv[4] = {vv[i].x, vv[i].y, vv[i].z, vv[i].w};
#pragma unroll
                for (int e = 0; e < 4; ++e) { const int d = 32 * hh + 8 * i + 2 * e;
                    *(LAS bf16*)(Vt + d * VT_STRIDE + key * 2) = (bf16)(wv[e] & 0xffffu); *(LAS bf16*)(Vt + (d + 1) * VT_STRIDE + key * 2) = (bf16)(wv[e] >> 16); } }
            if (blk == SEQ / 128 - 1 && key >= 128) {
                float* kp = A.out + O_KP + ((size_t)(b * 128 + key - 128) * 4 + kvh) * 64; float* vp = A.out + O_VP + ((size_t)(b * 128 + key - 128) * 4 + kvh) * 64;
#pragma unroll
                for (int ks = 0; ks < 4; ++ks) { *(f32x4*)(kp + 8 * hh + 16 * ks) = (f32x4){o[ks][0], o[ks][1], o[ks][2], o[ks][3]}; *(f32x4*)(kp + 8 * hh + 16 * ks + 4) = (f32x4){o[ks][4], o[ks][5], o[ks][6], o[ks][7]}; }
#pragma unroll
                for (int i = 0; i < 4; ++i) { *(f32x4*)(vp + 32 * hh + 8 * i) = (f32x4){bflo(vv[i].x), bfhi(vv[i].x), bflo(vv[i].y), bfhi(vv[i].y)}; *(f32x4*)(vp + 32 * hh + 8 * i + 4) = (f32x4){bflo(vv[i].z), bfhi(vv[i].z), bflo(vv[i].w), bfhi(vv[i].w)}; }
            }
        } else {
#pragma unroll
            for (int ks = 0; ks < 4; ++ks) *(LAS v4u*)(Ks + key * KS_STRIDE + (8 * hh + 16 * ks) * 2) = (v4u){0u, 0u, 0u, 0u};
#pragma unroll
            for (int d = 0; d < 32; ++d) *(LAS bf16*)(Vt + (32 * hh + d) * VT_STRIDE + key * 2) = (bf16)0;
        }
    }
    __syncthreads();
    const int g = wave >> 1, head = kvh * 4 + g, hh = lane >> 5, l31 = lane & 31;
    const float sink = A.in[22][head];
#pragma unroll 1
    for (int qt = 0; qt < 2; ++qt) {
        const int i0 = (wave & 1) * 64 + 32 * qt, qi = i0 + l31, t = blk * 128 + qi; const size_t row = (size_t)b * SEQ + t;
        bf16x8 qf[4];
        { float o[4][8]; norm_rope_row<32>(Z + row * DIN + ZQ + head * 64, hh, A.in[20], rope + (size_t)t * 64, 0.125f, o);
#pragma unroll
          for (int ks = 0; ks < 4; ++ks) qf[ks] = pack8(o[ks]); }
        const int kt0 = i0 >> 5;
        f32x16 s[5];
#pragma unroll
        for (int kk = 0; kk < 5; ++kk) {
#pragma unroll
            for (int r = 0; r < 16; ++r) s[kk][r] = 0.f;
#pragma unroll
            for (int ks = 0; ks < 4; ++ks) { const bf16x8 kf = *(const LAS bf16x8*)(Ks + (32 * (kt0 + kk) + l31) * KS_STRIDE + (8 * hh + 16 * ks) * 2); s[kk] = MFMA32(kf, qf[ks], s[kk]); } }
        float mx = sink;
#pragma unroll
        for (int kk = 0; kk < 5; ++kk)
#pragma unroll
            for (int r = 0; r < 16; ++r) { const int j = 32 * (kt0 + kk) + 8 * (r >> 2) + 4 * hh + (r & 3); const bool ok = (j > qi) && (j <= qi + 128) && (blk > 0 || j >= 128);
                s[kk][r] = ok ? s[kk][r] : -INFINITY; mx = fmaxf(mx, s[kk][r]); }
        mx = fmaxf(mx, __shfl_xor(mx, 32));
        float l = 0.f;
#pragma unroll
        for (int kk = 0; kk < 5; ++kk)
#pragma unroll
            for (int r = 0; r < 16; ++r) { const float p = fexp(s[kk][r] - mx); s[kk][r] = p; l += p; }
        l += __shfl_xor(l, 32);
        const float inv = 1.f / (l + fexp(sink - mx));
        f32x16 oacc[2];
#pragma unroll
        for (int dt = 0; dt < 2; ++dt)
#pragma unroll
            for (int r = 0; r < 16; ++r) oacc[dt][r] = 0.f;
#pragma unroll
        for (int kk = 0; kk < 5; ++kk)
#pragma unroll
            for (int s2 = 0; s2 < 2; ++s2) { float pv[8];
#pragma unroll
                for (int e = 0; e < 8; ++e) pv[e] = s[kk][8 * s2 + e];
                const bf16x8 pf = pack8(pv);
#pragma unroll
                for (int dt = 0; dt < 2; ++dt) { const LAS unsigned char* vp = Vt + (32 * dt + l31) * VT_STRIDE + (32 * (kt0 + kk) + 16 * s2 + 4 * hh) * 2;
                    const v2u lo = *(const LAS v2u*)vp, hi = *(const LAS v2u*)(vp + 16); const v4u a4 = (v4u){lo.x, lo.y, hi.x, hi.y};
                    oacc[dt] = MFMA32(__builtin_bit_cast(bf16x8, a4), pf, oacc[dt]); } }
        bf16* op = OATT + row * DATT + head * 64;
#pragma unroll
        for (int dt = 0; dt < 2; ++dt)
#pragma unroll
            for (int g4 = 0; g4 < 4; ++g4) *(v2u*)(op + 32 * dt + 8 * g4 + 4 * hh) = (v2u){pk2(oacc[dt][4 * g4] * inv, oacc[dt][4 * g4 + 1] * inv), pk2(oacc[dt][4 * g4 + 2] * inv, oacc[dt][4 * g4 + 3] * inv)};
    }
    __syncthreads();
}
__device__ __forceinline__ void attn_sample_item(const Args& A, LAS float* wl  , int bs, int head, int lane) {
    unsigned char* ws = A.ws; const bf16* Z = (const bf16*)(ws + WS_HZ); const float* rp = (const float*)(ws + WS_ROPE) + (size_t)4096 * 64; bf16* OATT = (bf16*)(ws + WS_OATT);
    const int kvh = head >> 2, d = lane, f = d & 31; const size_t row = MPROMPT + bs;
    const bf16* zr = Z + row * DIN;
    const float cs = rp[f], sn = rp[32 + f];
    float q = bf1(zr[ZQ + head * 64 + d]); { const float rstd = rsqrtf(wave_sum(q * q) * (1.f / 64.f) + EPSN); q = q * rstd * A.in[20][d]; const float qo = __shfl_xor(q, 32); q = (d < 32 ? q * cs - qo * sn : q * cs + qo * sn) * 0.125f; }
    float kn = bf1(zr[ZK + kvh * 64 + d]); { const float rstd = rsqrtf(wave_sum(kn * kn) * (1.f / 64.f) + EPSN); kn = kn * rstd * A.in[21][d]; const float ko = __shfl_xor(kn, 32); kn = d < 32 ? kn * cs - ko * sn : kn * cs + ko * sn; }
    const float vn = bf1(zr[ZV + kvh * 64 + d]);
    if ((head & 3) == 0) { A.out[O_KS + ((size_t)bs * 4 + kvh) * 64 + d] = kn; A.out[O_VS + ((size_t)bs * 4 + kvh) * 64 + d] = vn; }
    const float snew = wave_sum(q * kn);
    wl[d] = q; LDS_WAIT();
    const float* ck = A.in[4] + (size_t)bs * 128 * 256 + kvh * 64; const float* cv = A.in[5] + (size_t)bs * 128 * 256 + kvh * 64;
    float s0 = 0.f, s1 = 0.f;
    { const float* k0 = ck + (size_t)lane * 256; const float* k1 = ck + (size_t)(lane + 64) * 256;
#pragma unroll
      for (int i = 0; i < 16; ++i) { const f32x4 qv = *(const LAS f32x4*)(wl + 4 * i), a = *(const f32x4*)(k0 + 4 * i), c = *(const f32x4*)(k1 + 4 * i);
          s0 += (qv.x * a.x + qv.y * a.y) + (qv.z * a.z + qv.w * a.w); s1 += (qv.x * c.x + qv.y * c.y) + (qv.z * c.z + qv.w * c.w); } }
    if (lane == 0) s0 = snew;
    const float sink = A.in[22][head];
    const float mx = fmaxf(wave_max(fmaxf(s0, s1)), sink);
    const float p0 = fexp(s0 - mx), p1 = fexp(s1 - mx);
    const float inv = 1.f / (wave_sum(p0 + p1) + fexp(sink - mx));
    wl[64 + lane] = p0; wl[128 + lane] = p1; LDS_WAIT();
    float o = wl[64] * vn;
#pragma unroll 8
    for (int j = 1; j < 128; ++j) o += wl[64 + j] * cv[(size_t)j * 256 + d];
    OATT[row * DATT + head * 64 + d] = (bf16)(pk2(o * inv, 0.f) & 0xffffu);
    LDS_WAIT();
}
template <bool FINAL> __device__ __forceinline__ void rnn_item(const Args& A, LAS float* xcs  , int b, int c, int hb, int lane) {
    unsigned char* ws = A.ws; const bf16* Z = (const bf16*)(ws + WS_HZ); bf16* ORNN = (bf16*)(ws + WS_ORNN); float* CA = (float*)(ws + WS_CA); float* CH = (float*)(ws + WS_CH);
    const int hh = lane >> 5, l31 = lane & 31, t00 = c * TCHUNK, ch0 = hb * 64;
    const float* cw = A.in[23] + ch0; const float* cbp = A.in[24] + ch0;
#pragma unroll 1
    for (int tt = 0; tt < 2; ++tt) {
        const int t = t00 + 32 * tt + l31; const bf16* zr = Z + ((size_t)b * SEQ + t) * DIN + ZRX + ch0 + 8 * hh;
#pragma unroll 2
        for (int ks = 0; ks < 4; ++ks) {
            const v4u z0 = {0u, 0u, 0u, 0u};
            const v4u x0 = *(const v4u*)(zr + 16 * ks), x1 = t >= 1 ? *(const v4u*)(zr + 16 * ks - DIN) : z0, x2 = t >= 2 ? *(const v4u*)(zr + 16 * ks - 2 * DIN) : z0, x3 = t >= 3 ? *(const v4u*)(zr + 16 * ks - 3 * DIN) : z0;
            const int cg = 8 * hh + 16 * ks; float xc[8];
#pragma unroll
            for (int q = 0; q < 2; ++q) { const f32x4 w0 = *(const f32x4*)(cw + cg + 4 * q), w1 = *(const f32x4*)(cw + DRNN + cg + 4 * q), w2 = *(const f32x4*)(cw + 2 * DRNN + cg + 4 * q), w3 = *(const f32x4*)(cw + 3 * DRNN + cg + 4 * q), bb = *(const f32x4*)(cbp + cg + 4 * q);
                const unsigned a0 = q == 0 ? x0.x : x0.z, a1 = q == 0 ? x0.y : x0.w, b0 = q == 0 ? x1.x : x1.z, b1 = q == 0 ? x1.y : x1.w, c0 = q == 0 ? x2.x : x2.z, c1 = q == 0 ? x2.y : x2.w, d0 = q == 0 ? x3.x : x3.z, d1 = q == 0 ? x3.y : x3.w;
                xc[4 * q + 0] = bb.x + w3.x * bflo(a0) + w2.x * bflo(b0) + w1.x * bflo(c0) + w0.x * bflo(d0);
                xc[4 * q + 1] = bb.y + w3.y * bfhi(a0) + w2.y * bfhi(b0) + w1.y * bfhi(c0) + w0.y * bfhi(d0);
                xc[4 * q + 2] = bb.z + w3.z * bflo(a1) + w2.z * bflo(b1) + w1.z * bflo(c1) + w0.z * bflo(d1);
                xc[4 * q + 3] = bb.w + w3.w * bfhi(a1) + w2.w * bfhi(b1) + w1.w * bfhi(c1) + w0.w * bfhi(d1); }
#pragma unroll
            for (int e = 0; e < 8; ++e) xcs[(32 * tt + l31) * 65 + cg + e] = xc[e];
            if (FINAL && c == NCHUNK - 1 && tt == 1 && l31 >= 29) { float* cp = A.out + O_CP + ((size_t)b * 3 + (l31 - 29)) * DRNN + ch0 + cg;
                *(f32x4*)cp = (f32x4){bflo(x0.x), bfhi(x0.x), bflo(x0.y), bfhi(x0.y)}; *(f32x4*)(cp + 4) = (f32x4){bflo(x0.z), bfhi(x0.z), bflo(x0.w), bfhi(x0.w)}; }
        }
    }
    LDS_WAIT();
#pragma unroll 1
    for (int nt = 0; nt < 2; ++nt) {
        const int j = ch0 + 32 * nt + l31;
        bf16x8 wf[2][4];
#pragma unroll
        for (int gt = 0; gt < 2; ++gt) { const float* wg = A.in[gt == 0 ? 25 : 27] + (size_t)hb * 4096 + 32 * nt + l31;
#pragma unroll
            for (int ks = 0; ks < 4; ++ks) { float v[8];
#pragma unroll
                for (int e = 0; e < 8; ++e) v[e] = wg[(8 * hh + 16 * ks + e) * 64];
                wf[gt][ks] = pack8(v); } }
        const float brg = A.in[26][j], big = A.in[28][j], sp = log1pf(expf(-A.in[29][j]));
        float H = 0.f, Ap = 1.f;
        if (FINAL) { const float* pa = CA + (size_t)b * NCHUNK * DRNN + j; const float* ph = CH + (size_t)b * NCHUNK * DRNN + j;
            for (int c0 = 0; c0 < c; c0 += 8) { float ca[8], cv[8];
#pragma unroll
                for (int u = 0; u < 8; ++u) { ca[u] = pa[(size_t)(c0 + u) * DRNN]; cv[u] = ph[(size_t)(c0 + u) * DRNN]; }
#pragma unroll
                for (int u = 0; u < 8; ++u) H = (c0 + u < c) ? ca[u] * H + cv[u] : H; } }
#pragma unroll 1
        for (int tt = 0; tt < 2; ++tt) {
            const int t0 = t00 + 32 * tt;
            f32x16 ar, ai;
#pragma unroll
            for (int r = 0; r < 16; ++r) { ar[r] = 0.f; ai[r] = 0.f; }
#pragma unroll
            for (int ks = 0; ks < 4; ++ks) { float v[8];
#pragma unroll
                for (int e = 0; e < 8; ++e) v[e] = xcs[(32 * tt + l31) * 65 + 8 * hh + 16 * ks + e];
                const bf16x8 af = pack8(v); ar = MFMA32(af, wf[0][ks], ar); ai = MFMA32(af, wf[1][ks], ai); }
            float rgv[16];
            if (FINAL) {
#pragma unroll
                for (int r = 0; r < 16; ++r) { const int tk = 8 * (r >> 2) + 4 * hh + (r & 3); rgv[r] = bf1(Z[((size_t)b * SEQ + t0 + tk) * DIN + ZRG + j]); } }
#pragma unroll
            for (int r = 0; r < 16; ++r) { const int tk = 8 * (r >> 2) + 4 * hh + (r & 3);
                const float rg_ = fsig(ar[r] + brg), ig_ = fsig(ai[r] + big); const float la = -8.f * rg_ * sp; const float a = fexp(la);
                const float mult = __builtin_amdgcn_sqrtf(fmaxf(1.f - a * a, 0.f)); ar[r] = a; ai[r] = mult * ig_ * xcs[(32 * tt + tk) * 65 + 32 * nt + l31]; }
            float Hs[4];
#pragma unroll
            for (int g4 = 0; g4 < 4; ++g4) { float Aa = 1.f, U = 0.f;
#pragma unroll
                for (int r4 = 0; r4 < 4; ++r4) { const float a = ar[4 * g4 + r4]; U = a * U + ai[4 * g4 + r4]; Aa *= a; }
                const float pA = __shfl_xor(Aa, 32), pU = __shfl_xor(U, 32);
                const float A0 = hh == 0 ? Aa : pA, U0 = hh == 0 ? U : pU, A1 = hh == 0 ? pA : Aa, U1 = hh == 0 ? pU : U;
                const float Hs0 = H; H = A0 * H + U0; const float Hs1 = H; H = A1 * H + U1; Hs[g4] = hh == 0 ? Hs0 : Hs1; Ap *= A0 * A1; }
            if (FINAL) {
#pragma unroll
                for (int g4 = 0; g4 < 4; ++g4) { float h = Hs[g4];
#pragma unroll
                    for (int r4 = 0; r4 < 4; ++r4) { const int r = 4 * g4 + r4, tk = 8 * g4 + 4 * hh + r4; h = ar[r] * h + ai[r];
                        ORNN[((size_t)b * SEQ + t0 + tk) * DRNN + j] = (bf16)(pk2(h * gelu_tanh(rgv[r]), 0.f) & 0xffffu); } } }
        }
        if (!FINAL) { if (hh == 0) { const size_t o = ((size_t)b * NCHUNK + c) * DRNN + j; CA[o] = Ap; CH[o] = H; } }
        else if (c == NCHUNK - 1 && hh == 0) A.out[O_HP + (size_t)b * DRNN + j] = H;
    }
    LDS_WAIT();
}
__device__ __forceinline__ void rnn_sample_item(const Args& A, int bs, int hb, int lane) {
    unsigned char* ws = A.ws; const bf16* Z = (const bf16*)(ws + WS_HZ); bf16* ORNN = (bf16*)(ws + WS_ORNN);
    const int ch = hb * 64 + lane; const size_t row = MPROMPT + bs;
    const float* sc = A.in[7] + (size_t)bs * 3 * DRNN + ch; const float b0 = sc[0], b1 = sc[DRNN], b2 = sc[2 * DRNN];
    const float rx = bf1(Z[row * DIN + ZRX + ch]), rg = bf1(Z[row * DIN + ZRG + ch]);
    const float xc = A.in[24][ch] + A.in[23][ch] * b0 + A.in[23][DRNN + ch] * b1 + A.in[23][2 * DRNN + ch] * b2 + A.in[23][3 * DRNN + ch] * rx;
    const float* wr = A.in[25] + (size_t)hb * 4096 + lane; const float* wi = A.in[27] + (size_t)hb * 4096 + lane;
    float ar = A.in[26][ch], ai = A.in[28][ch];
#pragma unroll 16
    for (int i = 0; i < 64; ++i) { const float xi = __shfl(xc, i); ar += xi * wr[i * 64]; ai += xi * wi[i * 64]; }
    const float rg_ = fsig(ar), ig_ = fsig(ai), la = -8.f * rg_ * log1pf(expf(-A.in[29][ch])), a = expf(la), mult = sqrtf(fmaxf(-expm1f(2.f * la), 0.f));
    const float h = a * A.in[6][(size_t)bs * DRNN + ch] + mult * ig_ * xc;
    A.out[O_HS + (size_t)bs * DRNN + ch] = h;
    ORNN[row * DRNN + ch] = (bf16)(pk2(h * gelu_tanh(rg), 0.f) & 0xffffu);
    float* co = A.out + O_CS + (size_t)bs * 3 * DRNN + ch; co[0] = b1; co[DRNN] = b2; co[2 * DRNN] = rx;
}

#define XB_TMO      128
#define XB_XCNT(j)  (256  + 64 * (j))
#define XB_XSUB(j)  (1280 + 64 * (j))
#define XB_XGEN(j)  (2304 + 64 * (j))
#define XB_TOP      3328
#define XB_TOPGEN   3392
#define XCD_BAR_WORDS 3456
#define XB_SPIN_CAP (1u << 18)

__device__ __forceinline__ unsigned xb_ld(unsigned* p)              { return __hip_atomic_load(p, __ATOMIC_RELAXED, __HIP_MEMORY_SCOPE_AGENT); }
__device__ __forceinline__ unsigned xb_add(unsigned* p, unsigned v) { return __hip_atomic_fetch_add(p, v, __ATOMIC_RELAXED, __HIP_MEMORY_SCOPE_AGENT); }
__device__ __forceinline__ unsigned xb_xcc_id() { return (unsigned)__builtin_amdgcn_s_getreg((3 << 11) | 20) & 0xFu; }
#define XB_SPIN(cond, bar) do { unsigned _sp = 0; while (cond) { __builtin_amdgcn_s_sleep(1); \
    if ((++_sp & 255u) == 0u) { if (xb_ld(&(bar)[XB_TMO])) break; if (_sp > XB_SPIN_CAP) { atomicAdd(&(bar)[XB_TMO], 1u); break; } } } } while (0)

struct XcdBarrier {
    unsigned* bar; unsigned x;
    volatile LAS unsigned* st;
};

__device__ __forceinline__ XcdBarrier xcd_barrier_post(unsigned* bar, volatile LAS unsigned* st) {
    XcdBarrier b; b.bar = bar; b.x = xb_xcc_id(); b.st = st;
    if (threadIdx.x == 0) (void)xb_add(&bar[XB_XCNT(b.x)], 1u);
    return b;
}
__device__ __forceinline__ void xcd_barrier_complete(unsigned* bar, unsigned x, unsigned& nloc, unsigned& nx) {
    const unsigned G = gridDim.x * gridDim.y * gridDim.z;
    unsigned sum, cnt, mine, sp = 0u;
    for (;;) {
        sum = 0u; cnt = 0u; mine = 0u;
#pragma unroll
        for (unsigned j = 0; j < 16; ++j) { const unsigned c = xb_ld(&bar[XB_XCNT(j)]); sum += c; cnt += (c > 0u) ? 1u : 0u; mine = (j == x) ? c : mine; }
        if (sum == G) break;
        __builtin_amdgcn_s_sleep(1);
        if ((++sp & 255u) == 0u) { if (xb_ld(&bar[XB_TMO])) break; if (sp > XB_SPIN_CAP) { atomicAdd(&bar[XB_TMO], 1u); break; } }
    }
    nloc = mine > 0u ? mine : 1u; nx = cnt > 0u ? cnt : 1u;
}

__device__ __forceinline__ void xcd_barrier(const XcdBarrier& b) {
    asm volatile("s_waitcnt vmcnt(0)" ::: "memory");
    __syncthreads();
    if (threadIdx.x == 0) {
        unsigned* bar = b.bar;
        __builtin_amdgcn_s_waitcnt(0);
        unsigned nloc = b.st[0], nx = b.st[1];
        if (nloc == 0u) { xcd_barrier_complete(bar, b.x, nloc, nx); b.st[0] = nloc; b.st[1] = nx; }
        const unsigned old = xb_add(&bar[XB_XSUB(b.x)], 1u);
        const unsigned gen = old / nloc;
        if (old + 1u == (gen + 1u) * nloc) {
            __builtin_amdgcn_fence(__ATOMIC_RELEASE, "agent");
            asm volatile("s_waitcnt vmcnt(0)" ::: "memory");
            const unsigned og = xb_add(&bar[XB_TOP], 1u);
            const unsigned tg = og / nx;
            if (og + 1u == (tg + 1u) * nx) xb_add(&bar[XB_TOPGEN], 1u);
            else XB_SPIN(xb_ld(&bar[XB_TOPGEN]) == tg, bar);
            __builtin_amdgcn_fence(__ATOMIC_ACQUIRE, "agent");
            xb_add(&bar[XB_XGEN(b.x)], 1u);
            asm volatile("s_waitcnt vmcnt(0)" ::: "memory");
        } else {
            XB_SPIN(xb_ld(&bar[XB_XGEN(b.x)]) == gen, bar);
            __builtin_amdgcn_fence(__ATOMIC_ACQUIRE, "agent");
            asm volatile("s_waitcnt vmcnt(0)" ::: "memory");
        }
    }
    __syncthreads();
}

__global__ void __launch_bounds__(NTHREADS, 2) mk_fwd(Args args) {
    extern __shared__ __attribute__((aligned(16))) unsigned char lds_raw[];
    LAS unsigned char* lds = (LAS unsigned char*)lds_raw;
    const int tid = threadIdx.x, lane = tid & 63, wave = __builtin_amdgcn_readfirstlane(tid >> 6);
    const int G = gridDim.x, bx = blockIdx.x;
    unsigned char* ws = args.ws;
    const int lo = args.ph_lo, hi = args.ph_hi;
    if (tid < 16) ((LAS unsigned*)(lds + MISC_OFF))[tid] = 0u;
    __syncthreads();
    if (hi > 1000) cg::this_grid().sync();
    XcdBarrier bar; bar.bar = (unsigned*)(ws + WS_BAR); bar.x = 0; bar.st = nullptr;
    if (hi - lo > 1) bar = xcd_barrier_post((unsigned*)(ws + WS_BAR), (volatile LAS unsigned*)(lds + MISC_OFF));
    bf16* XN = (bf16*)(ws + WS_XN); bf16* HB = (bf16*)(ws + WS_HZ); bf16* ZB = (bf16*)(ws + WS_HZ); float* XB = (float*)(ws + WS_X); float* MOD = (float*)(ws + WS_MOD);
    bf16* OATT = (bf16*)(ws + WS_OATT); bf16* ORNN = (bf16*)(ws + WS_ORNN); bf16* MIX = (bf16*)(ws + WS_MIX);
#ifndef PH_MASK
#define PH_MASK 0x1fff
#endif
#define IN(k) (((PH_MASK >> (k)) & 1) && lo <= (k) && (k) < hi)
#ifndef REP_MASK
#define REP_MASK 0
#endif
#define REPS(k) for (int rep_ = 0; rep_ < 1 + ((REP_MASK >> (k)) & 1); ++rep_)
#define SEAM(k) do { if (IN(k) && IN((k) + 1)) { xcd_barrier(bar); } } while (0)

    if (IN(0)) REPS(0) { p0_prologue(args, lds, tid, wave, lane); } SEAM(0);
    if (IN(1)) REPS(1) { norm_phase(args.in[0], args.in[1], args.in[10], MOD, 0, XN, wave, lane); } SEAM(1);
    LAS float* red = (LAS float*)lds;
    const float* MODS = MOD;
    if (IN(2)) { for (int it = bx - 128; it >= 0 && it < DFF / 32; it += 128) sg_ffn_up(XN, (const bf16*)(ws + WS_W13A), HB, it, red, wave, lane);
        if (bx >= 128) { const int w = (bx - 128) * NWAVES + wave; LAS float* scr = (LAS float*)(lds + wave * 16640);
            tr_matrix<0>(args.in[15], (bf16*)(ws + WS_W2A), DFF, DM, w, 128 * NWAVES, scr, lane); tr_matrix<0>(args.in[19], (bf16*)(ws + WS_WIN), DM, DIN, w, 128 * NWAVES, scr, lane); __syncthreads(); }
        pg8::Gemm g{XN, (const bf16*)(ws + WS_W13A), MPROMPT, 2 * DFF, DM}; pg8::StaticOrder S; S.init(MPROMPT, 2 * DFF, G, bx); pg8::EpiSwiGLU E{HB, DFF};
        pg8::gemm_phase<pg8::EpiSwiGLU, pg8::StaticOrder, true, true>(lds, g, S, E); } SEAM(2);
    if (IN(3)) { for (int it = bx; it < DM / 32; it += G) sg_res(HB + (size_t)MPROMPT * DFF, DFF, (const bf16*)(ws + WS_W2A), args.in[1], XB + (size_t)MPROMPT * DM, MODS + 2 * DM, 0.5f, it, red, wave, lane);
        pg8::Gemm g{HB, (const bf16*)(ws + WS_W2A), MPROMPT, DM, DFF}; pg8::StaticOrder S; S.init(MPROMPT, DM, G, bx); pg8::EpiRes E{args.in[0], args.in[1], XB, MOD + 2 * DM, 0.5f};
        pg8::gemm_phase<pg8::EpiRes, pg8::StaticOrder, true, true>(lds, g, S, E); } SEAM(3);
    if (IN(4)) { norm_phase(XB, XB + (size_t)MPROMPT * DM, args.in[11], MOD, 3, XN, wave, lane); } SEAM(4);
    if (IN(5)) { for (int it = bx - 192; it >= 0 && it < DIN / 32; it += 64) sg_z(XN, (const bf16*)(ws + WS_WIN), ZB, it, red, wave, lane);
        if (bx >= 192) { const int w = (bx - 192) * NWAVES + wave; LAS float* scr = (LAS float*)(lds + wave * 16640);
            tr_matrix<0>(args.in[30], (bf16*)(ws + WS_WPA), DATT, DM, w, 64 * NWAVES, scr, lane); tr_matrix<0>(args.in[31], (bf16*)(ws + WS_WPR), DRNN, DM, w, 64 * NWAVES, scr, lane);
            tr_matrix<0>(args.in[32], (bf16*)(ws + WS_WOUT), DM, DM, w, 64 * NWAVES, scr, lane); __syncthreads(); }
        pg8::Gemm g{XN, (const bf16*)(ws + WS_WIN), MPROMPT, DIN, DM}; pg8::StaticOrder S; S.init(MPROMPT, DIN, G, bx); pg8::EpiBf16<0> E{ZB, DIN, nullptr, 0, 0, 1.f};
        pg8::gemm_phase<pg8::EpiBf16<0>, pg8::StaticOrder, true, true>(lds, g, S, E); } SEAM(5);
    if (IN(6)) REPS(6) {
#ifndef NO_ATTN
        for (int it = bx; it < 256; it += G) attn_item(args, lds, it >> 7, (it >> 2) & 31, it & 3, tid, wave, lane);
#endif
#ifndef NO_RNN
        for (int it = bx; it < 4 * NCHUNK; it += G) rnn_item<false>(args, (LAS float*)(lds + wave * 16640), it >> 7, (it >> 1) & 63, (it & 1) * 8 + wave, lane);
#endif
        __syncthreads();
#ifndef NO_SATTN
        for (int it = (G - 1 - bx) * NWAVES + wave; it < NSAMP * 16; it += G * NWAVES) attn_sample_item(args, (LAS float*)(lds + wave * 768), it >> 4, it & 15, lane);
#endif
        __syncthreads();
        { const int w = bx * NWAVES + wave; LAS float* scr = (LAS float*)(lds + wave * 16640);
          tr_matrix<1>(args.in[16], (bf16*)(ws + WS_W13B), DM, DFF, w, G * NWAVES, scr, lane); tr_matrix<2>(args.in[17], (bf16*)(ws + WS_W13B), DM, DFF, w, G * NWAVES, scr, lane);
          tr_matrix<0>(args.in[18], (bf16*)(ws + WS_W2B), DFF, DM, w, G * NWAVES, scr, lane); }
    } SEAM(6);
    if (IN(7)) {
        REPS(7) for (int it = bx; it < 4 * NCHUNK; it += G) rnn_item<true>(args, (LAS float*)(lds + wave * 16640), it >> 7, (it >> 1) & 63, (it & 1) * 8 + wave, lane);
        for (int it = (G - 1 - bx) * NWAVES + wave; it < NSAMP * 16; it += G * NWAVES) rnn_sample_item(args, it >> 4, it & 15, lane);
        __syncthreads();
        pg8::Gemm g{OATT, (const bf16*)(ws + WS_WPA), MPROMPT, DM, DATT}; pg8::StaticOrder S; S.init(MPROMPT, DM, G, bx); pg8::EpiGateMix<false> E{MIX, ZB + ZGA};
        pg8::gemm_phase<pg8::EpiGateMix<false>, pg8::StaticOrder, true, true>(lds, g, S, E); } SEAM(7);
    if (IN(8)) { for (int it = bx; it < DM / 32; it += G) sg_mix(OATT, ORNN, (const bf16*)(ws + WS_WPA), (const bf16*)(ws + WS_WPR), ZB, MIX, it, red, wave, lane);
        pg8::Gemm g{ORNN, (const bf16*)(ws + WS_WPR), MPROMPT, DM, DRNN}; pg8::StaticOrder S; S.init(MPROMPT, DM, G, bx); pg8::EpiGateMix<true> E{MIX, ZB + ZGR};
        pg8::gemm_phase<pg8::EpiGateMix<true>, pg8::StaticOrder, true, true>(lds, g, S, E); } SEAM(8);
    if (IN(9)) { for (int it = bx; it < DM / 32; it += G) sg_res(MIX + (size_t)MPROMPT * DM, DM, (const bf16*)(ws + WS_WOUT), XB + (size_t)MPROMPT * DM, XB + (size_t)MPROMPT * DM, MODS + 5 * DM, 1.f, it, red, wave, lane);
        pg8::Gemm g{MIX, (const bf16*)(ws + WS_WOUT), MPROMPT, DM, DM}; pg8::StaticOrder S; S.init(MPROMPT, DM, G, bx); pg8::EpiRes E{XB, XB + (size_t)MPROMPT * DM, XB, MOD + 5 * DM, 1.f};
        pg8::gemm_phase<pg8::EpiRes, pg8::StaticOrder, true, true>(lds, g, S, E); } SEAM(9);
    if (IN(10)) { norm_phase(XB, XB + (size_t)MPROMPT * DM, args.in[12], MOD, 6, XN, wave, lane); } SEAM(10);
    if (IN(11)) { for (int it = bx - 128; it >= 0 && it < DFF / 32; it += 128) sg_ffn_up(XN, (const bf16*)(ws + WS_W13B), HB, it, red, wave, lane);
        pg8::Gemm g{XN, (const bf16*)(ws + WS_W13B), MPROMPT, 2 * DFF, DM}; pg8::StaticOrder S; S.init(MPROMPT, 2 * DFF, G, bx); pg8::EpiSwiGLU E{HB, DFF};
        pg8::gemm_phase<pg8::EpiSwiGLU, pg8::StaticOrder, true, true>(lds, g, S, E); } SEAM(11);
    if (IN(12)) { for (int it = bx; it < DM / 32; it += G) sg_res(HB + (size_t)MPROMPT * DFF, DFF, (const bf16*)(ws + WS_W2B), XB + (size_t)MPROMPT * DM, args.out + O_Y + (size_t)MPROMPT * DM, MODS + 8 * DM, 0.5f, it, red, wave, lane);
        pg8::Gemm g{HB, (const bf16*)(ws + WS_W2B), MPROMPT, DM, DFF}; pg8::StaticOrder S; S.init(MPROMPT, DM, G, bx); pg8::EpiRes E{XB, XB + (size_t)MPROMPT * DM, args.out + O_Y, MOD + 8 * DM, 0.5f};
        pg8::gemm_phase<pg8::EpiRes, pg8::StaticOrder, true, true>(lds, g, S, E); }
#undef IN
#undef SEAM
}

extern "C" void kernel_launch(void* const* d_in, const int* in_sizes, int n_in, void* d_out, int out_size, void* d_ws, size_t ws_size, hipStream_t stream) {
    static int grid = 0;
    if (grid == 0) {
        if (n_in != 33 || out_size != (int)O_END || ws_size < WS_END) { fprintf(stderr, "kernel_launch: unexpected shapes: n_in %d out %d ws %zu\n", n_in, out_size, ws_size); grid = -1; return; }
        int dev = 0, cus = 0, per_cu = 0;
        hipGetDevice(&dev); hipDeviceGetAttribute(&cus, hipDeviceAttributeMultiprocessorCount, dev);
        hipFuncSetAttribute((const void*)mk_fwd, hipFuncAttributeMaxDynamicSharedMemorySize, LDS_BYTES);
        hipOccupancyMaxActiveBlocksPerMultiprocessor(&per_cu, (const void*)mk_fwd, NTHREADS, LDS_BYTES);
        if (per_cu < 1) { fprintf(stderr, "kernel_launch: occupancy query says %d blocks per CU\n", per_cu); grid = -1; return; }
        grid = cus;
    }
    if (grid < 0) return;
    Args a{};
    for (int i = 0; i < 33; ++i) a.in[i] = (const float*)d_in[i];
    a.out = (float*)d_out; a.ws = (unsigned char*)d_ws;
#if MK_ONE_LAUNCH
    if (hipMemsetAsync((char*)d_ws + WS_BAR, 0, 65536, stream) != hipSuccess) { fprintf(stderr, "memset failed\n"); return; }
    a.ph_lo = 0; a.ph_hi = 13;
    void* kargs[] = {&a};
    hipError_t e = hipLaunchCooperativeKernel((const void*)mk_fwd, dim3(grid), dim3(NTHREADS), kargs, LDS_BYTES, stream);
    if (e != hipSuccess) fprintf(stderr, "cooperative launch failed: %s (grid %d)\n", hipGetErrorString(e), grid);
#else
    for (int p = 0; p < 13; ++p) { a.ph_lo = p; a.ph_hi = p + 1; hipLaunchKernelGGL(mk_fwd, dim3(grid), dim3(NTHREADS), LDS_BYTES, stream, a); }
#endif
}
```
